# Optimizing an MI355X kernel written in HIP

```python
import math
import jax, jax.numpy as jnp
from jax import lax
import numpy as np

D_MODEL = 1024
BATCH = 32
SEQ = 2048
DEPTH = 4

N_META = 16
CHUNK = 64
PAD = CHUNK - N_META
GLA_HEADS = 4
GLA_DK = 128
GLA_DV = 256
GLA_RANK = 16
GLA_TAU = 16.0
RET_HEADS = 4
RET_DK = 128
RET_DV = 256
ROPE_BASE = 10000.0
D_FF = 2816
N_EXPERTS = 8
TOP_K = 2
D_FF_EXPERT = 3584
ALPHA = (2 * DEPTH) ** 0.25
BETA = (8 * DEPTH) ** -0.25
LN_EPS = 1e-5
GN_EPS = 1e-6
N_DENSE = (DEPTH + 1) // 2
N_MOE = DEPTH // 2

GLA_QK = GLA_HEADS * GLA_DK
GLA_V = GLA_HEADS * GLA_DV
RET_QK = RET_HEADS * RET_DK
RET_V = RET_HEADS * RET_DV
IN_SIZES = (GLA_QK, GLA_QK, GLA_V, GLA_V, GLA_RANK,
            RET_QK, RET_QK, RET_V, RET_V,
            D_MODEL, D_MODEL)
N_IN = sum(IN_SIZES)

kernel_name = "hybrid_gla_retention_deepnorm_moe"


def layer_norm(x, g, b):
    xf = x.astype(jnp.float32)
    mu = jnp.mean(xf, axis=-1, keepdims=True)
    var = jnp.mean(jnp.square(xf - mu), axis=-1, keepdims=True)
    y = (xf - mu) * lax.rsqrt(var + LN_EPS) * g.astype(jnp.float32) + b.astype(jnp.float32)
    return y.astype(x.dtype)


def rotary(t, pos):
    half = t.shape[-1] // 2
    inv = ROPE_BASE ** (-jnp.arange(half, dtype=jnp.float32) / half)
    ang = pos[:, None] * inv[None, :]
    cos = jnp.cos(ang)[None, :, None, :]
    sin = jnp.sin(ang)[None, :, None, :]
    t1, t2 = t[..., :half], t[..., half:]
    return jnp.concatenate([t1 * cos - t2 * sin, t1 * sin + t2 * cos], axis=-1)


def to_chunks(t, n_heads):
    bsz, length, width = t.shape
    t = jnp.pad(t.astype(jnp.float32), ((0, 0), (PAD, 0), (0, 0)))
    n = (length + PAD) // CHUNK
    return t.reshape(bsz, n, CHUNK, n_heads, width // n_heads).transpose(0, 3, 1, 2, 4)


def from_chunks(o):
    bsz, h, n, c, d = o.shape
    return o.transpose(0, 2, 3, 1, 4).reshape(bsz, n * c, h, d)[:, PAD:]


def chunk_recurrence(q_in, k_tail, v, decay):
    bsz, h, n, c, dk = q_in.shape
    dv = v.shape[-1]

    def step(s, inp):
        qc, kc, vc, dc = inp
        o = jnp.einsum('bhcd,bhdv->bhcv', qc, s)
        s = s * dc[..., None] + jnp.einsum('bhcd,bhcv->bhdv', kc, vc)
        return s, o

    xs = (jnp.moveaxis(q_in, 2, 0), jnp.moveaxis(k_tail, 2, 0),
          jnp.moveaxis(v, 2, 0), jnp.moveaxis(decay, 2, 0))
    s0 = jnp.zeros((bsz, h, dk, dv), jnp.float32)
    _, o = lax.scan(step, s0, xs)
    return jnp.moveaxis(o, 0, 2)


def gla_chunked(q, k, v, log_a):
    b = jnp.cumsum(log_a, axis=3)
    b_last = b[..., -1:, :]
    q_in = q * jnp.exp(b)
    k_in = k * jnp.exp(-b)
    causal = jnp.tril(jnp.ones((CHUNK, CHUNK), dtype=bool))
    scores = jnp.where(causal, jnp.einsum('bhnid,bhnjd->bhnij', q_in, k_in), 0.0)
    o_intra = jnp.einsum('bhnij,bhnjv->bhniv', scores, v)
    k_tail = k * jnp.exp(b_last - b)
    decay = jnp.exp(b_last[..., 0, :])
    return o_intra + chunk_recurrence(q_in, k_tail, v, decay)


def retention_chunked(q, k, v, log_gamma):
    idx = jnp.arange(CHUNK, dtype=jnp.float32)
    rel = idx[:, None] - idx[None, :]
    lg = log_gamma[:, None, None]
    dmat = jnp.where(rel >= 0, jnp.exp(lg * jnp.maximum(rel, 0.0)), 0.0)
    scores = jnp.einsum('bhnid,bhnjd->bhnij', q, k) * dmat[None, :, None]
    o_intra = jnp.einsum('bhnij,bhnjv->bhniv', scores, v)
    xi = jnp.exp(log_gamma[:, None] * (idx + 1.0))[None, :, None, :, None]
    zeta = jnp.exp(log_gamma[:, None] * (CHUNK - 1.0 - idx))[None, :, None, :, None]
    bsz, h, n, _, dk = q.shape
    decay = jnp.broadcast_to(jnp.exp(log_gamma * CHUNK)[None, :, None, None], (bsz, h, n, dk))
    return o_intra + chunk_recurrence(q * xi, k * zeta, v, decay)


def token_mixer(x, w_in, b_gate, gla_w_a2, gla_b_a, gla_norm_g, ret_norm_g, ret_norm_b,
                w_pa, w_pb, w_o):
    bsz, length, _ = x.shape
    proj = x @ w_in
    split_at = np.cumsum(np.array(IN_SIZES))[:-1].tolist()
    gq, gk, gv, gr, ga, rq, rk, rv, rg, gate_a, gate_b = jnp.split(proj, split_at, axis=-1)

    log_a = jax.nn.log_sigmoid((ga @ gla_w_a2 + gla_b_a).astype(jnp.float32)) / GLA_TAU
    o_a = gla_chunked(to_chunks(gq * GLA_DK ** -0.5, GLA_HEADS), to_chunks(gk, GLA_HEADS),
                      to_chunks(gv, GLA_HEADS), to_chunks(log_a, GLA_HEADS))
    o_a = from_chunks(o_a)
    o_a = o_a * lax.rsqrt(jnp.mean(jnp.square(o_a), axis=-1, keepdims=True) + LN_EPS) \
        * gla_norm_g.astype(jnp.float32)
    y_a = (jax.nn.silu(gr.astype(jnp.float32)) * o_a.reshape(bsz, length, GLA_V)) @ w_pa

    pos = jnp.arange(length, dtype=jnp.float32)
    rq_r = rotary(rq.astype(jnp.float32).reshape(bsz, length, RET_HEADS, RET_DK), pos)
    rk_r = rotary(rk.astype(jnp.float32).reshape(bsz, length, RET_HEADS, RET_DK), pos) * RET_DK ** -0.5
    log_gamma = jnp.log(1.0 - 2.0 ** (-5.0 - jnp.arange(RET_HEADS, dtype=jnp.float32)))
    o_b = retention_chunked(to_chunks(rq_r.reshape(bsz, length, RET_QK), RET_HEADS),
                            to_chunks(rk_r.reshape(bsz, length, RET_QK), RET_HEADS),
                            to_chunks(rv, RET_HEADS), log_gamma)
    o_b = from_chunks(o_b)
    mu = jnp.mean(o_b, axis=-1, keepdims=True)
    var = jnp.mean(jnp.square(o_b - mu), axis=-1, keepdims=True)
    o_b = ((o_b - mu) * lax.rsqrt(var + GN_EPS)).reshape(bsz, length, RET_V) \
        * ret_norm_g.astype(jnp.float32) + ret_norm_b.astype(jnp.float32)
    y_b = (jax.nn.silu(rg.astype(jnp.float32)) * o_b) @ w_pb

    merged = jax.nn.sigmoid((gate_a + b_gate[0]).astype(jnp.float32)) * y_a \
        + jax.nn.sigmoid((gate_b + b_gate[1]).astype(jnp.float32)) * y_b
    return (merged @ w_o).astype(x.dtype)


def swiglu(x, w_gate, w_up, w_down):
    return (jax.nn.silu(x @ w_gate) * (x @ w_up)) @ w_down


def moe_swiglu(x, w_router, w_gate, w_up, w_down):
    bsz, length, d = x.shape
    t = x.reshape(-1, d)
    probs = jax.nn.softmax((t @ w_router).astype(jnp.float32), axis=-1)
    top_p, top_i = lax.top_k(probs, TOP_K)
    top_p = top_p / jnp.sum(top_p, axis=-1, keepdims=True)
    combine = jnp.sum(jax.nn.one_hot(top_i, N_EXPERTS, dtype=jnp.float32) * top_p[..., None], axis=1)
    out = jnp.zeros(t.shape, jnp.float32)
    for e in range(N_EXPERTS):
        out = out + combine[:, e:e + 1] * swiglu(t, w_gate[e], w_up[e], w_down[e]).astype(jnp.float32)
    return out.reshape(bsz, length, d).astype(x.dtype)


def setup_inputs(seed: int = 0) -> dict:
    key = jax.random.key(seed)
    ks = jax.random.split(key, 24)
    f32 = jnp.float32
    nrm = lambda k, shape, scale: jax.random.normal(k, shape, f32) * scale
    d = D_MODEL
    return {
        "x": nrm(ks[0], (BATCH, SEQ, d), 1.0),
        "meta": nrm(ks[1], (N_META, d), 1.0),
        "w_in": nrm(ks[2], (DEPTH, d, N_IN), d ** -0.5),
        "b_gate": nrm(ks[3], (DEPTH, 2, d), 0.01),
        "gla_w_a2": nrm(ks[4], (DEPTH, GLA_RANK, GLA_QK), GLA_RANK ** -0.5),
        "gla_b_a": nrm(ks[5], (DEPTH, GLA_QK), 0.01),
        "gla_norm_g": 1.0 + nrm(ks[6], (DEPTH, GLA_DV), 0.02),
        "ret_norm_g": 1.0 + nrm(ks[7], (DEPTH, RET_V), 0.02),
        "ret_norm_b": nrm(ks[8], (DEPTH, RET_V), 0.01),
        "w_pa": nrm(ks[9], (DEPTH, GLA_V, d), GLA_V ** -0.5),
        "w_pb": nrm(ks[10], (DEPTH, RET_V, d), RET_V ** -0.5),
        "w_o": nrm(ks[11], (DEPTH, d, d), BETA * d ** -0.5),
        "ln1_g": 1.0 + nrm(ks[12], (DEPTH, d), 0.02),
        "ln1_b": nrm(ks[13], (DEPTH, d), 0.01),
        "ffn_w_gate": nrm(ks[14], (N_DENSE, d, D_FF), d ** -0.5),
        "ffn_w_up": nrm(ks[15], (N_DENSE, d, D_FF), d ** -0.5),
        "ffn_w_down": nrm(ks[16], (N_DENSE, D_FF, d), BETA * D_FF ** -0.5),
        "moe_w_router": nrm(ks[17], (N_MOE, d, N_EXPERTS), d ** -0.5),
        "moe_w_gate": nrm(ks[18], (N_MOE, N_EXPERTS, d, D_FF_EXPERT), d ** -0.5),
        "moe_w_up": nrm(ks[19], (N_MOE, N_EXPERTS, d, D_FF_EXPERT), d ** -0.5),
        "moe_w_down": nrm(ks[20], (N_MOE, N_EXPERTS, D_FF_EXPERT, d), BETA * D_FF_EXPERT ** -0.5),
        "ln2_g": 1.0 + nrm(ks[21], (DEPTH, d), 0.02),
        "ln2_b": nrm(ks[22], (DEPTH, d), 0.01),
    }


def reference(x, meta, w_in, b_gate, gla_w_a2, gla_b_a, gla_norm_g, ret_norm_g, ret_norm_b,
              w_pa, w_pb, w_o, ln1_g, ln1_b, ffn_w_gate, ffn_w_up, ffn_w_down,
              moe_w_router, moe_w_gate, moe_w_up, moe_w_down, ln2_g, ln2_b):
    bsz = x.shape[0]
    h = jnp.concatenate([jnp.broadcast_to(meta[None].astype(x.dtype), (bsz, N_META, x.shape[-1])), x], axis=1)
    for l in range(DEPTH):
        mix = token_mixer(h, w_in[l], b_gate[l], gla_w_a2[l], gla_b_a[l], gla_norm_g[l],
                          ret_norm_g[l], ret_norm_b[l], w_pa[l], w_pb[l], w_o[l])
        h = layer_norm(ALPHA * h + mix, ln1_g[l], ln1_b[l])
        if l % 2 == 0:
            f = swiglu(h, ffn_w_gate[l // 2], ffn_w_up[l // 2], ffn_w_down[l // 2])
        else:
            f = moe_swiglu(h, moe_w_router[l // 2], moe_w_gate[l // 2], moe_w_up[l // 2], moe_w_down[l // 2])
        h = layer_norm(ALPHA * h + f, ln2_g[l], ln2_b[l])
    return h[:, N_META:]
```

```cpp
#include <hip/hip_runtime.h>
#include <cstdio>
#include <cstdint>

#ifndef N_LAUNCH_MODE
#define N_LAUNCH_MODE 1
#endif

#define LAS __attribute__((address_space(3)))
typedef unsigned short bf16;
typedef short bf16x8 __attribute__((ext_vector_type(8)));
typedef float f32x4 __attribute__((ext_vector_type(4)));
typedef float f32x2 __attribute__((ext_vector_type(2)));
typedef unsigned u32x4 __attribute__((ext_vector_type(4)));
typedef unsigned u32x2 __attribute__((ext_vector_type(2)));

constexpr int D = 1024, NB = 32, SEQ = 2048, DEPTH = 4, NMETA = 16;
constexpr int M = NB * SEQ;
constexpr int NIN = 8208;
constexpr int N1 = 6400;
constexpr int DFF = 2816, DFFE = 3584, NEXP = 8, HFF = 1792;
constexpr float ALPHA = 1.681792830507429f;
constexpr float QSCALE = 0.08838834764831845f;
constexpr float LN_EPS = 1e-5f, GN_EPS = 1e-6f;
constexpr int NPH = 12;
constexpr int NPHASES = DEPTH * NPH;

constexpr size_t MiB = 1u << 20;
constexpr size_t WS_CTL = 0, CTL_ZERO_BYTES = 1 * MiB;
constexpr size_t WS_ROPE = 1 * MiB;
constexpr size_t WS_META = 3 * MiB;
constexpr size_t WS_MOE = 4 * MiB;
constexpr size_t WS_GA = 8 * MiB;
constexpr size_t WS_W = 12 * MiB;
constexpr size_t WS_XA = 204 * MiB;
constexpr size_t WS_XBF = 460 * MiB;
constexpr size_t WS_QK = 588 * MiB;
constexpr size_t WS_V = 844 * MiB;
constexpr size_t WS_END = 1100 * MiB;
constexpr size_t W_B1 = 0;
constexpr size_t W_B2 = W_B1 + (size_t)N1 * D * 2;
constexpr size_t W_PA = W_B2 + (size_t)2048 * D * 2;
constexpr size_t W_PB = W_PA + (size_t)D * D * 2;
constexpr size_t W_O = W_PB + (size_t)D * D * 2;
constexpr size_t W_F = W_O + (size_t)D * D * 2;
constexpr size_t W_FD_DENSE = W_F + (size_t)2 * DFF * D * 2;
constexpr size_t W_FD_MOE = W_F + (size_t)NEXP * 2 * DFFE * D * 2;
static_assert(W_FD_MOE + (size_t)NEXP * 2 * D * HFF * 2 <= 192 * MiB, "weights fit");
constexpr size_t MT_HA = 0, MT_HB = 65536, MT_XB = 131072, MT_QK = 163840, MT_V = 229376, MT_SIG = 294912, MT_GA = 360448, MT_MRG = 364544,
                 MT_U = 397312  , MT_Y = 512000  , MT_TOK = 643072  , MT_O = 644096  ;
static_assert(MT_O + 65536 <= MiB, "meta map");
constexpr int CW_CNT = 1024;
constexpr int CW_BAR = 4096;

constexpr int RING_BYTES = 131072;
constexpr int LDS_BYTES = 147456;
constexpr int MISC_OFF = LDS_BYTES - 1024;
constexpr int NWAVES = 8, NTHR = 512;

__device__ __forceinline__ unsigned f2bf(float f) { unsigned u = __builtin_bit_cast(unsigned, f); return (u + 0x7fffu + ((u >> 16) & 1u)) >> 16; }
__device__ __forceinline__ float bf2f(unsigned h) { return __builtin_bit_cast(float, (h & 0xffffu) << 16); }
__device__ __forceinline__ unsigned pk2(float lo, float hi) { return f2bf(lo) | (f2bf(hi) << 16); }
__device__ __forceinline__ void store_bf4(bf16* p, f32x4 v) { u32x2 w; w.x = pk2(v[0], v[1]); w.y = pk2(v[2], v[3]); *(u32x2*)p = w; }
__device__ __forceinline__ f32x4 load_bf4(const bf16* p) { const u32x2 w = *(const u32x2*)p; return (f32x4){bf2f(w.x), bf2f(w.x >> 16), bf2f(w.y), bf2f(w.y >> 16)}; }
__device__ __forceinline__ float sigmoidf_(float x) { return 1.0f / (1.0f + __expf(-x)); }
__device__ __forceinline__ float siluf_(float x) { return x / (1.0f + __expf(-x)); }
__device__ __forceinline__ float wave_sum(float v) {
#pragma unroll
    for (int o = 1; o < 64; o <<= 1) v += __shfl_xor(v, o);
    return v;
}
#define LDS_WAIT() asm volatile("s_waitcnt lgkmcnt(0)" ::: "memory")
#define VM_WAIT() asm volatile("s_waitcnt vmcnt(0)" ::: "memory")

namespace pg8 {
constexpr int BM = 256, BK = 64, HALF = 128, HTB = HALF * BK * 2, STAGE_BYTES = 8 * HTB, NXCD = 8, WGM = 8;
__host__ __device__ __forceinline__ int lds_byte(int r, int c) { const int st = (r >> 4) * 2 + (c >> 5), rr = r & 15, cc = c & 31, ob = rr * 64 + cc * 2; return st * 1024 + (ob ^ (((ob >> 9) & 1) << 5)); }
__host__ __device__ __forceinline__ void stage_rc(int b, int& R, int& C) { const int st = b / 1024, sb = b % 1024, swz = sb ^ (((sb >> 9) & 1) << 5); R = (st >> 1) * 16 + swz / 64; C = (st & 1) * 32 + (swz % 64) / 2; }

struct Unit { const char* A; const char* B; int row0, col0, e, nvalid; };

struct SchedDense {
    static constexpr bool GATHER = false;
    int nM, nN, nwg, G, c; const char* A; const char* Bt; unsigned lda, ldb;
    __device__ void init(int Mr, int Nc, int G_, int c_, const void* A_, unsigned lda_, const void* Bt_, unsigned ldb_) { nM = Mr / BM; nN = Nc / BM; nwg = nM * nN; G = G_; c = c_; A = (const char*)A_; Bt = (const char*)Bt_; lda = lda_; ldb = ldb_; }
    __device__ bool next(int i, Unit& u) const {
        const long L = (long)i * G + c; if (L >= nwg) return false;
        int wgid = (int)L; { const int q = nwg / NXCD, r = nwg % NXCD, xcd = wgid % NXCD, off = wgid / NXCD; wgid = (xcd < r ? xcd * (q + 1) : r * (q + 1) + (xcd - r) * q) + off; }
        const int nig = WGM * nN, gid = wgid / nig, fm = gid * WGM, gsz = (nM - fm) < WGM ? (nM - fm) : WGM;
        const int pm = fm + ((wgid % nig) % gsz), pn = (wgid % nig) / gsz;
        u.A = A + (size_t)pm * BM * lda; u.B = Bt + (size_t)pn * BM * ldb; u.row0 = pm * BM; u.col0 = pn * BM; u.e = 0; u.nvalid = BM; return true;
    }
    __device__ __forceinline__ unsigned a_off(const Unit&, int R, int h) const { return (unsigned)(h * HALF + R) * lda; }
};

template <class F> struct EpiEl {
    F f;
    template <int MODE> __device__ __forceinline__ void loop(const f32x4 (&acc)[2][2][4][2], const Unit& u, int wr, int wc, int fr, int fq) const {
#pragma unroll
        for (int ai = 0; ai < 2; ++ai)
#pragma unroll
            for (int m = 0; m < 4; ++m) { const int r = ai * HALF + wr * 64 + m * 16 + fr;
#pragma unroll
                for (int bj = 0; bj < 2; ++bj)
#pragma unroll
                    for (int n = 0; n < 2; ++n) f.template at<MODE>(u, r, bj * HALF + wc * 32 + n * 16 + 4 * fq, acc[ai][bj][m][n]);
                asm volatile("" ::: "memory"); }
    }
    __device__ __forceinline__ void operator()(const f32x4 (&acc)[2][2][4][2], const Unit& u, int wr, int wc, int fr, int fq) const {
        if constexpr (F::NMODES == 1) loop<0>(acc, u, wr, wc, fr, fq);
        else {
            const int mode = __builtin_amdgcn_readfirstlane(f.mode(u));
            if (mode == 0) loop<0>(acc, u, wr, wc, fr, fq);
            else if (mode == 1) loop<1>(acc, u, wr, wc, fr, fq);
            else if (mode == 2) loop<2>(acc, u, wr, wc, fr, fq);
            else if (mode == 3) loop<3>(acc, u, wr, wc, fr, fq);
            else loop<4>(acc, u, wr, wc, fr, fq);
        }
    }
};

template <class Epi, class Sched, bool ALIGN_EPI = true>
__device__ __forceinline__ void gemm_phase(LAS unsigned char* lds, const int tid, const Sched& S, const Epi& E, const int K, const unsigned lda, const unsigned ldb) {
    const int wid = __builtin_amdgcn_readfirstlane(tid >> 6), lane = tid & 63, wr = wid >> 2, wc = wid & 3, fr = lane & 15, fq = lane >> 4;
    const int nt = K / BK;
    int Rr[2], Cc[2]; unsigned voffA[2], voffB[2];
#pragma unroll
    for (int i = 0; i < 2; ++i) { int R, C; stage_rc(tid * 16 + i * 8192, R, C); Rr[i] = R; Cc[i] = C; voffA[i] = (unsigned)R * lda + (unsigned)C * 2u; voffB[i] = (unsigned)R * ldb + (unsigned)C * 2u; }
    const size_t kstep = (size_t)(BK * 2);
    const size_t hstepA = (size_t)HALF * lda, hstepB = (size_t)HALF * ldb;
    const unsigned ldsw = (unsigned)wid * 1024u;
    const int aoff = lds_byte(wr * 64 + fr, fq * 8), boff = lds_byte(wc * 32 + fr, fq * 8);
#define PG8_SA(b, h) (((b) * 2 + (h)) * HTB)
#define PG8_SB(b, h) ((4 + (b) * 2 + (h)) * HTB)
#define PG8_STAGE_B(bufoff, gbase) do { _Pragma("unroll") for (int _i = 0; _i < 2; ++_i) \
        __builtin_amdgcn_global_load_lds((const unsigned*)((const char*)(gbase) + voffB[_i]), (LAS unsigned*)(lds + (bufoff) + ldsw + _i * 8192), 16, 0, 0); } while (0)
#define PG8_STAGE_A(bufoff, gbase, h, ox) do { _Pragma("unroll") for (int _i = 0; _i < 2; ++_i) { \
        const char* _p = Sched::GATHER ? ((const char*)(gbase) + (ox)[h][_i]) : ((const char*)(gbase) + (h) * hstepA + voffA[_i]); \
        __builtin_amdgcn_global_load_lds((const unsigned*)_p, (LAS unsigned*)(lds + (bufoff) + ldsw + _i * 8192), 16, 0, 0); } } while (0)
#define PG8_LDA(dst, b, h) do { _Pragma("unroll") for (int m = 0; m < 4; ++m) _Pragma("unroll") for (int k = 0; k < 2; ++k) dst[m][k] = *(const LAS bf16x8*)(lds + PG8_SA(b, h) + aoff + m * 2048 + k * 1024); } while (0)
#define PG8_LDB(dst, b, h) do { _Pragma("unroll") for (int n = 0; n < 2; ++n) _Pragma("unroll") for (int k = 0; k < 2; ++k) dst[n][k] = *(const LAS bf16x8*)(lds + PG8_SB(b, h) + boff + n * 2048 + k * 1024); } while (0)
#define PG8_MMA(ai, bj, At, Bt) do { __builtin_amdgcn_s_setprio(1); _Pragma("unroll") for (int m = 0; m < 4; ++m) _Pragma("unroll") for (int n = 0; n < 2; ++n) _Pragma("unroll") for (int k = 0; k < 2; ++k) \
        acc[ai][bj][m][n] = __builtin_amdgcn_mfma_f32_16x16x32_bf16(Bt[n][k], At[m][k], acc[ai][bj][m][n], 0, 0, 0); __builtin_amdgcn_s_setprio(0); } while (0)
#define PG8_WAIT_V(n) asm volatile("s_waitcnt vmcnt(" #n ")" ::: "memory")
#define PG8_WAIT_L(n) asm volatile("s_waitcnt lgkmcnt(" #n ")" ::: "memory")
#define PG8_BAR __builtin_amdgcn_s_barrier()
#define PG8_SCHED __builtin_amdgcn_sched_barrier(0)
    Unit cur, nxt; int ui = 0;
    if (!S.next(0, cur)) return;
    f32x4 acc[2][2][4][2];
#pragma unroll
    for (int a = 0; a < 2; ++a)
#pragma unroll
        for (int b = 0; b < 2; ++b)
#pragma unroll
            for (int m = 0; m < 4; ++m)
#pragma unroll
                for (int n = 0; n < 2; ++n) acc[a][b][m][n] = (f32x4){0.f, 0.f, 0.f, 0.f};
    bf16x8 At[4][2], B0[2][2], B1[2][2];
    unsigned oc[2][2];
#pragma unroll
    for (int h = 0; h < 2; ++h)
#pragma unroll
        for (int i = 0; i < 2; ++i) oc[h][i] = Sched::GATHER ? (S.a_off(cur, Rr[i], h) + (unsigned)Cc[i] * 2u) : 0u;
    const char* cA = cur.A; const char* cB = cur.B;
    PG8_STAGE_B(PG8_SB(0, 0), cB); PG8_STAGE_B(PG8_SB(0, 1), cB + hstepB); PG8_STAGE_A(PG8_SA(0, 0), cA, 0, oc); PG8_STAGE_A(PG8_SA(0, 1), cA, 1, oc);
    if (wr == 1) PG8_BAR;
    PG8_WAIT_V(2); PG8_BAR;
    PG8_STAGE_B(PG8_SB(1, 0), cB + kstep); PG8_STAGE_A(PG8_SA(1, 0), cA + kstep, 0, oc); PG8_STAGE_B(PG8_SB(1, 1), cB + hstepB + kstep);
    PG8_WAIT_V(6); PG8_BAR;
    for (;;) {
        const bool has_next = S.next(ui + 1, nxt);
        const char* nA = has_next ? nxt.A : cA; const char* nB = has_next ? nxt.B : cB;
        for (int t = 0; t < nt; t += 2) {
            const bool last = (t == nt - 2);
            const char* a1 = cA + (size_t)(t + 1) * kstep;
            const char* a2 = last ? nA : cA + (size_t)(t + 2) * kstep; const char* b2 = last ? nB : cB + (size_t)(t + 2) * kstep;
            const char* a3 = a2 + kstep; const char* b3 = b2 + kstep;
            PG8_LDB(B0, 0, 0); PG8_LDB(B1, 0, 1); PG8_SCHED; PG8_LDA(At, 0, 0); PG8_STAGE_A(PG8_SA(1, 1), a1, 1, oc);
            if constexpr (Sched::GATHER) { if (last && has_next) {
#pragma unroll
                for (int h = 0; h < 2; ++h)
#pragma unroll
                    for (int i = 0; i < 2; ++i) oc[h][i] = S.a_off(nxt, Rr[i], h) + (unsigned)Cc[i] * 2u; } }
            PG8_WAIT_V(8); PG8_WAIT_L(0); PG8_BAR; PG8_MMA(0, 0, At, B0); PG8_MMA(0, 1, At, B1); PG8_BAR; PG8_SCHED;
            PG8_LDA(At, 0, 1); PG8_STAGE_B(PG8_SB(0, 0), b2); PG8_STAGE_B(PG8_SB(0, 1), b2 + hstepB); PG8_STAGE_A(PG8_SA(0, 0), a2, 0, oc);
            PG8_WAIT_V(8); PG8_WAIT_L(0); PG8_BAR; PG8_MMA(1, 0, At, B0); PG8_MMA(1, 1, At, B1); PG8_BAR; PG8_SCHED;
            PG8_LDB(B0, 1, 0); PG8_LDB(B1, 1, 1); PG8_SCHED; PG8_LDA(At, 1, 0); PG8_STAGE_A(PG8_SA(0, 1), a2, 1, oc);
            PG8_WAIT_V(8); PG8_WAIT_L(0); PG8_BAR; PG8_MMA(0, 0, At, B0); PG8_MMA(0, 1, At, B1); PG8_BAR; PG8_SCHED;
            PG8_LDA(At, 1, 1); PG8_STAGE_B(PG8_SB(1, 0), b3); PG8_STAGE_B(PG8_SB(1, 1), b3 + hstepB); PG8_STAGE_A(PG8_SA(1, 0), a3, 0, oc);
            PG8_WAIT_V(8); PG8_WAIT_L(0); PG8_BAR; PG8_MMA(1, 0, At, B0); PG8_MMA(1, 1, At, B1); PG8_BAR; PG8_SCHED;
        }
        if constexpr (ALIGN_EPI) { if (wr == 0) PG8_BAR; }
        E(acc, cur, wr, wc, fr, fq);
        if (!has_next) break;
#pragma unroll
        for (int a = 0; a < 2; ++a)
#pragma unroll
            for (int b = 0; b < 2; ++b)
#pragma unroll
                for (int m = 0; m < 4; ++m)
#pragma unroll
                    for (int n = 0; n < 2; ++n) acc[a][b][m][n] = (f32x4){0.f, 0.f, 0.f, 0.f};
        cur = nxt; cA = nA; cB = nB; ++ui;
        if constexpr (ALIGN_EPI) { if (wr == 1) PG8_BAR; }
    }
    PG8_WAIT_V(0);
    if constexpr (!ALIGN_EPI) { if (wr == 0) PG8_BAR; }
    PG8_BAR;
#undef PG8_SA
#undef PG8_SB
#undef PG8_STAGE_A
#undef PG8_STAGE_B
#undef PG8_LDA
#undef PG8_LDB
#undef PG8_MMA
#undef PG8_WAIT_V
#undef PG8_WAIT_L
#undef PG8_BAR
#undef PG8_SCHED
}
}

#define XB_TMO      128
#define XB_XCNT(j)  (256  + 64 * (j))
#define XB_XSUB(j)  (1280 + 64 * (j))
#define XB_XGEN(j)  (2304 + 64 * (j))
#define XB_TOP      3328
#define XB_TOPGEN   3392
#define XCD_BAR_WORDS 3456
#define XB_SPIN_CAP (1u << 18)
__device__ __forceinline__ unsigned xb_ld(unsigned* p)              { return __hip_atomic_load(p, __ATOMIC_RELAXED, __HIP_MEMORY_SCOPE_AGENT); }
__device__ __forceinline__ unsigned xb_add(unsigned* p, unsigned v) { return __hip_atomic_fetch_add(p, v, __ATOMIC_RELAXED, __HIP_MEMORY_SCOPE_AGENT); }
__device__ __forceinline__ unsigned xb_xcc_id() { return (unsigned)__builtin_amdgcn_s_getreg((3 << 11) | 20) & 0xFu; }
#define XB_SPIN(cond, bar) do { unsigned _sp = 0; while (cond) { __builtin_amdgcn_s_sleep(1); \
    if ((++_sp & 255u) == 0u) { if (xb_ld(&(bar)[XB_TMO])) break; if (_sp > XB_SPIN_CAP) { atomicAdd(&(bar)[XB_TMO], 1u); break; } } } } while (0)
struct XcdBarrier { unsigned* bar; unsigned x; volatile LAS unsigned* st; };
__device__ __forceinline__ XcdBarrier xcd_barrier_post(unsigned* bar, volatile LAS unsigned* st) {
    XcdBarrier b; b.bar = bar; b.x = xb_xcc_id(); b.st = st;
    if (threadIdx.x == 0) (void)xb_add(&bar[XB_XCNT(b.x)], 1u);
    return b;
}
__device__ __forceinline__ void xcd_barrier_complete(unsigned* bar, unsigned x, unsigned& nloc, unsigned& nx) {
    const unsigned G = gridDim.x * gridDim.y * gridDim.z;
    unsigned sum, cnt, mine, sp = 0u;
    for (;;) {
        sum = 0u; cnt = 0u; mine = 0u;
#pragma unroll
        for (unsigned j = 0; j < 16; ++j) { const unsigned c = xb_ld(&bar[XB_XCNT(j)]); sum += c; cnt += (c > 0u) ? 1u : 0u; mine = (j == x) ? c : mine; }
        if (sum == G) break;
        __builtin_amdgcn_s_sleep(1);
        if ((++sp & 255u) == 0u) { if (xb_ld(&bar[XB_TMO])) break; if (sp > XB_SPIN_CAP) { atomicAdd(&bar[XB_TMO], 1u); break; } }
    }
    nloc = mine > 0u ? mine : 1u; nx = cnt > 0u ? cnt : 1u;
}
__device__ __forceinline__ void xcd_barrier(const XcdBarrier& b) {
    asm volatile("s_waitcnt vmcnt(0)" ::: "memory");
    __syncthreads();
    if (threadIdx.x == 0) {
        unsigned* bar = b.bar;
        __builtin_amdgcn_s_waitcnt(0);
        unsigned nloc = b.st[0], nx = b.st[1];
        if (nloc == 0u) { xcd_barrier_complete(bar, b.x, nloc, nx); b.st[0] = nloc; b.st[1] = nx; }
        const unsigned old = xb_add(&bar[XB_XSUB(b.x)], 1u);
        const unsigned gen = old / nloc;
        if (old + 1u == (gen + 1u) * nloc) {
            __builtin_amdgcn_fence(__ATOMIC_RELEASE, "agent");
            asm volatile("s_waitcnt vmcnt(0)" ::: "memory");
            const unsigned og = xb_add(&bar[XB_TOP], 1u);
            const unsigned tg = og / nx;
            if (og + 1u == (tg + 1u) * nx) xb_add(&bar[XB_TOPGEN], 1u);
            else XB_SPIN(xb_ld(&bar[XB_TOPGEN]) == tg, bar);
            __builtin_amdgcn_fence(__ATOMIC_ACQUIRE, "agent");
            xb_add(&bar[XB_XGEN(b.x)], 1u);
            asm volatile("s_waitcnt vmcnt(0)" ::: "memory");
        } else {
            XB_SPIN(xb_ld(&bar[XB_XGEN(b.x)]) == gen, bar);
            __builtin_amdgcn_fence(__ATOMIC_ACQUIRE, "agent");
            asm volatile("s_waitcnt vmcnt(0)" ::: "memory");
        }
    }
    __syncthreads();
}

struct Args { const float* in[23]; float* out; unsigned char* ws; int ph_lo, ph_hi; };
enum { I_X = 0, I_META, I_WIN, I_BGATE, I_WA2, I_BA, I_GNG, I_RNG, I_RNB, I_WPA, I_WPB, I_WO, I_LN1G, I_LN1B, I_FG, I_FU, I_FD, I_RT, I_MG, I_MU, I_MD, I_LN2G, I_LN2B };

struct Frame {
    LAS unsigned char* lds; volatile LAS unsigned* MISC; unsigned* ctl;
    int tid, lane, wave, G, bid, gtid, gthreads, gwave, gwaves;
    unsigned char* ws;
};

template <class AR, class BR, class F>
__device__ __forceinline__ void naive_gemm(const Frame& Fr, int nrows, int ncols, int K, AR arow, BR brow, F f) {
    const int nc4 = ncols >> 2;
    for (int idx = Fr.gtid; idx < nrows * nc4; idx += Fr.gthreads) {
        const int row = idx / nc4, c0 = (idx % nc4) * 4;
        const bf16* a = arow(row);
        f32x4 acc = (f32x4){0.f, 0.f, 0.f, 0.f};
#pragma unroll
        for (int j = 0; j < 4; ++j) {
            const bf16* b = brow(row, c0 + j);
            float s = 0.f;
            for (int k = 0; k < K; k += 8) {
                const u32x4 av = *(const u32x4*)(a + k), bv = *(const u32x4*)(b + k);
                s += bf2f(av.x) * bf2f(bv.x) + bf2f(av.x >> 16) * bf2f(bv.x >> 16) + bf2f(av.y) * bf2f(bv.y) + bf2f(av.y >> 16) * bf2f(bv.y >> 16)
                   + bf2f(av.z) * bf2f(bv.z) + bf2f(av.z >> 16) * bf2f(bv.z >> 16) + bf2f(av.w) * bf2f(bv.w) + bf2f(av.w >> 16) * bf2f(bv.w >> 16);
            }
            acc[j] = s;
        }
        pg8::Unit u; u.A = nullptr; u.B = nullptr; u.row0 = 0; u.col0 = c0 & ~255; u.e = 0; u.nvalid = nrows;
        const int cc = c0 & 255;
        if constexpr (F::NMODES == 1) f.template at<0>(u, row, cc, acc);
        else { const int mode = f.mode(u);
            if (mode == 0) f.template at<0>(u, row, cc, acc); else if (mode == 1) f.template at<1>(u, row, cc, acc); else if (mode == 2) f.template at<2>(u, row, cc, acc);
            else if (mode == 3) f.template at<3>(u, row, cc, acc); else f.template at<4>(u, row, cc, acc); }
    }
}

struct F1 {
    static constexpr int NMODES = 5;
    bf16* QK; bf16* V; bf16* SIG; float* GA; const f32x2* rope; const float* bg; int posmask, posbase;
    __device__ __forceinline__ int mode(const pg8::Unit& u) const { const int c = u.col0; return c < 1024 ? 0 : (c < 2048 ? 1 : (c < 4096 ? 2 : (c < 6144 ? 3 : 4))); }
    template <int MODE> __device__ __forceinline__ void at(const pg8::Unit& u, int r, int c, f32x4 v) const {
        const int row = u.row0 + r, col = u.col0 + c;
        if (MODE == 0) { const float s = col < 512 ? QSCALE : 1.f; store_bf4(QK + (size_t)row * 2048 + col, v * s); }
        else if (MODE == 1) {
            const int j = (col - 1024) & 127, pos = (row & posmask) + posbase; const f32x2 c0 = rope[pos * 64 + (j >> 1)], c1 = rope[pos * 64 + (j >> 1) + 1];
            const float s = col >= 1536 ? QSCALE : 1.f;
            f32x4 o; o[0] = (v[0] * c0.x - v[1] * c0.y) * s; o[1] = (v[0] * c0.y + v[1] * c0.x) * s; o[2] = (v[2] * c1.x - v[3] * c1.y) * s; o[3] = (v[2] * c1.y + v[3] * c1.x) * s;
            store_bf4(QK + (size_t)row * 2048 + col, o);
        }
        else if (MODE == 2) store_bf4(V + (size_t)row * 2048 + (col - 2048), v);
        else if (MODE == 3) { const int cc = col - 4096; const f32x4 b = *(const f32x4*)(bg + cc);
            f32x4 o; o[0] = sigmoidf_(v[0] + b[0]); o[1] = sigmoidf_(v[1] + b[1]); o[2] = sigmoidf_(v[2] + b[2]); o[3] = sigmoidf_(v[3] + b[3]);
            store_bf4(SIG + (size_t)row * 2048 + cc, o); }
        else { if (col < 6160) *(f32x4*)(GA + (size_t)row * 16 + (col - 6144)) = v; }
    }
};
struct F2 {
    static constexpr int NMODES = 1;
    const bf16* O; bf16* V;
    template <int MODE> __device__ __forceinline__ void at(const pg8::Unit& u, int r, int c, f32x4 v) const {
        const size_t off = (size_t)(u.row0 + r) * 2048 + u.col0 + c; bf16* p = V + off; const f32x4 o = load_bf4(O + off);
        f32x4 w; w[0] = siluf_(v[0]) * o[0]; w[1] = siluf_(v[1]) * o[1]; w[2] = siluf_(v[2]) * o[2]; w[3] = siluf_(v[3]) * o[3];
        store_bf4(p, w);
    }
};
struct F3 {
    static constexpr int NMODES = 1;
    bf16* MRG; const bf16* SIG; int second;
    template <int MODE> __device__ __forceinline__ void at(const pg8::Unit& u, int r, int c, f32x4 v) const {
        const int row = u.row0 + r, col = u.col0 + c; bf16* p = MRG + (size_t)row * 1024 + col;
        const f32x4 g = load_bf4(SIG + (size_t)row * 2048 + second * 1024 + col); f32x4 o = g * v;
        if (second) o = o + load_bf4(p);
        store_bf4(p, o);
    }
};
struct F4 {
    static constexpr int NMODES = 1;
    const float* RES; float* OUT;
    template <int MODE> __device__ __forceinline__ void at(const pg8::Unit& u, int r, int c, f32x4 v) const {
        const size_t o = (size_t)(u.row0 + r) * 1024 + u.col0 + c; const f32x4 h = *(const f32x4*)(RES + o);
        *(f32x4*)(OUT + o) = h * ALPHA + v;
    }
};
struct F5 {
    static constexpr int NMODES = 1;
    bf16* U; int ldu;
    template <int MODE> __device__ __forceinline__ void at(const pg8::Unit& u, int r, int c, f32x4 v) const {
        bf16* p = U + (size_t)(u.row0 + r) * ldu + ((u.col0 + c) >> 1);
        *(unsigned*)p = pk2(siluf_(v[0]) * v[2], siluf_(v[1]) * v[3]);
    }
};
struct F6M {
    static constexpr int NMODES = 1;
    bf16* Y; int second;
    template <int MODE> __device__ __forceinline__ void at(const pg8::Unit& u, int r, int c, f32x4 v) const {
        if (r >= u.nvalid) return;
        bf16* p = Y + (size_t)(u.row0 + r) * 1024 + u.col0 + c;
        if (second) v = v + load_bf4(p);
        store_bf4(p, v);
    }
};
struct F6Mm {
    static constexpr int NMODES = 1;
    float* Y; int second;
    template <int MODE> __device__ __forceinline__ void at(const pg8::Unit& u, int r, int c, f32x4 v) const {
        float* p = Y + (size_t)r * 1024 + u.col0 + c;
        if (second) v = v + *(const f32x4*)p;
        *(f32x4*)p = v;
    }
};

struct SchedMoeUp {
    static constexpr bool GATHER = true;
    volatile LAS unsigned* T; const int* perm; const char* A; const char* W; int G, c, hf;
    __device__ bool next(int i, pg8::Unit& u) const {
        const int TT = (int)T[32]; const long L = (long)i * G + c; if (L >= (long)TT * 14) return false;
        const int gt = (int)(L / 14), pn = (int)(L % 14); int e = 0;
#pragma unroll
        for (int j = 1; j < 8; ++j) e += (gt >= (int)T[24 + j]) ? 1 : 0;
        u.A = A; u.B = W + ((size_t)(e * 2 + hf) * DFFE + (size_t)pn * 256) * (D * 2); u.row0 = gt * 256; u.col0 = pn * 256; u.e = e; u.nvalid = gt - (int)T[24 + e];
        return true;
    }
    __device__ __forceinline__ unsigned a_off(const pg8::Unit& u, int R, int h) const {
        const int rank = u.nvalid * 256 + h * 128 + R, cnt = (int)T[16 + u.e];
        const int tok = perm[u.e * M + (rank < cnt ? rank : 0)];
        return (unsigned)tok * (unsigned)(D * 2);
    }
};
struct SchedMoeDown {
    static constexpr bool GATHER = false;
    volatile LAS unsigned* T; const char* A; const char* W; int G, c, hf;
    __device__ bool next(int i, pg8::Unit& u) const {
        const int TT = (int)T[32]; const long L = (long)i * G + c; if (L >= (long)TT * 4) return false;
        const int gt = (int)(L / 4), pn = (int)(L % 4); int e = 0;
#pragma unroll
        for (int j = 1; j < 8; ++j) e += (gt >= (int)T[24 + j]) ? 1 : 0;
        const int ti = gt - (int)T[24 + e], cnt = (int)T[16 + e];
        u.A = A + (size_t)gt * 256 * (HFF * 2); u.B = W + ((size_t)(e * 2 + hf) * D + (size_t)pn * 256) * (HFF * 2);
        u.row0 = (int)T[40 + e] + ti * 256; u.col0 = pn * 256; u.e = e; u.nvalid = (cnt - ti * 256) < 256 ? (cnt - ti * 256) : 256;
        return true;
    }
    __device__ __forceinline__ unsigned a_off(const pg8::Unit&, int R, int h) const { return (unsigned)(h * 128 + R) * (unsigned)(HFF * 2); }
};

__device__ __forceinline__ int map_b1(int n) {
    if (n < 1024) return n;
    if (n < 2048) { const int t = n - 1024, blk = t >> 9, hh = (t >> 7) & 3, j = t & 127; return (blk ? 3600 : 3088) + hh * 128 + (j >> 1) + 64 * (j & 1); }
    if (n < 3072) return 1024 + (n - 2048);
    if (n < 4096) return 4112 + (n - 3072);
    if (n < 5120) return 6160 + (n - 4096);
    if (n < 6144) return 7184 + (n - 5120);
    if (n < 6160) return 3072 + (n - 6144);
    return -1;
}
__device__ __forceinline__ int map_b2(int n) { return n < 1024 ? 2048 + n : 5136 + (n - 1024); }
__device__ __forceinline__ void cvt_item(const float* W, const float* W2, int kind, int foff, int ldsrc, int koff, int K, bf16* WT, LAS float* scr, int item, int lane) {
    const int nkb = K / 64, nb = item / nkb, kb = item % nkb, k0 = 64 * kb, n0 = 32 * nb;
    const int n = n0 + (lane & 31);
    int col; const float* src = W;
    if (kind == 0) col = n; else if (kind == 1) col = map_b1(n); else if (kind == 2) col = map_b2(n);
    else { col = foff + 2 * (n >> 2) + (n & 1); if (n & 2) src = W2; }
#pragma unroll 8
    for (int i = 0; i < 32; ++i) { const int kk = 2 * i + (lane >> 5); scr[kk * 33 + (lane & 31)] = (col >= 0) ? src[(size_t)(koff + k0 + kk) * ldsrc + col] : 0.f; }
    LDS_WAIT(); asm volatile("" ::: "memory");
    const int c = lane & 7;
#pragma unroll
    for (int j = 0; j < 4; ++j) { const int nn = (lane >> 3) + 8 * j; const LAS float* s = scr + (8 * c) * 33 + nn;
        u32x4 o; o.x = pk2(s[0 * 33], s[1 * 33]); o.y = pk2(s[2 * 33], s[3 * 33]); o.z = pk2(s[4 * 33], s[5 * 33]); o.w = pk2(s[6 * 33], s[7 * 33]);
        *(u32x4*)(WT + (size_t)(n0 + nn) * K + k0 + 8 * c) = o; }
    LDS_WAIT(); asm volatile("" ::: "memory");
}
__device__ __forceinline__ void cvt_job(const Frame& F, int& rot, const float* W, const float* W2, int kind, int foff, int ldsrc, int koff, int K, int Nnew, bf16* WT) {
    LAS float* scr = (LAS float*)(F.lds + F.wave * 16384);
    const int items = (K / 64) * (Nnew / 32);
    int start = F.gwave - rot; if (start < 0) start += F.gwaves;
    for (int it = start; it < items; it += F.gwaves) cvt_item(W, W2, kind, foff, ldsrc, koff, K, WT, scr, it, F.lane);
    rot = (rot + items) % F.gwaves;
}

__device__ __forceinline__ void ln_vals(f32x4 (&v)[4], const float* g, const float* b, int lane) {
    float s = 0.f;
#pragma unroll
    for (int j = 0; j < 4; ++j) s += (v[j][0] + v[j][1]) + (v[j][2] + v[j][3]);
    const float mean = wave_sum(s) * (1.f / D); float s2 = 0.f;
#pragma unroll
    for (int j = 0; j < 4; ++j) { v[j] = v[j] - mean; s2 += (v[j][0] * v[j][0] + v[j][1] * v[j][1]) + (v[j][2] * v[j][2] + v[j][3] * v[j][3]); }
    const float rstd = 1.f / sqrtf(wave_sum(s2) * (1.f / D) + LN_EPS);
#pragma unroll
    for (int j = 0; j < 4; ++j) { const f32x4 gg = *(const f32x4*)(g + 4 * lane + 256 * j), bb = *(const f32x4*)(b + 4 * lane + 256 * j); v[j] = v[j] * rstd * gg + bb; }
}
__device__ __forceinline__ void row_load(f32x4 (&v)[4], const float* p, int lane) {
#pragma unroll
    for (int j = 0; j < 4; ++j) v[j] = *(const f32x4*)(p + 4 * lane + 256 * j);
}
__device__ __forceinline__ void row_store(const f32x4 (&v)[4], float* p, bf16* pb, int lane) {
#pragma unroll
    for (int j = 0; j < 4; ++j) { *(f32x4*)(p + 4 * lane + 256 * j) = v[j]; store_bf4(pb + 4 * lane + 256 * j, v[j]); }
}
__device__ __forceinline__ void route_row(const f32x4 (&v)[4], const float* wr, int lane, int& e1, int& e2, float& w1, float& w2) {
    float lg[8];
#pragma unroll
    for (int e = 0; e < 8; ++e) lg[e] = 0.f;
#pragma unroll
    for (int j = 0; j < 4; ++j)
#pragma unroll
        for (int q = 0; q < 4; ++q) { const float* w = wr + (size_t)(4 * lane + 256 * j + q) * 8; const f32x4 wa = *(const f32x4*)w, wb = *(const f32x4*)(w + 4); const float x = v[j][q];
            lg[0] += x * wa[0]; lg[1] += x * wa[1]; lg[2] += x * wa[2]; lg[3] += x * wa[3]; lg[4] += x * wb[0]; lg[5] += x * wb[1]; lg[6] += x * wb[2]; lg[7] += x * wb[3]; }
#pragma unroll
    for (int e = 0; e < 8; ++e) lg[e] = wave_sum(lg[e]);
    int a = 0; float la = lg[0];
#pragma unroll
    for (int e = 1; e < 8; ++e) if (lg[e] > la) { la = lg[e]; a = e; }
    int b = -1; float lb = -3.0e38f;
#pragma unroll
    for (int e = 0; e < 8; ++e) if (e != a && lg[e] > lb) { lb = lg[e]; b = e; }
    const float t = __expf(lb - la);
    e1 = a; e2 = b; w1 = 1.f / (1.f + t); w2 = t / (1.f + t);
}

constexpr int MX_QIN = 0, MX_KIN = 33792, MX_P = 67584, MX_OB = 84224, MX_VT = 100608  ;
constexpr int MX_GA = 133376, MX_SEG = 137472  , MX_DEC = 139520  , MX_END = 140032;
static_assert(MX_END <= MISC_OFF, "mixer LDS below the MISC words");
struct MixArgs {
    bf16* QK; bf16* V; const float* GA;
    bf16* mQK; bf16* mV; const float* mGA; bf16* mO;
    const float* wa2; const float* ba; const float* gng; const float* rng; const float* rnb;
};
__device__ __forceinline__ void mixer_phase(const Frame& F, const MixArgs& a) {
    LAS float* qin = (LAS float*)(F.lds + MX_QIN); LAS float* kin = (LAS float*)(F.lds + MX_KIN); LAS float* P = (LAS float*)(F.lds + MX_P);
    LAS float* ob = (LAS float*)(F.lds + MX_OB); LAS bf16* vt = (LAS bf16*)(F.lds + MX_VT); LAS float* bc = (LAS float*)(F.lds + MX_P);
    LAS float* gab = (LAS float*)(F.lds + MX_GA); LAS float* seg = (LAS float*)(F.lds + MX_SEG); LAS float* dec = (LAS float*)(F.lds + MX_DEC);
    const int tid = F.tid, lane = F.lane, wave = F.wave, vv = tid & 255, dh = tid >> 8;
    for (int it = F.bid; it < NB * 8; it += F.G) {
        const int b = it >> 3, type = (it >> 2) & 1, head = it & 3;
        const int qcol = (type ? 1024 : 0) + head * 128, kcol = qcol + 512, vcol = type * 1024 + head * 256;
        const float lng = __logf(1.0f - exp2f(-5.0f - (float)head));
        float S[64];
#pragma unroll
        for (int i = 0; i < 64; ++i) S[i] = 0.f;
        const int gd = tid & 127, gi = tid >> 7;
        float wa[16]; float bad = 0.f;
        if (type == 0) {
#pragma unroll
            for (int r = 0; r < 16; ++r) wa[r] = a.wa2[r * 512 + head * 128 + gd];
            bad = a.ba[head * 128 + gd];
        } else {
#pragma unroll
            for (int r = 0; r < 16; ++r) wa[r] = 0.f;
        }
#pragma unroll 1
        for (int ch = -1; ch < 32; ++ch) {
            const bool meta = ch < 0;
            const bf16* qkb = meta ? a.mQK : a.QK + (size_t)(b * SEQ + ch * 64) * 2048;
            bf16* vb = meta ? a.mV : a.V + (size_t)(b * SEQ + ch * 64) * 2048;
            const float* gb = meta ? a.mGA : a.GA + (size_t)(b * SEQ + ch * 64) * 16;
            const int roff = meta ? 48 : 0;
            __syncthreads();
            for (int e = tid; e < 64 * 32; e += NTHR) {
                const int i = e >> 5, c4 = (e & 31) * 4; f32x4 q = (f32x4){0.f, 0.f, 0.f, 0.f}, k = q;
                if (i >= roff) { q = load_bf4(qkb + (size_t)(i - roff) * 2048 + qcol + c4); k = load_bf4(qkb + (size_t)(i - roff) * 2048 + kcol + c4); }
                *(LAS f32x4*)(qin + i * 132 + c4) = q; *(LAS f32x4*)(kin + i * 132 + c4) = k;
            }
            for (int e = tid; e < 64 * 64; e += NTHR) {
                const int i = e >> 6, c4 = (e & 63) * 4; u32x2 w; w.x = 0u; w.y = 0u;
                if (i >= roff) w = *(const u32x2*)(vb + (size_t)(i - roff) * 2048 + vcol + c4);
                *(LAS u32x2*)(vt + i * 256 + c4) = w;
            }
            if (type == 0) for (int e = tid; e < 64 * 16; e += NTHR) { const int i = e >> 4; gab[e] = (i >= roff) ? gb[(size_t)(i - roff) * 16 + (e & 15)] : 0.f; }
            __syncthreads();
            if (type == 0) {
                float run = 0.f;
#pragma unroll 4
                for (int ii = 0; ii < 16; ++ii) { const int i = gi * 16 + ii; float pre = bad;
#pragma unroll
                    for (int r = 0; r < 16; ++r) pre += gab[i * 16 + r] * wa[r];
                    const float ls = fminf(pre, 0.f) - log1pf(__expf(-fabsf(pre)));
                    run += (i >= roff) ? ls * (1.0f / 16.0f) : 0.f; bc[i * 128 + gd] = run; }
                seg[gi * 128 + gd] = run;
                __syncthreads();
                float off = 0.f;
#pragma unroll
                for (int g = 0; g < 4; ++g) off += (g < gi) ? seg[g * 128 + gd] : 0.f;
                if (gi == 3) dec[gd] = __expf(off + run);
#pragma unroll 4
                for (int ii = 0; ii < 16; ++ii) { const int i = gi * 16 + ii; const float bb = bc[i * 128 + gd] + off;
                    qin[i * 132 + gd] *= __expf(bb); kin[i * 132 + gd] *= __expf(-bb); }
            } else {
#pragma unroll 4
                for (int ii = 0; ii < 16; ++ii) { const int i = gi * 16 + ii; const float bb = (float)(i + 1) * lng;
                    qin[i * 132 + gd] *= __expf(bb); kin[i * 132 + gd] *= __expf(-bb); }
                if (gi == 3) dec[gd] = __expf(64.0f * lng);
            }
            __syncthreads();
            {
                const int i = tid >> 3, j0 = (tid & 7) * 8; float sc[8];
#pragma unroll
                for (int jj = 0; jj < 8; ++jj) sc[jj] = 0.f;
                for (int d4 = 0; d4 < 128; d4 += 4) { const f32x4 q = *(const LAS f32x4*)(qin + i * 132 + d4);
#pragma unroll
                    for (int jj = 0; jj < 8; ++jj) { const f32x4 k = *(const LAS f32x4*)(kin + (j0 + jj) * 132 + d4); sc[jj] += (q[0] * k[0] + q[1] * k[1]) + (q[2] * k[2] + q[3] * k[3]); } }
                __syncthreads();
#pragma unroll
                for (int jj = 0; jj < 8; ++jj) P[i * 65 + j0 + jj] = (j0 + jj <= i) ? sc[jj] : 0.f;
            }
            __syncthreads();
#pragma unroll 1
            for (int p = 0; p < 8; ++p) {
#pragma unroll 1
                for (int ii = 0; ii < 8; ++ii) { const int i = p * 8 + ii; float s = 0.f;
#pragma unroll
                    for (int d4 = 0; d4 < 64; d4 += 4) { const f32x4 q = *(const LAS f32x4*)(qin + i * 132 + dh * 64 + d4); s += (q[0] * S[d4] + q[1] * S[d4 + 1]) + (q[2] * S[d4 + 2] + q[3] * S[d4 + 3]); }
                    const int jlo = dh ? (i >> 1) + 1 : 0, jhi = dh ? i : (i >> 1);
                    for (int j = jlo; j <= jhi; ++j) s += P[i * 65 + j] * bf2f(vt[j * 256 + vv]);
                    ob[(dh * 8 + ii) * 256 + vv] = s; }
                __syncthreads();
                {
                    const int ii = wave, i = p * 8 + ii;
                    const f32x4 o = *(const LAS f32x4*)(ob + ii * 256 + lane * 4) + *(const LAS f32x4*)(ob + (8 + ii) * 256 + lane * 4);
                    f32x4 y;
                    if (type == 0) {
                        const float ss = wave_sum((o[0] * o[0] + o[1] * o[1]) + (o[2] * o[2] + o[3] * o[3]));
                        const float rs = 1.0f / sqrtf(ss * (1.0f / 256.0f) + LN_EPS);
                        const f32x4 g = *(const f32x4*)(a.gng + lane * 4); y = o * rs * g;
                    } else {
                        const float mu = wave_sum((o[0] + o[1]) + (o[2] + o[3])) * (1.0f / 256.0f); const f32x4 dd = o - mu;
                        const float var = wave_sum((dd[0] * dd[0] + dd[1] * dd[1]) + (dd[2] * dd[2] + dd[3] * dd[3])) * (1.0f / 256.0f);
                        const float rs = 1.0f / sqrtf(var + GN_EPS);
                        const f32x4 g = *(const f32x4*)(a.rng + head * 256 + lane * 4), bb = *(const f32x4*)(a.rnb + head * 256 + lane * 4); y = dd * rs * g + bb;
                    }
                    if (i >= roff && (!meta || b == 0)) store_bf4((meta ? a.mO : vb) + (size_t)(i - roff) * 2048 + vcol + lane * 4, y);
                }
                __syncthreads();
            }
#pragma unroll 1
            for (int j = 0; j < 64; ++j) { const float vj = bf2f(vt[j * 256 + vv]);
#pragma unroll
                for (int d4 = 0; d4 < 64; d4 += 4) { const f32x4 k = *(const LAS f32x4*)(kin + j * 132 + dh * 64 + d4); S[d4] += k[0] * vj; S[d4 + 1] += k[1] * vj; S[d4 + 2] += k[2] * vj; S[d4 + 3] += k[3] * vj; } }
#pragma unroll
            for (int d4 = 0; d4 < 64; d4 += 4) { const f32x4 dc = *(const LAS f32x4*)(dec + dh * 64 + d4); S[d4] *= dc[0]; S[d4 + 1] *= dc[1]; S[d4 + 2] *= dc[2]; S[d4 + 3] *= dc[3]; }
        }
    }
    __syncthreads();
}

typedef const __attribute__((address_space(4))) Args* KArgs;
__device__ __forceinline__ KArgs kargs() { KArgs p = (KArgs)__builtin_amdgcn_kernarg_segment_ptr(); asm volatile("" : "+s"(p)); return p; }
#define ENV() \
    KArgs A_ = kargs(); \
    Frame F; { int t_ = threadIdx.x; asm volatile("" : "+v"(t_)); int b_ = blockIdx.x; asm volatile("" : "+s"(b_)); \
        { LAS unsigned char* l_ = (LAS unsigned char*)lds_raw; asm volatile("" : "+s"(l_)); F.lds = l_; } F.MISC = (volatile LAS unsigned*)(F.lds + MISC_OFF); F.tid = t_; F.lane = t_ & 63; F.wave = __builtin_amdgcn_readfirstlane(t_ >> 6); \
        F.G = gridDim.x; F.bid = b_; F.gtid = b_ * NTHR + t_; F.gthreads = F.G * NTHR; F.gwave = b_ * NWAVES + F.wave; F.gwaves = F.G * NWAVES; F.ws = A_->ws; F.ctl = (unsigned*)(A_->ws + WS_CTL); } \
    unsigned char* ws = A_->ws; typedef const float* cfp_; const __attribute__((address_space(4))) cfp_* in = A_->in; \
    float* XA = (float*)(ws + WS_XA); float* XB = A_->out; bf16* XBF = (bf16*)(ws + WS_XBF); \
    bf16* QK = (bf16*)(ws + WS_QK); bf16* V = (bf16*)(ws + WS_V); float* GA = (float*)(ws + WS_GA); \
    bf16* MRG = QK; bf16* U = QK; const f32x2* rope = (const f32x2*)(ws + WS_ROPE); \
    unsigned char* mt = ws + WS_META; \
    float* mHA = (float*)(mt + MT_HA); float* mHB = (float*)(mt + MT_HB); bf16* mXB = (bf16*)(mt + MT_XB); bf16* mQK = (bf16*)(mt + MT_QK); bf16* mV = (bf16*)(mt + MT_V); \
    bf16* mSIG = (bf16*)(mt + MT_SIG); float* mGA = (float*)(mt + MT_GA); bf16* mMRG = (bf16*)(mt + MT_MRG); bf16* mU = (bf16*)(mt + MT_U); float* mY = (float*)(mt + MT_Y); \
    bf16* mO = (bf16*)(mt + MT_O); int* mTokE = (int*)(mt + MT_TOK); float* mTokW = (float*)(mt + MT_TOK + 128); \
    int* perm = (int*)(ws + WS_MOE); int* tok_slot = (int*)(ws + WS_MOE + 2 * MiB); float* tok_w = (float*)(ws + WS_MOE + 2 * MiB + 512 * 1024); \
    const bf16* B1t = (const bf16*)(ws + WS_W + W_B1); const bf16* B2t = (const bf16*)(ws + WS_W + W_B2); const bf16* PAt = (const bf16*)(ws + WS_W + W_PA); \
    const bf16* PBt = (const bf16*)(ws + WS_W + W_PB); const bf16* Ot = (const bf16*)(ws + WS_W + W_O); const bf16* FGU = (const bf16*)(ws + WS_W + W_F); \
    const bf16* FDd = (const bf16*)(ws + WS_W + W_FD_DENSE); const bf16* FDm = (const bf16*)(ws + WS_W + W_FD_MOE); \
    const float* hin = (l == 0) ? in[I_X] : (l == 1 ? XB : XA); float* x1buf = (l < 2) ? XA : XB; float* x2buf = (l == 0) ? XB : XA; \
    bf16* SIG = (bf16*)x1buf; bf16* Y = (bf16*)((l == 1) ? XB : XA); \
    const float* mhin = (l == 0) ? in[I_META] : (l == 1 ? mHB : mHA); float* mx1 = (l < 2) ? mHA : mHB; float* mx2 = (l == 0) ? mHB : mHA; \
    (void)XA; (void)XB; (void)XBF; (void)QK; (void)V; (void)GA; (void)MRG; (void)U; (void)rope; (void)mHA; (void)mHB; (void)mXB; (void)mQK; (void)mV; (void)mSIG; (void)mGA; (void)mMRG; (void)mU; (void)mY; \
    (void)mO; (void)mTokE; (void)mTokW; (void)perm; (void)tok_slot; (void)tok_w; (void)B1t; (void)B2t; (void)PAt; (void)PBt; (void)Ot; (void)FGU; (void)FDd; (void)FDm; (void)hin; (void)x1buf; (void)x2buf; \
    (void)SIG; (void)Y; (void)mhin; (void)mx1; (void)mx2; (void)in

__global__ void __launch_bounds__(NTHR, 2) fwd_kernel(Args args) {
    extern __shared__ __attribute__((aligned(16))) unsigned char lds_raw[];
    const int lo = args.ph_lo, hi = args.ph_hi;
    const bool multi = (hi - lo) > 1;
    {
        volatile LAS unsigned* MISC0 = (volatile LAS unsigned*)((LAS unsigned char*)lds_raw + MISC_OFF);
        for (int u = threadIdx.x; u < 256; u += NTHR) MISC0[u] = 0u;
        __syncthreads();
        if (multi) (void)xcd_barrier_post((unsigned*)(args.ws + WS_CTL) + CW_BAR, MISC0);
    }
#ifndef PH_MASK
#define PH_MASK 0xFFF
#endif
#define INS(slot, k) ((((PH_MASK) >> (slot)) & 1) && lo <= (k) && (k) < hi)
#define IN(k) (lo <= (k) && (k) < hi)
#define SEAM(k) do { if (IN(k) && IN((k) + 1)) { KArgs B_ = kargs(); XcdBarrier bar; bar.bar = (unsigned*)(B_->ws + WS_CTL) + CW_BAR; bar.x = xb_xcc_id(); \
        bar.st = (volatile LAS unsigned*)((LAS unsigned char*)lds_raw + MISC_OFF); xcd_barrier(bar); } } while (0)

    for (int l = 0; l < DEPTH; ++l) {
        const int pb = l * NPH;
        if (hi <= pb || lo >= pb + NPH) continue;
        const bool moe = (l & 1) != 0; const int l2 = l >> 1;
        if (INS(0, pb + 0)) { ENV();
            int rot = 0;
            const float* win = in[I_WIN] + (size_t)l * D * NIN;
            cvt_job(F, rot, win, nullptr, 1, 0, NIN, 0, D, N1, (bf16*)B1t);
            cvt_job(F, rot, win, nullptr, 2, 0, NIN, 0, D, 2048, (bf16*)B2t);
            cvt_job(F, rot, in[I_WPA] + (size_t)l * D * D, nullptr, 0, 0, D, 0, D, D, (bf16*)PAt);
            cvt_job(F, rot, in[I_WPB] + (size_t)l * D * D, nullptr, 0, 0, D, 0, D, D, (bf16*)PBt);
            cvt_job(F, rot, in[I_WO] + (size_t)l * D * D, nullptr, 0, 0, D, 0, D, D, (bf16*)Ot);
            if (!moe) {
                cvt_job(F, rot, in[I_FG] + (size_t)l2 * D * DFF, in[I_FU] + (size_t)l2 * D * DFF, 3, 0, DFF, 0, D, 2 * DFF, (bf16*)FGU);
                cvt_job(F, rot, in[I_FD] + (size_t)l2 * DFF * D, nullptr, 0, 0, D, 0, DFF, D, (bf16*)FDd);
            } else {
                for (int e = 0; e < NEXP; ++e)
                    for (int hf = 0; hf < 2; ++hf) {
                        const float* wg = in[I_MG] + ((size_t)l2 * NEXP + e) * D * DFFE; const float* wu = in[I_MU] + ((size_t)l2 * NEXP + e) * D * DFFE;
                        cvt_job(F, rot, wg, wu, 3, hf * HFF, DFFE, 0, D, DFFE, (bf16*)FGU + (size_t)(e * 2 + hf) * DFFE * D);
                        cvt_job(F, rot, in[I_MD] + ((size_t)l2 * NEXP + e) * DFFE * D, nullptr, 0, 0, D, hf * HFF, HFF, D, (bf16*)FDm + (size_t)(e * 2 + hf) * D * HFF);
                    }
                if (F.gtid < NEXP) F.ctl[CW_CNT + 64 * F.gtid] = 0u;
            }
            if (l == 0) {
                for (int i = F.gtid; i < 2064 * 64; i += F.gthreads) { const int pos = i >> 6, k = i & 63; const float inv = powf(10000.0f, -(float)k / 64.0f); const float ang = (float)pos * inv;
                    float sn, cs; sincosf(ang, &sn, &cs); ((f32x2*)rope)[i] = (f32x2){cs, sn}; }
                const float* x = in[I_X];
                for (size_t i = (size_t)F.gtid * 4; i < (size_t)M * D; i += (size_t)F.gthreads * 4) store_bf4(XBF + i, *(const f32x4*)(x + i));
                for (int i = F.gtid * 4; i < NMETA * D; i += F.gthreads * 4) store_bf4(mXB + i, *(const f32x4*)(in[I_META] + i));
            }
        }
        SEAM(pb + 0);

        if (INS(1, pb + 1)) { ENV();
            const float* bg = in[I_BGATE] + (size_t)l * 2 * D;
            { F1 f{mQK, mV, mSIG, mGA, rope, bg, 15, 0};
              naive_gemm(F, NMETA, N1, D, [=](int r) { return mXB + (size_t)r * D; }, [=](int, int c) { return B1t + (size_t)c * D; }, f); }
            pg8::SchedDense S; S.init(M, N1, F.G, F.bid, XBF, D * 2, B1t, D * 2);
            pg8::EpiEl<F1> E{F1{QK, V, SIG, GA, rope, bg, 2047, 16}};
            pg8::gemm_phase<pg8::EpiEl<F1>, pg8::SchedDense>(F.lds, F.tid, S, E, D, D * 2, D * 2);
        }
        SEAM(pb + 1);

        if (INS(2, pb + 2)) { ENV();
            MixArgs ma{QK, V, GA, mQK, mV, mGA, mO, in[I_WA2] + (size_t)l * 16 * 512, in[I_BA] + (size_t)l * 512, in[I_GNG] + (size_t)l * 256,
                       in[I_RNG] + (size_t)l * 1024, in[I_RNB] + (size_t)l * 1024};
            mixer_phase(F, ma);
        }
        SEAM(pb + 2);

        if (INS(3, pb + 3)) { ENV();
            { F2 f{mO, mV}; naive_gemm(F, NMETA, 2048, D, [=](int r) { return mXB + (size_t)r * D; }, [=](int, int c) { return B2t + (size_t)c * D; }, f); }
            pg8::SchedDense S; S.init(M, 2048, F.G, F.bid, XBF, D * 2, B2t, D * 2);
            pg8::EpiEl<F2> E{F2{V, V}};
            pg8::gemm_phase<pg8::EpiEl<F2>, pg8::SchedDense>(F.lds, F.tid, S, E, D, D * 2, D * 2);
        }
        SEAM(pb + 3);

        if (INS(4, pb + 4)) { ENV();
#pragma unroll 1
            for (int pass = 0; pass < 2; ++pass) {
                const bf16* Wt = pass ? PBt : PAt;
                { F3 f{mMRG, mSIG, pass}; const bf16* mA = mV + pass * 1024; naive_gemm(F, NMETA, D, D, [=](int r) { return mA + (size_t)r * 2048; }, [=](int, int c) { return Wt + (size_t)c * D; }, f); }
                pg8::SchedDense S; S.init(M, D, F.G, F.bid, V + pass * 1024, 2048 * 2, Wt, D * 2);
                pg8::EpiEl<F3> E{F3{MRG, SIG, pass}};
                pg8::gemm_phase<pg8::EpiEl<F3>, pg8::SchedDense>(F.lds, F.tid, S, E, D, 2048 * 2, D * 2);
            }
        }
        SEAM(pb + 4);

        if (INS(5, pb + 5)) { ENV();
            { F4 f{mhin, mx1}; naive_gemm(F, NMETA, D, D, [=](int r) { return mMRG + (size_t)r * D; }, [=](int, int c) { return Ot + (size_t)c * D; }, f); }
            pg8::SchedDense S; S.init(M, D, F.G, F.bid, MRG, D * 2, Ot, D * 2);
            pg8::EpiEl<F4> E{F4{hin, x1buf}};
            pg8::gemm_phase<pg8::EpiEl<F4>, pg8::SchedDense>(F.lds, F.tid, S, E, D, D * 2, D * 2);
        }
        SEAM(pb + 5);

        if (INS(6, pb + 6)) { ENV();
            const float* g = in[I_LN1G] + (size_t)l * D; const float* bb = in[I_LN1B] + (size_t)l * D;
            const float* wrt = in[I_RT] + (size_t)l2 * D * NEXP;
            for (int r = F.gwave; r < M + NMETA; r += F.gwaves) {
                const bool ism = r >= M; const int rr = ism ? r - M : r;
                float* p = ism ? mx1 + (size_t)rr * D : x1buf + (size_t)rr * D; bf16* pbf = ism ? mXB + (size_t)rr * D : XBF + (size_t)rr * D;
                f32x4 v[4]; row_load(v, p, F.lane); ln_vals(v, g, bb, F.lane); row_store(v, p, pbf, F.lane);
                if (moe) {
                    int e1, e2; float w1, w2; route_row(v, wrt, F.lane, e1, e2, w1, w2);
                    if (F.lane == 0) {
                        if (ism) { mTokE[rr * 2] = e1; mTokE[rr * 2 + 1] = e2; mTokW[rr * 2] = w1; mTokW[rr * 2 + 1] = w2; }
                        else {
                            const unsigned r1 = atomicAdd(F.ctl + CW_CNT + 64 * e1, 1u), r2 = atomicAdd(F.ctl + CW_CNT + 64 * e2, 1u);
                            perm[e1 * M + (int)r1] = rr; perm[e2 * M + (int)r2] = rr;
                            tok_slot[rr * 2] = (e1 << 16) | (int)r1; tok_slot[rr * 2 + 1] = (e2 << 16) | (int)r2; tok_w[rr * 2] = w1; tok_w[rr * 2 + 1] = w2;
                        }
                    }
                }
            }
        }
        SEAM(pb + 6);

        if (!moe) {
            if (INS(7, pb + 7)) { ENV();
                { F5 f{mU, DFF}; naive_gemm(F, NMETA, 2 * DFF, D, [=](int r) { return mXB + (size_t)r * D; }, [=](int, int c) { return FGU + (size_t)c * D; }, f); }
                pg8::SchedDense S; S.init(M, 2 * DFF, F.G, F.bid, XBF, D * 2, FGU, D * 2);
                pg8::EpiEl<F5> E{F5{U, DFF}};
                pg8::gemm_phase<pg8::EpiEl<F5>, pg8::SchedDense>(F.lds, F.tid, S, E, D, D * 2, D * 2);
            }
            SEAM(pb + 7);
            if (INS(8, pb + 8)) { ENV();
                { F4 f{mx1, mx2}; naive_gemm(F, NMETA, D, DFF, [=](int r) { return mU + (size_t)r * DFF; }, [=](int, int c) { return FDd + (size_t)c * DFF; }, f); }
                pg8::SchedDense S; S.init(M, D, F.G, F.bid, U, DFF * 2, FDd, DFF * 2);
                pg8::EpiEl<F4> E{F4{x1buf, x2buf}};
                pg8::gemm_phase<pg8::EpiEl<F4>, pg8::SchedDense>(F.lds, F.tid, S, E, DFF, DFF * 2, DFF * 2);
            }
            SEAM(pb + 8);
            SEAM(pb + 9);
            SEAM(pb + 10);
            if (INS(11, pb + 11)) { ENV();
                const float* g = in[I_LN2G] + (size_t)l * D; const float* bb = in[I_LN2B] + (size_t)l * D;
                for (int r = F.gwave; r < M + NMETA; r += F.gwaves) {
                    const bool ism = r >= M; const int rr = ism ? r - M : r;
                    float* p = ism ? mx2 + (size_t)rr * D : x2buf + (size_t)rr * D; bf16* pbf = ism ? mXB + (size_t)rr * D : XBF + (size_t)rr * D;
                    f32x4 v[4]; row_load(v, p, F.lane); ln_vals(v, g, bb, F.lane); row_store(v, p, pbf, F.lane);
                }
            }
            SEAM(pb + 11);
        } else {
            if (lo <= pb + 11 && hi > pb + 7) { ENV();
                if (F.tid == 0) {
                    unsigned ts = 0, cb = 0;
                    for (int e = 0; e < NEXP; ++e) { const unsigned c = __hip_atomic_load(F.ctl + CW_CNT + 64 * e, __ATOMIC_RELAXED, __HIP_MEMORY_SCOPE_AGENT);
                        F.MISC[16 + e] = c; F.MISC[24 + e] = ts; F.MISC[40 + e] = cb; ts += (c + 255u) >> 8; cb += c; }
                    F.MISC[32] = ts;
                }
                __syncthreads();
            }
#pragma unroll 1
            for (int hf = 0; hf < 2; ++hf) {
                if (INS(9, pb + 7 + 2 * hf)) { ENV();
                    { F5 f{mU, HFF};
                      naive_gemm(F, 2 * NMETA, 2 * HFF, D, [=](int r) { return mXB + (size_t)(r >> 1) * D; },
                                 [=](int r, int c) { return FGU + ((size_t)(mTokE[r] * 2 + hf) * DFFE + c) * D; }, f); }
                    SchedMoeUp S{F.MISC, perm, (const char*)XBF, (const char*)FGU, F.G, F.bid, hf};
                    pg8::EpiEl<F5> E{F5{U, HFF}};
                    pg8::gemm_phase<pg8::EpiEl<F5>, SchedMoeUp>(F.lds, F.tid, S, E, D, D * 2, D * 2);
                }
                SEAM(pb + 7 + 2 * hf);
                if (INS(10, pb + 8 + 2 * hf)) { ENV();
                    { F6Mm f{mY, hf};
                      naive_gemm(F, 2 * NMETA, D, HFF, [=](int r) { return mU + (size_t)r * HFF; },
                                 [=](int r, int c) { return FDm + ((size_t)(mTokE[r] * 2 + hf) * D + c) * HFF; }, f); }
                    SchedMoeDown S{F.MISC, (const char*)U, (const char*)FDm, F.G, F.bid, hf};
                    pg8::EpiEl<F6M> E{F6M{Y, hf}};
                    pg8::gemm_phase<pg8::EpiEl<F6M>, SchedMoeDown>(F.lds, F.tid, S, E, HFF, HFF * 2, HFF * 2);
                }
                SEAM(pb + 8 + 2 * hf);
            }
            if (INS(11, pb + 11)) { ENV();
                const float* g = in[I_LN2G] + (size_t)l * D; const float* bb = in[I_LN2B] + (size_t)l * D;
                for (int r = F.gwave; r < M + NMETA; r += F.gwaves) {
                    const bool ism = r >= M; const int rr = ism ? r - M : r;
                    float* p = ism ? mx1 + (size_t)rr * D : x1buf + (size_t)rr * D; bf16* pbf = ism ? mXB + (size_t)rr * D : XBF + (size_t)rr * D;
                    f32x4 v[4]; row_load(v, p, F.lane);
                    if (ism) {
                        const float w1 = mTokW[rr * 2], w2 = mTokW[rr * 2 + 1];
#pragma unroll
                        for (int j = 0; j < 4; ++j) { const f32x4 y1 = *(const f32x4*)(mY + (size_t)(rr * 2) * D + 4 * F.lane + 256 * j), y2 = *(const f32x4*)(mY + (size_t)(rr * 2 + 1) * D + 4 * F.lane + 256 * j);
                            v[j] = v[j] * ALPHA + y1 * w1 + y2 * w2; }
                    } else {
                        const int s1 = tok_slot[rr * 2], s2 = tok_slot[rr * 2 + 1]; const float w1 = tok_w[rr * 2], w2 = tok_w[rr * 2 + 1];
                        const size_t y1r = (size_t)F.MISC[40 + (s1 >> 16)] + (size_t)(s1 & 0xffff), y2r = (size_t)F.MISC[40 + (s2 >> 16)] + (size_t)(s2 & 0xffff);
#pragma unroll
                        for (int j = 0; j < 4; ++j) { const f32x4 y1 = load_bf4(Y + y1r * D + 4 * F.lane + 256 * j), y2 = load_bf4(Y + y2r * D + 4 * F.lane + 256 * j);
                            v[j] = v[j] * ALPHA + y1 * w1 + y2 * w2; }
                    }
                    ln_vals(v, g, bb, F.lane); row_store(v, p, pbf, F.lane);
                }
            }
            SEAM(pb + 11);
        }
    }
#undef IN
#undef SEAM
}

extern "C" void kernel_launch(void* const* d_in, const int* in_sizes, int n_in, void* d_out, int out_size, void* d_ws, size_t ws_size, hipStream_t stream) {
    static int grid = 0;
    if (grid == 0) {
        if (n_in != 23 || in_sizes[0] != M * D || out_size != M * D || ws_size < WS_END) { fprintf(stderr, "kernel_launch: unexpected shapes / workspace (%d inputs, ws %zu)\n", n_in, ws_size); grid = -1; return; }
        int dev = 0, cus = 0, per_cu = 0;
        if (hipGetDevice(&dev) != hipSuccess || hipDeviceGetAttribute(&cus, hipDeviceAttributeMultiprocessorCount, dev) != hipSuccess) { grid = -1; return; }
        if (hipFuncSetAttribute((const void*)fwd_kernel, hipFuncAttributeMaxDynamicSharedMemorySize, LDS_BYTES) != hipSuccess) { fprintf(stderr, "kernel_launch: hipFuncSetAttribute failed\n"); grid = -1; return; }
        if (hipOccupancyMaxActiveBlocksPerMultiprocessor(&per_cu, (const void*)fwd_kernel, NTHR, LDS_BYTES) != hipSuccess || per_cu < 1) fprintf(stderr, "kernel_launch: occupancy query says %d\n", per_cu);
        (void)hipGetLastError();
        grid = cus;
    }
    if (grid < 0) return;
    if (hipMemsetAsync((char*)d_ws + WS_CTL, 0, CTL_ZERO_BYTES, stream) != hipSuccess) return;
    Args a{};
    for (int i = 0; i < 23; ++i) a.in[i] = (const float*)d_in[i];
    a.out = (float*)d_out; a.ws = (unsigned char*)d_ws;
#if N_LAUNCH_MODE == 1
    a.ph_lo = 0; a.ph_hi = NPHASES;
    hipLaunchKernelGGL(fwd_kernel, dim3(grid), dim3(NTHR), LDS_BYTES, stream, a);
#else
    for (int p = 0; p < NPHASES; ++p) {
        const int l = p / NPH, s = p % NPH;
        if ((l & 1) == 0 && (s == 9 || s == 10)) continue;
        a.ph_lo = p; a.ph_hi = p + 1;
        hipLaunchKernelGGL(fwd_kernel, dim3(grid), dim3(NTHR), LDS_BYTES, stream, a);
    }
#endif
}
```

```cpp
#include <hip/hip_runtime.h>
#include <cstdio>
#include <cstdint>

#ifndef N_LAUNCH_MODE
#define N_LAUNCH_MODE 1
#endif

#ifndef MIXER_FAST
#define MIXER_FAST 1
#endif
#ifndef PROBE_DUP
#define PROBE_DUP 0
#endif
#define LAS __attribute__((address_space(3)))
typedef unsigned short bf16;
typedef short bf16x8 __attribute__((ext_vector_type(8)));
typedef float f32x4 __attribute__((ext_vector_type(4)));
typedef float f32x2 __attribute__((ext_vector_type(2)));
typedef unsigned u32x4 __attribute__((ext_vector_type(4)));
typedef unsigned u32x2 __attribute__((ext_vector_type(2)));

constexpr int D = 1024, NB = 32, SEQ = 2048, DEPTH = 4, NMETA = 16;
constexpr int M = NB * SEQ;
constexpr int NIN = 8208;
constexpr int N1 = 6400;
constexpr int DFF = 2816, DFFE = 3584, NEXP = 8, HFF = 1792;
constexpr float ALPHA = 1.681792830507429f;
constexpr float QSCALE = 0.08838834764831845f;
constexpr float LN_EPS = 1e-5f, GN_EPS = 1e-6f;
constexpr int NPH = 12;
constexpr int NPHASES = DEPTH * NPH;

constexpr size_t MiB = 1u << 20;
constexpr size_t WS_CTL = 0, CTL_ZERO_BYTES = 1 * MiB;
constexpr size_t WS_ROPE = 1 * MiB;
constexpr size_t WS_META = 3 * MiB;
constexpr size_t WS_MOE = 4 * MiB;
constexpr size_t WS_GA = 8 * MiB;
constexpr size_t WS_W = 12 * MiB;
constexpr size_t WS_XA = 204 * MiB;
constexpr size_t WS_XBF = 460 * MiB;
constexpr size_t WS_QK = 588 * MiB;
constexpr size_t WS_V = 844 * MiB;
constexpr size_t WS_END = 1100 * MiB;
constexpr size_t W_B1 = 0;
constexpr size_t W_B2 = W_B1 + (size_t)N1 * D * 2;
constexpr size_t W_PA = W_B2 + (size_t)2048 * D * 2;
constexpr size_t W_PB = W_PA + (size_t)D * D * 2;
constexpr size_t W_O = W_PB + (size_t)D * D * 2;
constexpr size_t W_F = W_O + (size_t)D * D * 2;
constexpr size_t W_FD_DENSE = W_F + (size_t)2 * DFF * D * 2;
constexpr size_t W_FD_MOE = W_F + (size_t)NEXP * 2 * DFFE * D * 2;
static_assert(W_FD_MOE + (size_t)NEXP * 2 * D * HFF * 2 <= 192 * MiB, "weights fit");
constexpr size_t MT_HA = 0, MT_HB = 65536, MT_XB = 131072, MT_QK = 163840, MT_V = 229376, MT_SIG = 294912, MT_GA = 360448, MT_MRG = 364544,
                 MT_U = 397312  , MT_Y = 512000  , MT_TOK = 643072  , MT_O = 644096  ;
static_assert(MT_O + 65536 <= MiB, "meta map");
constexpr int CW_CNT = 1024;
constexpr int CW_BAR = 4096;

constexpr int RING_BYTES = 131072;
constexpr int LDS_BYTES = 147456;
constexpr int MISC_OFF = LDS_BYTES - 1024;
constexpr int NWAVES = 8, NTHR = 512;

__device__ __forceinline__ unsigned f2bf(float f) { unsigned u = __builtin_bit_cast(unsigned, f); return (u + 0x7fffu + ((u >> 16) & 1u)) >> 16; }
__device__ __forceinline__ float bf2f(unsigned h) { return __builtin_bit_cast(float, (h & 0xffffu) << 16); }
__device__ __forceinline__ unsigned pk2(float lo, float hi) { return f2bf(lo) | (f2bf(hi) << 16); }
__device__ __forceinline__ void store_bf4(bf16* p, f32x4 v) { u32x2 w; w.x = pk2(v[0], v[1]); w.y = pk2(v[2], v[3]); *(u32x2*)p = w; }
__device__ __forceinline__ f32x4 load_bf4(const bf16* p) { const u32x2 w = *(const u32x2*)p; return (f32x4){bf2f(w.x), bf2f(w.x >> 16), bf2f(w.y), bf2f(w.y >> 16)}; }
__device__ __forceinline__ float sigmoidf_(float x) { return 1.0f / (1.0f + __expf(-x)); }
__device__ __forceinline__ float siluf_(float x) { return x / (1.0f + __expf(-x)); }
__device__ __forceinline__ float wave_sum(float v) {
#pragma unroll
    for (int o = 1; o < 64; o <<= 1) v += __shfl_xor(v, o);
    return v;
}
#define LDS_WAIT() asm volatile("s_waitcnt lgkmcnt(0)" ::: "memory")
#define VM_WAIT() asm volatile("s_waitcnt vmcnt(0)" ::: "memory")

namespace pg8 {
constexpr int BM = 256, BK = 64, HALF = 128, HTB = HALF * BK * 2, STAGE_BYTES = 8 * HTB, NXCD = 8, WGM = 8;
__host__ __device__ __forceinline__ int lds_byte(int r, int c) { const int st = (r >> 4) * 2 + (c >> 5), rr = r & 15, cc = c & 31, ob = rr * 64 + cc * 2; return st * 1024 + (ob ^ (((ob >> 9) & 1) << 5)); }
__host__ __device__ __forceinline__ void stage_rc(int b, int& R, int& C) { const int st = b / 1024, sb = b % 1024, swz = sb ^ (((sb >> 9) & 1) << 5); R = (st >> 1) * 16 + swz / 64; C = (st & 1) * 32 + (swz % 64) / 2; }

struct Unit { const char* A; const char* B; int row0, col0, e, nvalid; };

struct SchedDense {
    static constexpr bool GATHER = false;
    int nM, nN, nwg, G, c; const char* A; const char* Bt; unsigned lda, ldb;
    __device__ void init(int Mr, int Nc, int G_, int c_, const void* A_, unsigned lda_, const void* Bt_, unsigned ldb_) { nM = Mr / BM; nN = Nc / BM; nwg = nM * nN; G = G_; c = c_; A = (const char*)A_; Bt = (const char*)Bt_; lda = lda_; ldb = ldb_; }
    __device__ bool next(int i, Unit& u) const {
        const long L = (long)i * G + c; if (L >= nwg) return false;
        int wgid = (int)L; { const int q = nwg / NXCD, r = nwg % NXCD, xcd = wgid % NXCD, off = wgid / NXCD; wgid = (xcd < r ? xcd * (q + 1) : r * (q + 1) + (xcd - r) * q) + off; }
        const int nig = WGM * nN, gid = wgid / nig, fm = gid * WGM, gsz = (nM - fm) < WGM ? (nM - fm) : WGM;
        const int pm = fm + ((wgid % nig) % gsz), pn = (wgid % nig) / gsz;
        u.A = A + (size_t)pm * BM * lda; u.B = Bt + (size_t)pn * BM * ldb; u.row0 = pm * BM; u.col0 = pn * BM; u.e = 0; u.nvalid = BM; return true;
    }
    __device__ __forceinline__ unsigned a_off(const Unit&, int R, int h) const { return (unsigned)(h * HALF + R) * lda; }
};

template <class F> struct EpiEl {
    F f;
    template <int MODE> __device__ __forceinline__ void loop(const f32x4 (&acc)[2][2][4][2], const Unit& u, int wr, int wc, int fr, int fq) const {
#pragma unroll
        for (int ai = 0; ai < 2; ++ai)
#pragma unroll
            for (int m = 0; m < 4; ++m) { const int r = ai * HALF + wr * 64 + m * 16 + fr;
#pragma unroll
                for (int bj = 0; bj < 2; ++bj)
#pragma unroll
                    for (int n = 0; n < 2; ++n) f.template at<MODE>(u, r, bj * HALF + wc * 32 + n * 16 + 4 * fq, acc[ai][bj][m][n]);
                asm volatile("" ::: "memory"); }
    }
    __device__ __forceinline__ void operator()(const f32x4 (&acc)[2][2][4][2], const Unit& u, int wr, int wc, int fr, int fq) const {
        if constexpr (F::NMODES == 1) loop<0>(acc, u, wr, wc, fr, fq);
        else {
            const int mode = __builtin_amdgcn_readfirstlane(f.mode(u));
            if (mode == 0) loop<0>(acc, u, wr, wc, fr, fq);
            else if (mode == 1) loop<1>(acc, u, wr, wc, fr, fq);
            else if (mode == 2) loop<2>(acc, u, wr, wc, fr, fq);
            else if (mode == 3) loop<3>(acc, u, wr, wc, fr, fq);
            else loop<4>(acc, u, wr, wc, fr, fq);
        }
    }
};

template <class Epi, class Sched, bool ALIGN_EPI = true>
__device__ __forceinline__ void gemm_phase(LAS unsigned char* lds, const int tid, const Sched& S, const Epi& E, const int K, const unsigned lda, const unsigned ldb) {
    const int wid = __builtin_amdgcn_readfirstlane(tid >> 6), lane = tid & 63, wr = wid >> 2, wc = wid & 3, fr = lane & 15, fq = lane >> 4;
    const int nt = K / BK;
    int Rr[2], Cc[2]; unsigned voffA[2], voffB[2];
#pragma unroll
    for (int i = 0; i < 2; ++i) { int R, C; stage_rc(tid * 16 + i * 8192, R, C); Rr[i] = R; Cc[i] = C; voffA[i] = (unsigned)R * lda + (unsigned)C * 2u; voffB[i] = (unsigned)R * ldb + (unsigned)C * 2u; }
    const size_t kstep = (size_t)(BK * 2);
    const size_t hstepA = (size_t)HALF * lda, hstepB = (size_t)HALF * ldb;
    const unsigned ldsw = (unsigned)wid * 1024u;
    const int aoff = lds_byte(wr * 64 + fr, fq * 8), boff = lds_byte(wc * 32 + fr, fq * 8);
#define PG8_SA(b, h) (((b) * 2 + (h)) * HTB)
#define PG8_SB(b, h) ((4 + (b) * 2 + (h)) * HTB)
#define PG8_STAGE_B(bufoff, gbase) do { _Pragma("unroll") for (int _i = 0; _i < 2; ++_i) \
        __builtin_amdgcn_global_load_lds((const unsigned*)((const char*)(gbase) + voffB[_i]), (LAS unsigned*)(lds + (bufoff) + ldsw + _i * 8192), 16, 0, 0); } while (0)
#define PG8_STAGE_A(bufoff, gbase, h, ox) do { _Pragma("unroll") for (int _i = 0; _i < 2; ++_i) { \
        const char* _p = Sched::GATHER ? ((const char*)(gbase) + (ox)[h][_i]) : ((const char*)(gbase) + (h) * hstepA + voffA[_i]); \
        __builtin_amdgcn_global_load_lds((const unsigned*)_p, (LAS unsigned*)(lds + (bufoff) + ldsw + _i * 8192), 16, 0, 0); } } while (0)
#define PG8_LDA(dst, b, h) do { _Pragma("unroll") for (int m = 0; m < 4; ++m) _Pragma("unroll") for (int k = 0; k < 2; ++k) dst[m][k] = *(const LAS bf16x8*)(lds + PG8_SA(b, h) + aoff + m * 2048 + k * 1024); } while (0)
#define PG8_LDB(dst, b, h) do { _Pragma("unroll") for (int n = 0; n < 2; ++n) _Pragma("unroll") for (int k = 0; k < 2; ++k) dst[n][k] = *(const LAS bf16x8*)(lds + PG8_SB(b, h) + boff + n * 2048 + k * 1024); } while (0)
#define PG8_MMA(ai, bj, At, Bt) do { __builtin_amdgcn_s_setprio(1); _Pragma("unroll") for (int m = 0; m < 4; ++m) _Pragma("unroll") for (int n = 0; n < 2; ++n) _Pragma("unroll") for (int k = 0; k < 2; ++k) \
        acc[ai][bj][m][n] = __builtin_amdgcn_mfma_f32_16x16x32_bf16(Bt[n][k], At[m][k], acc[ai][bj][m][n], 0, 0, 0); __builtin_amdgcn_s_setprio(0); } while (0)
#define PG8_WAIT_V(n) asm volatile("s_waitcnt vmcnt(" #n ")" ::: "memory")
#define PG8_WAIT_L(n) asm volatile("s_waitcnt lgkmcnt(" #n ")" ::: "memory")
#define PG8_BAR __builtin_amdgcn_s_barrier()
#define PG8_SCHED __builtin_amdgcn_sched_barrier(0)
    Unit cur, nxt; int ui = 0;
    if (!S.next(0, cur)) return;
    f32x4 acc[2][2][4][2];
#pragma unroll
    for (int a = 0; a < 2; ++a)
#pragma unroll
        for (int b = 0; b < 2; ++b)
#pragma unroll
            for (int m = 0; m < 4; ++m)
#pragma unroll
                for (int n = 0; n < 2; ++n) acc[a][b][m][n] = (f32x4){0.f, 0.f, 0.f, 0.f};
    bf16x8 At[4][2], B0[2][2], B1[2][2];
    unsigned oc[2][2];
#pragma unroll
    for (int h = 0; h < 2; ++h)
#pragma unroll
        for (int i = 0; i < 2; ++i) oc[h][i] = Sched::GATHER ? (S.a_off(cur, Rr[i], h) + (unsigned)Cc[i] * 2u) : 0u;
    const char* cA = cur.A; const char* cB = cur.B;
    PG8_STAGE_B(PG8_SB(0, 0), cB); PG8_STAGE_B(PG8_SB(0, 1), cB + hstepB); PG8_STAGE_A(PG8_SA(0, 0), cA, 0, oc); PG8_STAGE_A(PG8_SA(0, 1), cA, 1, oc);
    if (wr == 1) PG8_BAR;
    PG8_WAIT_V(2); PG8_BAR;
    PG8_STAGE_B(PG8_SB(1, 0), cB + kstep); PG8_STAGE_A(PG8_SA(1, 0), cA + kstep, 0, oc); PG8_STAGE_B(PG8_SB(1, 1), cB + hstepB + kstep);
    PG8_WAIT_V(6); PG8_BAR;
    for (;;) {
        const bool has_next = S.next(ui + 1, nxt);
        const char* nA = has_next ? nxt.A : cA; const char* nB = has_next ? nxt.B : cB;
        for (int t = 0; t < nt; t += 2) {
            const bool last = (t == nt - 2);
            const char* a1 = cA + (size_t)(t + 1) * kstep;
            const char* a2 = last ? nA : cA + (size_t)(t + 2) * kstep; const char* b2 = last ? nB : cB + (size_t)(t + 2) * kstep;
            const char* a3 = a2 + kstep; const char* b3 = b2 + kstep;
            PG8_LDB(B0, 0, 0); PG8_LDB(B1, 0, 1); PG8_SCHED; PG8_LDA(At, 0, 0); PG8_STAGE_A(PG8_SA(1, 1), a1, 1, oc);
            if constexpr (Sched::GATHER) { if (last && has_next) {
#pragma unroll
                for (int h = 0; h < 2; ++h)
#pragma unroll
                    for (int i = 0; i < 2; ++i) oc[h][i] = S.a_off(nxt, Rr[i], h) + (unsigned)Cc[i] * 2u; } }
            PG8_WAIT_V(8); PG8_WAIT_L(0); PG8_BAR; PG8_MMA(0, 0, At, B0); PG8_MMA(0, 1, At, B1); PG8_BAR; PG8_SCHED;
            PG8_LDA(At, 0, 1); PG8_STAGE_B(PG8_SB(0, 0), b2); PG8_STAGE_B(PG8_SB(0, 1), b2 + hstepB); PG8_STAGE_A(PG8_SA(0, 0), a2, 0, oc);
            PG8_WAIT_V(8); PG8_WAIT_L(0); PG8_BAR; PG8_MMA(1, 0, At, B0); PG8_MMA(1, 1, At, B1); PG8_BAR; PG8_SCHED;
            PG8_LDB(B0, 1, 0); PG8_LDB(B1, 1, 1); PG8_SCHED; PG8_LDA(At, 1, 0); PG8_STAGE_A(PG8_SA(0, 1), a2, 1, oc);
            PG8_WAIT_V(8); PG8_WAIT_L(0); PG8_BAR; PG8_MMA(0, 0, At, B0); PG8_MMA(0, 1, At, B1); PG8_BAR; PG8_SCHED;
            PG8_LDA(At, 1, 1); PG8_STAGE_B(PG8_SB(1, 0), b3); PG8_STAGE_B(PG8_SB(1, 1), b3 + hstepB); PG8_STAGE_A(PG8_SA(1, 0), a3, 0, oc);
            PG8_WAIT_V(8); PG8_WAIT_L(0); PG8_BAR; PG8_MMA(1, 0, At, B0); PG8_MMA(1, 1, At, B1); PG8_BAR; PG8_SCHED;
        }
        if constexpr (ALIGN_EPI) { if (wr == 0) PG8_BAR; }
        E(acc, cur, wr, wc, fr, fq);
        if (!has_next) break;
#pragma unroll
        for (int a = 0; a < 2; ++a)
#pragma unroll
            for (int b = 0; b < 2; ++b)
#pragma unroll
                for (int m = 0; m < 4; ++m)
#pragma unroll
                    for (int n = 0; n < 2; ++n) acc[a][b][m][n] = (f32x4){0.f, 0.f, 0.f, 0.f};
        cur = nxt; cA = nA; cB = nB; ++ui;
        if constexpr (ALIGN_EPI) { if (wr == 1) PG8_BAR; }
    }
    PG8_WAIT_V(0);
    if constexpr (!ALIGN_EPI) { if (wr == 0) PG8_BAR; }
    PG8_BAR;
#undef PG8_SA
#undef PG8_SB
#undef PG8_STAGE_A
#undef PG8_STAGE_B
#undef PG8_LDA
#undef PG8_LDB
#undef PG8_MMA
#undef PG8_WAIT_V
#undef PG8_WAIT_L
#undef PG8_BAR
#undef PG8_SCHED
}
}

#define XB_TMO      128
#define XB_XCNT(j)  (256  + 64 * (j))
#define XB_XSUB(j)  (1280 + 64 * (j))
#define XB_XGEN(j)  (2304 + 64 * (j))
#define XB_TOP      3328
#define XB_TOPGEN   3392
#define XCD_BAR_WORDS 3456
#define XB_SPIN_CAP (1u << 18)
__device__ __forceinline__ unsigned xb_ld(unsigned* p)              { return __hip_atomic_load(p, __ATOMIC_RELAXED, __HIP_MEMORY_SCOPE_AGENT); }
__device__ __forceinline__ unsigned xb_add(unsigned* p, unsigned v) { return __hip_atomic_fetch_add(p, v, __ATOMIC_RELAXED, __HIP_MEMORY_SCOPE_AGENT); }
__device__ __forceinline__ unsigned xb_xcc_id() { return (unsigned)__builtin_amdgcn_s_getreg((3 << 11) | 20) & 0xFu; }
#define XB_SPIN(cond, bar) do { unsigned _sp = 0; while (cond) { __builtin_amdgcn_s_sleep(1); \
    if ((++_sp & 255u) == 0u) { if (xb_ld(&(bar)[XB_TMO])) break; if (_sp > XB_SPIN_CAP) { atomicAdd(&(bar)[XB_TMO], 1u); break; } } } } while (0)
struct XcdBarrier { unsigned* bar; unsigned x; volatile LAS unsigned* st; };
__device__ __forceinline__ XcdBarrier xcd_barrier_post(unsigned* bar, volatile LAS unsigned* st) {
    XcdBarrier b; b.bar = bar; b.x = xb_xcc_id(); b.st = st;
    if (threadIdx.x == 0) (void)xb_add(&bar[XB_XCNT(b.x)], 1u);
    return b;
}
__device__ __forceinline__ void xcd_barrier_complete(unsigned* bar, unsigned x, unsigned& nloc, unsigned& nx) {
    const unsigned G = gridDim.x * gridDim.y * gridDim.z;
    unsigned sum, cnt, mine, sp = 0u;
    for (;;) {
        sum = 0u; cnt = 0u; mine = 0u;
#pragma unroll
        for (unsigned j = 0; j < 16; ++j) { const unsigned c = xb_ld(&bar[XB_XCNT(j)]); sum += c; cnt += (c > 0u) ? 1u : 0u; mine = (j == x) ? c : mine; }
        if (sum == G) break;
        __builtin_amdgcn_s_sleep(1);
        if ((++sp & 255u) == 0u) { if (xb_ld(&bar[XB_TMO])) break; if (sp > XB_SPIN_CAP) { atomicAdd(&bar[XB_TMO], 1u); break; } }
    }
    nloc = mine > 0u ? mine : 1u; nx = cnt > 0u ? cnt : 1u;
}
__device__ __forceinline__ void xcd_barrier(const XcdBarrier& b) {
    asm volatile("s_waitcnt vmcnt(0)" ::: "memory");
    __syncthreads();
    if (threadIdx.x == 0) {
        unsigned* bar = b.bar;
        __builtin_amdgcn_s_waitcnt(0);
        unsigned nloc = b.st[0], nx = b.st[1];
        if (nloc == 0u) { xcd_barrier_complete(bar, b.x, nloc, nx); b.st[0] = nloc; b.st[1] = nx; }
        const unsigned old = xb_add(&bar[XB_XSUB(b.x)], 1u);
        const unsigned gen = old / nloc;
        if (old + 1u == (gen + 1u) * nloc) {
            __builtin_amdgcn_fence(__ATOMIC_RELEASE, "agent");
            asm volatile("s_waitcnt vmcnt(0)" ::: "memory");
            const unsigned og = xb_add(&bar[XB_TOP], 1u);
            const unsigned tg = og / nx;
            if (og + 1u == (tg + 1u) * nx) xb_add(&bar[XB_TOPGEN], 1u);
            else XB_SPIN(xb_ld(&bar[XB_TOPGEN]) == tg, bar);
            __builtin_amdgcn_fence(__ATOMIC_ACQUIRE, "agent");
            xb_add(&bar[XB_XGEN(b.x)], 1u);
            asm volatile("s_waitcnt vmcnt(0)" ::: "memory");
        } else {
            XB_SPIN(xb_ld(&bar[XB_XGEN(b.x)]) == gen, bar);
            __builtin_amdgcn_fence(__ATOMIC_ACQUIRE, "agent");
            asm volatile("s_waitcnt vmcnt(0)" ::: "memory");
        }
    }
    __syncthreads();
}

struct Args { const float* in[23]; float* out; unsigned char* ws; int ph_lo, ph_hi; };
enum { I_X = 0, I_META, I_WIN, I_BGATE, I_WA2, I_BA, I_GNG, I_RNG, I_RNB, I_WPA, I_WPB, I_WO, I_LN1G, I_LN1B, I_FG, I_FU, I_FD, I_RT, I_MG, I_MU, I_MD, I_LN2G, I_LN2B };

struct Frame {
    LAS unsigned char* lds; volatile LAS unsigned* MISC; unsigned* ctl;
    int tid, lane, wave, G, bid, gtid, gthreads, gwave, gwaves;
    unsigned char* ws;
};

template <class AR, class BR, class F>
__device__ __forceinline__ void naive_gemm(const Frame& Fr, int nrows, int ncols, int K, AR arow, BR brow, F f) {
    const int nc4 = ncols >> 2;
#pragma unroll 1
    for (int rep = (PROBE_DUP & 1) ? 0 : 1; rep < 2; ++rep)
    for (int idx = Fr.gtid; idx < nrows * nc4; idx += Fr.gthreads) {
        const int row = idx / nc4, c0 = (idx % nc4) * 4;
        const bf16* a = arow(row);
        f32x4 acc = (f32x4){0.f, 0.f, 0.f, 0.f};
#pragma unroll
        for (int j = 0; j < 4; ++j) {
            const bf16* b = brow(row, c0 + j);
            float s = 0.f;
            for (int k = 0; k < K; k += 8) {
                const u32x4 av = *(const u32x4*)(a + k), bv = *(const u32x4*)(b + k);
                s += bf2f(av.x) * bf2f(bv.x) + bf2f(av.x >> 16) * bf2f(bv.x >> 16) + bf2f(av.y) * bf2f(bv.y) + bf2f(av.y >> 16) * bf2f(bv.y >> 16)
                   + bf2f(av.z) * bf2f(bv.z) + bf2f(av.z >> 16) * bf2f(bv.z >> 16) + bf2f(av.w) * bf2f(bv.w) + bf2f(av.w >> 16) * bf2f(bv.w >> 16);
            }
            acc[j] = s;
        }
        if (rep == 0) { if (acc[0] + acc[1] + acc[2] + acc[3] == 1.2345678e30f) *(f32x4*)(Fr.ws + WS_META + MT_Y) = acc; continue; }
        pg8::Unit u; u.A = nullptr; u.B = nullptr; u.row0 = 0; u.col0 = c0 & ~255; u.e = 0; u.nvalid = nrows;
        const int cc = c0 & 255;
        if constexpr (F::NMODES == 1) f.template at<0>(u, row, cc, acc);
        else { const int mode = f.mode(u);
            if (mode == 0) f.template at<0>(u, row, cc, acc); else if (mode == 1) f.template at<1>(u, row, cc, acc); else if (mode == 2) f.template at<2>(u, row, cc, acc);
            else if (mode == 3) f.template at<3>(u, row, cc, acc); else f.template at<4>(u, row, cc, acc); }
    }
}

struct F1 {
    static constexpr int NMODES = 5;
    bf16* QK; bf16* V; bf16* SIG; float* GA; const f32x2* rope; const float* bg; int posmask, posbase;
    __device__ __forceinline__ int mode(const pg8::Unit& u) const { const int c = u.col0; return c < 1024 ? 0 : (c < 2048 ? 1 : (c < 4096 ? 2 : (c < 6144 ? 3 : 4))); }
    template <int MODE> __device__ __forceinline__ void at(const pg8::Unit& u, int r, int c, f32x4 v) const {
        const int row = u.row0 + r, col = u.col0 + c;
        if (MODE == 0) { const float s = col < 512 ? QSCALE : 1.f; store_bf4(QK + (size_t)row * 2048 + col, v * s); }
        else if (MODE == 1) {
            const int j = (col - 1024) & 127, pos = (row & posmask) + posbase; const f32x2 c0 = rope[pos * 64 + (j >> 1)], c1 = rope[pos * 64 + (j >> 1) + 1];
            const float s = col >= 1536 ? QSCALE : 1.f;
            f32x4 o; o[0] = (v[0] * c0.x - v[1] * c0.y) * s; o[1] = (v[0] * c0.y + v[1] * c0.x) * s; o[2] = (v[2] * c1.x - v[3] * c1.y) * s; o[3] = (v[2] * c1.y + v[3] * c1.x) * s;
            store_bf4(QK + (size_t)row * 2048 + col, o);
        }
        else if (MODE == 2) store_bf4(V + (size_t)row * 2048 + (col - 2048), v);
        else if (MODE == 3) { const int cc = col - 4096; const f32x4 b = *(const f32x4*)(bg + cc);
            f32x4 o; o[0] = sigmoidf_(v[0] + b[0]); o[1] = sigmoidf_(v[1] + b[1]); o[2] = sigmoidf_(v[2] + b[2]); o[3] = sigmoidf_(v[3] + b[3]);
            store_bf4(SIG + (size_t)row * 2048 + cc, o); }
        else { if (col < 6160) *(f32x4*)(GA + (size_t)row * 16 + (col - 6144)) = v; }
    }
};
struct F2 {
    static constexpr int NMODES = 1;
    const bf16* O; bf16* V;
    template <int MODE> __device__ __forceinline__ void at(const pg8::Unit& u, int r, int c, f32x4 v) const {
        const size_t off = (size_t)(u.row0 + r) * 2048 + u.col0 + c; bf16* p = V + off; const f32x4 o = load_bf4(O + off);
        f32x4 w; w[0] = siluf_(v[0]) * o[0]; w[1] = siluf_(v[1]) * o[1]; w[2] = siluf_(v[2]) * o[2]; w[3] = siluf_(v[3]) * o[3];
        store_bf4(p, w);
    }
};
struct F3 {
    static constexpr int NMODES = 1;
    bf16* MRG; const bf16* SIG; int second;
    template <int MODE> __device__ __forceinline__ void at(const pg8::Unit& u, int r, int c, f32x4 v) const {
        const int row = u.row0 + r, col = u.col0 + c; bf16* p = MRG + (size_t)row * 1024 + col;
        const f32x4 g = load_bf4(SIG + (size_t)row * 2048 + second * 1024 + col); f32x4 o = g * v;
        if (second) o = o + load_bf4(p);
        store_bf4(p, o);
    }
};
struct F4 {
    static constexpr int NMODES = 1;
    const float* RES; float* OUT;
    template <int MODE> __device__ __forceinline__ void at(const pg8::Unit& u, int r, int c, f32x4 v) const {
        const size_t o = (size_t)(u.row0 + r) * 1024 + u.col0 + c; const f32x4 h = *(const f32x4*)(RES + o);
        *(f32x4*)(OUT + o) = h * ALPHA + v;
    }
};
struct F5 {
    static constexpr int NMODES = 1;
    bf16* U; int ldu;
    template <int MODE> __device__ __forceinline__ void at(const pg8::Unit& u, int r, int c, f32x4 v) const {
        bf16* p = U + (size_t)(u.row0 + r) * ldu + ((u.col0 + c) >> 1);
        *(unsigned*)p = pk2(siluf_(v[0]) * v[2], siluf_(v[1]) * v[3]);
    }
};
struct F6M {
    static constexpr int NMODES = 1;
    bf16* Y; int second;
    template <int MODE> __device__ __forceinline__ void at(const pg8::Unit& u, int r, int c, f32x4 v) const {
        if (r >= u.nvalid) return;
        bf16* p = Y + (size_t)(u.row0 + r) * 1024 + u.col0 + c;
        if (second) v = v + load_bf4(p);
        store_bf4(p, v);
    }
};
struct F6Mm {
    static constexpr int NMODES = 1;
    float* Y; int second;
    template <int MODE> __device__ __forceinline__ void at(const pg8::Unit& u, int r, int c, f32x4 v) const {
        float* p = Y + (size_t)r * 1024 + u.col0 + c;
        if (second) v = v + *(const f32x4*)p;
        *(f32x4*)p = v;
    }
};

struct SchedMoeUp {
    static constexpr bool GATHER = true;
    volatile LAS unsigned* T; const int* perm; const char* A; const char* W; int G, c, hf;
    __device__ bool next(int i, pg8::Unit& u) const {
        const int TT = (int)T[32]; const long L = (long)i * G + c; if (L >= (long)TT * 14) return false;
        const int gt = (int)(L / 14), pn = (int)(L % 14); int e = 0;
#pragma unroll
        for (int j = 1; j < 8; ++j) e += (gt >= (int)T[24 + j]) ? 1 : 0;
        u.A = A; u.B = W + ((size_t)(e * 2 + hf) * DFFE + (size_t)pn * 256) * (D * 2); u.row0 = gt * 256; u.col0 = pn * 256; u.e = e; u.nvalid = gt - (int)T[24 + e];
        return true;
    }
    __device__ __forceinline__ unsigned a_off(const pg8::Unit& u, int R, int h) const {
        const int rank = u.nvalid * 256 + h * 128 + R, cnt = (int)T[16 + u.e];
        const int tok = perm[u.e * M + (rank < cnt ? rank : 0)];
        return (unsigned)tok * (unsigned)(D * 2);
    }
};
struct SchedMoeDown {
    static constexpr bool GATHER = false;
    volatile LAS unsigned* T; const char* A; const char* W; int G, c, hf;
    __device__ bool next(int i, pg8::Unit& u) const {
        const int TT = (int)T[32]; const long L = (long)i * G + c; if (L >= (long)TT * 4) return false;
        const int gt = (int)(L / 4), pn = (int)(L % 4); int e = 0;
#pragma unroll
        for (int j = 1; j < 8; ++j) e += (gt >= (int)T[24 + j]) ? 1 : 0;
        const int ti = gt - (int)T[24 + e], cnt = (int)T[16 + e];
        u.A = A + (size_t)gt * 256 * (HFF * 2); u.B = W + ((size_t)(e * 2 + hf) * D + (size_t)pn * 256) * (HFF * 2);
        u.row0 = (int)T[40 + e] + ti * 256; u.col0 = pn * 256; u.e = e; u.nvalid = (cnt - ti * 256) < 256 ? (cnt - ti * 256) : 256;
        return true;
    }
    __device__ __forceinline__ unsigned a_off(const pg8::Unit&, int R, int h) const { return (unsigned)(h * 128 + R) * (unsigned)(HFF * 2); }
};

__device__ __forceinline__ int map_b1(int n) {
    if (n < 1024) return n;
    if (n < 2048) { const int t = n - 1024, blk = t >> 9, hh = (t >> 7) & 3, j = t & 127; return (blk ? 3600 : 3088) + hh * 128 + (j >> 1) + 64 * (j & 1); }
    if (n < 3072) return 1024 + (n - 2048);
    if (n < 4096) return 4112 + (n - 3072);
    if (n < 5120) return 6160 + (n - 4096);
    if (n < 6144) return 7184 + (n - 5120);
    if (n < 6160) return 3072 + (n - 6144);
    return -1;
}
__device__ __forceinline__ int map_b2(int n) { return n < 1024 ? 2048 + n : 5136 + (n - 1024); }
__device__ __forceinline__ void cvt_item(const float* W, const float* W2, int kind, int foff, int ldsrc, int koff, int K, bf16* WT, LAS float* scr, int item, int lane) {
    const int nkb = K / 64, nb = item / nkb, kb = item % nkb, k0 = 64 * kb, n0 = 32 * nb;
    const int n = n0 + (lane & 31);
    int col; const float* src = W;
    if (kind == 0) col = n; else if (kind == 1) col = map_b1(n); else if (kind == 2) col = map_b2(n);
    else { col = foff + 2 * (n >> 2) + (n & 1); if (n & 2) src = W2; }
#pragma unroll 8
    for (int i = 0; i < 32; ++i) { const int kk = 2 * i + (lane >> 5); scr[kk * 33 + (lane & 31)] = (col >= 0) ? src[(size_t)(koff + k0 + kk) * ldsrc + col] : 0.f; }
    LDS_WAIT(); asm volatile("" ::: "memory");
    const int c = lane & 7;
#pragma unroll
    for (int j = 0; j < 4; ++j) { const int nn = (lane >> 3) + 8 * j; const LAS float* s = scr + (8 * c) * 33 + nn;
        u32x4 o; o.x = pk2(s[0 * 33], s[1 * 33]); o.y = pk2(s[2 * 33], s[3 * 33]); o.z = pk2(s[4 * 33], s[5 * 33]); o.w = pk2(s[6 * 33], s[7 * 33]);
        *(u32x4*)(WT + (size_t)(n0 + nn) * K + k0 + 8 * c) = o; }
    LDS_WAIT(); asm volatile("" ::: "memory");
}
__device__ __forceinline__ void cvt_job(const Frame& F, int& rot, const float* W, const float* W2, int kind, int foff, int ldsrc, int koff, int K, int Nnew, bf16* WT) {
    LAS float* scr = (LAS float*)(F.lds + F.wave * 16384);
    const int items = (K / 64) * (Nnew / 32);
    int start = F.gwave - rot; if (start < 0) start += F.gwaves;
    for (int it = start; it < items; it += F.gwaves) cvt_item(W, W2, kind, foff, ldsrc, koff, K, WT, scr, it, F.lane);
    rot = (rot + items) % F.gwaves;
}

__device__ __forceinline__ void ln_vals(f32x4 (&v)[4], const float* g, const float* b, int lane) {
    float s = 0.f;
#pragma unroll
    for (int j = 0; j < 4; ++j) s += (v[j][0] + v[j][1]) + (v[j][2] + v[j][3]);
    const float mean = wave_sum(s) * (1.f / D); float s2 = 0.f;
#pragma unroll
    for (int j = 0; j < 4; ++j) { v[j] = v[j] - mean; s2 += (v[j][0] * v[j][0] + v[j][1] * v[j][1]) + (v[j][2] * v[j][2] + v[j][3] * v[j][3]); }
    const float rstd = 1.f / sqrtf(wave_sum(s2) * (1.f / D) + LN_EPS);
#pragma unroll
    for (int j = 0; j < 4; ++j) { const f32x4 gg = *(const f32x4*)(g + 4 * lane + 256 * j), bb = *(const f32x4*)(b + 4 * lane + 256 * j); v[j] = v[j] * rstd * gg + bb; }
}
__device__ __forceinline__ void row_load(f32x4 (&v)[4], const float* p, int lane) {
#pragma unroll
    for (int j = 0; j < 4; ++j) v[j] = *(const f32x4*)(p + 4 * lane + 256 * j);
}
__device__ __forceinline__ void row_store(const f32x4 (&v)[4], float* p, bf16* pb, int lane, int dry = 0) {
    if (dry) return;
#pragma unroll
    for (int j = 0; j < 4; ++j) { *(f32x4*)(p + 4 * lane + 256 * j) = v[j]; store_bf4(pb + 4 * lane + 256 * j, v[j]); }
}
__device__ __forceinline__ void route_row(const f32x4 (&v)[4], const float* wr, int lane, int& e1, int& e2, float& w1, float& w2) {
    float lg[8];
#pragma unroll
    for (int e = 0; e < 8; ++e) lg[e] = 0.f;
#pragma unroll
    for (int j = 0; j < 4; ++j)
#pragma unroll
        for (int q = 0; q < 4; ++q) { const float* w = wr + (size_t)(4 * lane + 256 * j + q) * 8; const f32x4 wa = *(const f32x4*)w, wb = *(const f32x4*)(w + 4); const float x = v[j][q];
            lg[0] += x * wa[0]; lg[1] += x * wa[1]; lg[2] += x * wa[2]; lg[3] += x * wa[3]; lg[4] += x * wb[0]; lg[5] += x * wb[1]; lg[6] += x * wb[2]; lg[7] += x * wb[3]; }
#pragma unroll
    for (int e = 0; e < 8; ++e) lg[e] = wave_sum(lg[e]);
    int a = 0; float la = lg[0];
#pragma unroll
    for (int e = 1; e < 8; ++e) if (lg[e] > la) { la = lg[e]; a = e; }
    int b = -1; float lb = -3.0e38f;
#pragma unroll
    for (int e = 0; e < 8; ++e) if (e != a && lg[e] > lb) { lb = lg[e]; b = e; }
    const float t = __expf(lb - la);
    e1 = a; e2 = b; w1 = 1.f / (1.f + t); w2 = t / (1.f + t);
}

constexpr int MX_QIN = 0, MX_KIN = 33792, MX_P = 67584, MX_OB = 84224, MX_VT = 100608  ;
constexpr int MX_GA = 133376, MX_SEG = 137472  , MX_DEC = 139520  , MX_END = 140032;
static_assert(MX_END <= MISC_OFF, "mixer LDS below the MISC words");
struct MixArgs {
    bf16* QK; bf16* V; const float* GA;
    bf16* mQK; bf16* mV; const float* mGA; bf16* mO;
    const float* wa2; const float* ba; const float* gng; const float* rng; const float* rnb;
    int dry;
};
__device__ __forceinline__ void mixer_phase(const Frame& F, const MixArgs& a) {
    LAS float* qin = (LAS float*)(F.lds + MX_QIN); LAS float* kin = (LAS float*)(F.lds + MX_KIN); LAS float* P = (LAS float*)(F.lds + MX_P);
    LAS float* ob = (LAS float*)(F.lds + MX_OB); LAS bf16* vt = (LAS bf16*)(F.lds + MX_VT); LAS float* bc = (LAS float*)(F.lds + MX_P);
    LAS float* gab = (LAS float*)(F.lds + MX_GA); LAS float* seg = (LAS float*)(F.lds + MX_SEG); LAS float* dec = (LAS float*)(F.lds + MX_DEC);
    const int tid = F.tid, lane = F.lane, wave = F.wave, vv = tid & 255, dh = tid >> 8;
    for (int it = F.bid; it < NB * 8; it += F.G) {
        const int b = it >> 3, type = (it >> 2) & 1, head = it & 3;
        const int qcol = (type ? 1024 : 0) + head * 128, kcol = qcol + 512, vcol = type * 1024 + head * 256;
        const float lng = __logf(1.0f - exp2f(-5.0f - (float)head));
        float S[64];
#pragma unroll
        for (int i = 0; i < 64; ++i) S[i] = 0.f;
        const int gd = tid & 127, gi = tid >> 7;
        float wa[16]; float bad = 0.f;
        if (type == 0) {
#pragma unroll
            for (int r = 0; r < 16; ++r) wa[r] = a.wa2[r * 512 + head * 128 + gd];
            bad = a.ba[head * 128 + gd];
        } else {
#pragma unroll
            for (int r = 0; r < 16; ++r) wa[r] = 0.f;
        }
#pragma unroll 1
        for (int ch = -1; ch < 32; ++ch) {
            const bool meta = ch < 0;
            const bf16* qkb = meta ? a.mQK : a.QK + (size_t)(b * SEQ + ch * 64) * 2048;
            bf16* vb = meta ? a.mV : a.V + (size_t)(b * SEQ + ch * 64) * 2048;
            const float* gb = meta ? a.mGA : a.GA + (size_t)(b * SEQ + ch * 64) * 16;
            const int roff = meta ? 48 : 0;
            __syncthreads();
            for (int e = tid; e < 64 * 32; e += NTHR) {
                const int i = e >> 5, c4 = (e & 31) * 4; f32x4 q = (f32x4){0.f, 0.f, 0.f, 0.f}, k = q;
                if (i >= roff) { q = load_bf4(qkb + (size_t)(i - roff) * 2048 + qcol + c4); k = load_bf4(qkb + (size_t)(i - roff) * 2048 + kcol + c4); }
                *(LAS f32x4*)(qin + i * 132 + c4) = q; *(LAS f32x4*)(kin + i * 132 + c4) = k;
            }
            for (int e = tid; e < 64 * 64; e += NTHR) {
                const int i = e >> 6, c4 = (e & 63) * 4; u32x2 w; w.x = 0u; w.y = 0u;
                if (i >= roff) w = *(const u32x2*)(vb + (size_t)(i - roff) * 2048 + vcol + c4);
                *(LAS u32x2*)(vt + i * 256 + c4) = w;
            }
            if (type == 0) for (int e = tid; e < 64 * 16; e += NTHR) { const int i = e >> 4; gab[e] = (i >= roff) ? gb[(size_t)(i - roff) * 16 + (e & 15)] : 0.f; }
            __syncthreads();
            if (type == 0) {
                float run = 0.f;
#pragma unroll 4
                for (int ii = 0; ii < 16; ++ii) { const int i = gi * 16 + ii; float pre = bad;
#pragma unroll
                    for (int r = 0; r < 16; ++r) pre += gab[i * 16 + r] * wa[r];
                    const float ls = fminf(pre, 0.f) - log1pf(__expf(-fabsf(pre)));
                    run += (i >= roff) ? ls * (1.0f / 16.0f) : 0.f; bc[i * 128 + gd] = run; }
                seg[gi * 128 + gd] = run;
                __syncthreads();
                float off = 0.f;
#pragma unroll
                for (int g = 0; g < 4; ++g) off += (g < gi) ? seg[g * 128 + gd] : 0.f;
                if (gi == 3) dec[gd] = __expf(off + run);
#pragma unroll 4
                for (int ii = 0; ii < 16; ++ii) { const int i = gi * 16 + ii; const float bb = bc[i * 128 + gd] + off;
                    qin[i * 132 + gd] *= __expf(bb); kin[i * 132 + gd] *= __expf(-bb); }
            } else {
#pragma unroll 4
                for (int ii = 0; ii < 16; ++ii) { const int i = gi * 16 + ii; const float bb = (float)(i + 1) * lng;
                    qin[i * 132 + gd] *= __expf(bb); kin[i * 132 + gd] *= __expf(-bb); }
                if (gi == 3) dec[gd] = __expf(64.0f * lng);
            }
            __syncthreads();
            {
                const int i = tid >> 3, j0 = (tid & 7) * 8; float sc[8];
#pragma unroll
                for (int jj = 0; jj < 8; ++jj) sc[jj] = 0.f;
                for (int d4 = 0; d4 < 128; d4 += 4) { const f32x4 q = *(const LAS f32x4*)(qin + i * 132 + d4);
#pragma unroll
                    for (int jj = 0; jj < 8; ++jj) { const f32x4 k = *(const LAS f32x4*)(kin + (j0 + jj) * 132 + d4); sc[jj] += (q[0] * k[0] + q[1] * k[1]) + (q[2] * k[2] + q[3] * k[3]); } }
                __syncthreads();
#pragma unroll
                for (int jj = 0; jj < 8; ++jj) P[i * 65 + j0 + jj] = (j0 + jj <= i) ? sc[jj] : 0.f;
            }
            __syncthreads();
#pragma unroll 1
            for (int p = 0; p < 8; ++p) {
#pragma unroll 1
                for (int ii = 0; ii < 8; ++ii) { const int i = p * 8 + ii; float s = 0.f;
#pragma unroll
                    for (int d4 = 0; d4 < 64; d4 += 4) { const f32x4 q = *(const LAS f32x4*)(qin + i * 132 + dh * 64 + d4); s += (q[0] * S[d4] + q[1] * S[d4 + 1]) + (q[2] * S[d4 + 2] + q[3] * S[d4 + 3]); }
                    const int jlo = dh ? (i >> 1) + 1 : 0, jhi = dh ? i : (i >> 1);
                    for (int j = jlo; j <= jhi; ++j) s += P[i * 65 + j] * bf2f(vt[j * 256 + vv]);
                    ob[(dh * 8 + ii) * 256 + vv] = s; }
                __syncthreads();
                {
                    const int ii = wave, i = p * 8 + ii;
                    const f32x4 o = *(const LAS f32x4*)(ob + ii * 256 + lane * 4) + *(const LAS f32x4*)(ob + (8 + ii) * 256 + lane * 4);
                    f32x4 y;
                    if (type == 0) {
                        const float ss = wave_sum((o[0] * o[0] + o[1] * o[1]) + (o[2] * o[2] + o[3] * o[3]));
                        const float rs = 1.0f / sqrtf(ss * (1.0f / 256.0f) + LN_EPS);
                        const f32x4 g = *(const f32x4*)(a.gng + lane * 4); y = o * rs * g;
                    } else {
                        const float mu = wave_sum((o[0] + o[1]) + (o[2] + o[3])) * (1.0f / 256.0f); const f32x4 dd = o - mu;
                        const float var = wave_sum((dd[0] * dd[0] + dd[1] * dd[1]) + (dd[2] * dd[2] + dd[3] * dd[3])) * (1.0f / 256.0f);
                        const float rs = 1.0f / sqrtf(var + GN_EPS);
                        const f32x4 g = *(const f32x4*)(a.rng + head * 256 + lane * 4), bb = *(const f32x4*)(a.rnb + head * 256 + lane * 4); y = dd * rs * g + bb;
                    }
                    if (i >= roff && (!meta || b == 0) && !a.dry) store_bf4((meta ? a.mO : vb) + (size_t)(i - roff) * 2048 + vcol + lane * 4, y);
                }
                __syncthreads();
            }
#pragma unroll 1
            for (int j = 0; j < 64; ++j) { const float vj = bf2f(vt[j * 256 + vv]);
#pragma unroll
                for (int d4 = 0; d4 < 64; d4 += 4) { const f32x4 k = *(const LAS f32x4*)(kin + j * 132 + dh * 64 + d4); S[d4] += k[0] * vj; S[d4 + 1] += k[1] * vj; S[d4 + 2] += k[2] * vj; S[d4 + 3] += k[3] * vj; } }
#pragma unroll
            for (int d4 = 0; d4 < 64; d4 += 4) { const f32x4 dc = *(const LAS f32x4*)(dec + dh * 64 + d4); S[d4] *= dc[0]; S[d4 + 1] *= dc[1]; S[d4 + 2] *= dc[2]; S[d4 + 3] *= dc[3]; }
        }
    }
    __syncthreads();
}

typedef float f32x16 __attribute__((ext_vector_type(16)));
typedef short s16x4 __attribute__((ext_vector_type(4)));
constexpr int QROW = 272, PROW = 144, KTROW = 144, OROWF = 260;
constexpr int FM_QIN = 0, FM_KIN = 17408, FM_PT = 34816, FM_KT = 44032  , FM_OT = 0  ,
              FM_VS = 66560  , FM_SEG = 99328, FM_DEC = 101376, FM_END = 101888;
static_assert(FM_KT + 128 * KTROW <= FM_VS && FM_END <= MISC_OFF, "fast mixer LDS map");
__device__ __forceinline__ bf16x8 pack8(float a0, float a1, float a2, float a3, float a4, float a5, float a6, float a7) {
    u32x4 p; p.x = pk2(a0, a1); p.y = pk2(a2, a3); p.z = pk2(a4, a5); p.w = pk2(a6, a7); return __builtin_bit_cast(bf16x8, p);
}
__device__ __forceinline__ void mixer_fast(const Frame& F, const MixArgs& a) {
    LAS unsigned char* L = F.lds;
    LAS float* seg = (LAS float*)(L + FM_SEG); LAS float* dec = (LAS float*)(L + FM_DEC); LAS float* ot = (LAS float*)(L + FM_OT);
    const int tid0 = F.tid, wave = F.wave;
    const int gi = __builtin_amdgcn_readfirstlane(tid0 >> 7);
    LAS unsigned char* slab = L + FM_VS + wave * 4096;
    for (int it = F.bid; it < NB * 8; it += F.G) {
        int tid = tid0; asm volatile("" : "+v"(tid));
        int lane = tid & 63, gd = tid & 127, l32 = lane & 31, hh = lane >> 5, l16 = lane & 15, quad = lane >> 4;
        const int b = it >> 3, type = (it >> 2) & 1, head = it & 3;
        const int qcol = (type ? 1024 : 0) + head * 128, kcol = qcol + 512, vcol = type * 1024 + head * 256;
        const float lng = __logf(1.0f - exp2f(-5.0f - (float)head));
        f32x16 S[4];
#pragma unroll
        for (int T = 0; T < 4; ++T)
#pragma unroll
            for (int r = 0; r < 16; ++r) S[T][r] = 0.f;
        unsigned qk[16];
        { const unsigned qoff = (unsigned)(qcol + gd) * 2u, koff = (unsigned)(kcol + gd) * 2u;
#pragma unroll
        for (int ii = 0; ii < 16; ++ii) qk[ii] = 0u;
        if (gi == 3) {
#pragma unroll
            for (int ii = 0; ii < 16; ++ii) { const char* rb = (const char*)a.mQK + (size_t)ii * 4096; qk[ii] = (unsigned)*(const bf16*)(rb + qoff) | ((unsigned)*(const bf16*)(rb + koff) << 16); }
        } }
        {
            const u32x4 z = (u32x4){0u, 0u, 0u, 0u};
#pragma unroll
            for (int j = 0; j < 3; ++j) *(LAS u32x4*)(slab + j * 1024 + lane * 16) = z;
            __builtin_amdgcn_global_load_lds((const unsigned*)(a.mV + (size_t)(lane >> 2) * 2048 + vcol + 32 * wave + 8 * (lane & 3)), (LAS unsigned*)(slab + 3 * 1024), 16, 0, 0);
        }
#pragma unroll 1
        for (int ch = -1; ch < 32; ++ch) {
            const bool meta = ch < 0;
            bf16* vb = meta ? a.mV : a.V + (size_t)(b * SEQ + ch * 64) * 2048;
            const float* gb = meta ? a.mGA : a.GA + (size_t)(b * SEQ + ch * 64) * 16;
            const int roff = meta ? 48 : 0;
            int gio = gi; asm volatile("" : "+s"(gio));
            tid = tid0; asm volatile("" : "+v"(tid));
            lane = tid & 63; gd = tid & 127; l32 = lane & 31; hh = lane >> 5; l16 = lane & 15; quad = lane >> 4;
            const unsigned qoff = (unsigned)(qcol + gd) * 2u, koff = (unsigned)(kcol + gd) * 2u;
            float bcs[16]; float run = 0.f;
            if (type == 0) {
                float wa[16]; const float bad = a.ba[head * 128 + gd];
#pragma unroll
                for (int r = 0; r < 16; ++r) wa[r] = a.wa2[r * 512 + head * 128 + gd];
#pragma unroll
                for (int ii = 0; ii < 16; ++ii) { const int c = gio * 16 + ii; float ls = 0.f;
                    if (c >= roff) { const float* gr = gb + (size_t)(c - roff) * 16; float pre = bad;
#pragma unroll
                        for (int r = 0; r < 16; ++r) pre += gr[r] * wa[r];
                        ls = (fminf(pre, 0.f) - log1pf(__expf(-fabsf(pre)))) * (1.0f / 16.0f); }
                    run += ls; bcs[ii] = run; }
                seg[gio * 128 + gd] = run;
            } else {
#pragma unroll
                for (int ii = 0; ii < 16; ++ii) bcs[ii] = (float)(gio * 16 + ii + 1) * lng;
            }
            __syncthreads();
            float off = 0.f;
            if (type == 0) {
#pragma unroll
                for (int g = 0; g < 4; ++g) off += (g < gio) ? seg[g * 128 + gd] : 0.f;
                if (gio == 3) dec[gd] = __expf(off + run);
            } else if (gio == 3) dec[gd] = __expf(64.0f * lng);
            {
                unsigned kt[8];
#pragma unroll
                for (int ii = 0; ii < 16; ++ii) { const int c = gio * 16 + ii; const float bb = bcs[ii] + off; const float eb = __expf(bb), en = __expf(-bb);
                    const unsigned qv = f2bf(bf2f(qk[ii]) * eb), kv = f2bf(bf2f(qk[ii] >> 16) * en);
                    *(LAS bf16*)(L + FM_QIN + c * QROW + gd * 2) = (bf16)qv; *(LAS bf16*)(L + FM_KIN + c * QROW + gd * 2) = (bf16)kv;
                    if (ii & 1) kt[ii >> 1] |= kv << 16; else kt[ii >> 1] = kv; }
                *(LAS u32x4*)(L + FM_KT + gd * KTROW + gio * 32) = (u32x4){kt[0], kt[1], kt[2], kt[3]};
                *(LAS u32x4*)(L + FM_KT + gd * KTROW + gio * 32 + 16) = (u32x4){kt[4], kt[5], kt[6], kt[7]};
            }
            __syncthreads();
#pragma unroll 1
            for (int tt = wave; tt < 10; tt += 8) {
                const int ti = (tt >= 6) ? 3 : (tt >= 3) ? 2 : (tt >= 1) ? 1 : 0, tj = tt - ti * (ti + 1) / 2;
                f32x4 pacc = (f32x4){0.f, 0.f, 0.f, 0.f};
#pragma unroll
                for (int ks = 0; ks < 4; ++ks) {
                    const bf16x8 A = *(const LAS bf16x8*)(L + FM_QIN + (16 * ti + l16) * QROW + (32 * ks + 8 * quad) * 2);
                    const bf16x8 B = *(const LAS bf16x8*)(L + FM_KIN + (16 * tj + l16) * QROW + (32 * ks + 8 * quad) * 2);
                    pacc = __builtin_amdgcn_mfma_f32_16x16x32_bf16(A, B, pacc, 0, 0, 0);
                }
#pragma unroll
                for (int jj = 0; jj < 4; ++jj) { const int row = 16 * ti + 4 * quad + jj, col = 16 * tj + l16;
                    *(LAS bf16*)(L + FM_PT + row * PROW + col * 2) = (bf16)f2bf((col > row) ? 0.f : pacc[jj]); }
            }
            if (wave == 2 || wave == 3) {
                const int ti = (wave == 2) ? 0 : 2, tj = ti + 1;
#pragma unroll
                for (int jj = 0; jj < 4; ++jj) *(LAS bf16*)(L + FM_PT + (16 * ti + 4 * quad + jj) * PROW + (16 * tj + l16) * 2) = (bf16)0;
            }
            if (ch < 31) { const bf16* nq = a.QK + (size_t)(b * SEQ + (ch + 1) * 64 + gi * 16) * 2048;
#pragma unroll
                for (int ii = 0; ii < 16; ++ii) { const char* rb = (const char*)nq + (size_t)ii * 4096; qk[ii] = (unsigned)*(const bf16*)(rb + qoff) | ((unsigned)*(const bf16*)(rb + koff) << 16); } }
            asm volatile("s_waitcnt vmcnt(0)" ::: "memory");
            __syncthreads();
            bf16x8 vf[4];
            {
                const unsigned base = (unsigned)(size_t)(slab + (8 * hh + (l16 >> 2)) * 64 + 32 * (quad & 1) + 8 * (l16 & 3));
                s16x4 t0, t1, t2, t3, t4, t5, t6, t7;
                asm volatile("ds_read_b64_tr_b16 %0, %8\n\tds_read_b64_tr_b16 %1, %8 offset:256\n\tds_read_b64_tr_b16 %2, %8 offset:1024\n\tds_read_b64_tr_b16 %3, %8 offset:1280\n\t"
                             "ds_read_b64_tr_b16 %4, %8 offset:2048\n\tds_read_b64_tr_b16 %5, %8 offset:2304\n\tds_read_b64_tr_b16 %6, %8 offset:3072\n\tds_read_b64_tr_b16 %7, %8 offset:3328\n\ts_waitcnt lgkmcnt(0)"
                             : "=&v"(t0), "=&v"(t1), "=&v"(t2), "=&v"(t3), "=&v"(t4), "=&v"(t5), "=&v"(t6), "=&v"(t7) : "v"(base) : "memory");
                vf[0] = (bf16x8){t0[0], t0[1], t0[2], t0[3], t1[0], t1[1], t1[2], t1[3]}; vf[1] = (bf16x8){t2[0], t2[1], t2[2], t2[3], t3[0], t3[1], t3[2], t3[3]};
                vf[2] = (bf16x8){t4[0], t4[1], t4[2], t4[3], t5[0], t5[1], t5[2], t5[3]}; vf[3] = (bf16x8){t6[0], t6[1], t6[2], t6[3], t7[0], t7[1], t7[2], t7[3]};
            }
            __builtin_amdgcn_sched_barrier(0);
            f32x16 O[2];
#pragma unroll
            for (int mt = 0; mt < 2; ++mt)
#pragma unroll
                for (int r = 0; r < 16; ++r) O[mt][r] = 0.f;
#pragma unroll
            for (int mt = 0; mt < 2; ++mt)
#pragma unroll
                for (int ks = 0; ks < 2 * mt + 2; ++ks) {
                    const bf16x8 A = *(const LAS bf16x8*)(L + FM_PT + (32 * mt + l32) * PROW + (16 * ks + 8 * hh) * 2);
                    O[mt] = __builtin_amdgcn_mfma_f32_32x32x16_bf16(A, vf[ks], O[mt], 0, 0, 0);
                }
#pragma unroll
            for (int T = 0; T < 4; ++T)
#pragma unroll
                for (int s2 = 0; s2 < 2; ++s2) {
                    const bf16x8 Bs = pack8(S[T][8 * s2], S[T][8 * s2 + 1], S[T][8 * s2 + 2], S[T][8 * s2 + 3], S[T][8 * s2 + 4], S[T][8 * s2 + 5], S[T][8 * s2 + 6], S[T][8 * s2 + 7]);
#pragma unroll
                    for (int mt = 0; mt < 2; ++mt) {
                        const LAS unsigned char* qp = L + FM_QIN + (32 * mt + l32) * QROW + (32 * T + 16 * s2 + 4 * hh) * 2;
                        const u32x2 lo = *(const LAS u32x2*)qp, hi = *(const LAS u32x2*)(qp + 16);
                        const bf16x8 A = __builtin_bit_cast(bf16x8, (u32x4){lo.x, lo.y, hi.x, hi.y});
                        O[mt] = __builtin_amdgcn_mfma_f32_32x32x16_bf16(A, Bs, O[mt], 0, 0, 0);
                    }
                    __builtin_amdgcn_sched_barrier(0);
                }
#pragma unroll
            for (int T = 0; T < 4; ++T) {
#pragma unroll
                for (int ks = 0; ks < 4; ++ks) {
                    const bf16x8 A = *(const LAS bf16x8*)(L + FM_KT + (32 * T + l32) * KTROW + (16 * ks + 8 * hh) * 2);
                    S[T] = __builtin_amdgcn_mfma_f32_32x32x16_bf16(A, vf[ks], S[T], 0, 0, 0);
                }
#pragma unroll
                for (int q4 = 0; q4 < 4; ++q4) { const f32x4 dc = *(const LAS f32x4*)(dec + 32 * T + 8 * q4 + 4 * hh);
                    S[T][4 * q4] *= dc[0]; S[T][4 * q4 + 1] *= dc[1]; S[T][4 * q4 + 2] *= dc[2]; S[T][4 * q4 + 3] *= dc[3]; }
                __builtin_amdgcn_sched_barrier(0);
            }
            if (ch < 31) { const bf16* nv = a.V + (size_t)(b * SEQ + (ch + 1) * 64) * 2048 + vcol + 32 * wave + 8 * (lane & 3);
                asm volatile("s_waitcnt lgkmcnt(0)" ::: "memory");
#pragma unroll
                for (int j = 0; j < 4; ++j) __builtin_amdgcn_global_load_lds((const unsigned*)(nv + (size_t)(16 * j + (lane >> 2)) * 2048), (LAS unsigned*)(slab + j * 1024), 16, 0, 0); }
            __syncthreads();
#pragma unroll
            for (int mt = 0; mt < 2; ++mt)
#pragma unroll
                for (int r = 0; r < 16; ++r) ot[(32 * mt + (r & 3) + 8 * (r >> 2) + 4 * hh) * OROWF + 32 * wave + l32] = O[mt][r];
            __syncthreads();
#pragma unroll 2
            for (int rr = 0; rr < 8; ++rr) {
                const int i = wave * 8 + rr;
                const f32x4 o = *(const LAS f32x4*)(ot + i * OROWF + lane * 4);
                f32x4 y;
                if (type == 0) {
                    const float ss = wave_sum((o[0] * o[0] + o[1] * o[1]) + (o[2] * o[2] + o[3] * o[3]));
                    const float rs = 1.0f / sqrtf(ss * (1.0f / 256.0f) + LN_EPS);
                    const f32x4 g = *(const f32x4*)(a.gng + lane * 4); y = o * rs * g;
                } else {
                    const float mu = wave_sum((o[0] + o[1]) + (o[2] + o[3])) * (1.0f / 256.0f); const f32x4 dd = o - mu;
                    const float var = wave_sum((dd[0] * dd[0] + dd[1] * dd[1]) + (dd[2] * dd[2] + dd[3] * dd[3])) * (1.0f / 256.0f);
                    const float rs = 1.0f / sqrtf(var + GN_EPS);
                    const f32x4 g = *(const f32x4*)(a.rng + head * 256 + lane * 4), bb = *(const f32x4*)(a.rnb + head * 256 + lane * 4); y = dd * rs * g + bb;
                }
                if (i >= roff && (!meta || b == 0) && !a.dry) store_bf4((meta ? a.mO : vb) + (size_t)(i - roff) * 2048 + vcol + lane * 4, y);
            }
        }
        __syncthreads();
    }
}

typedef const __attribute__((address_space(4))) Args* KArgs;
__device__ __forceinline__ KArgs kargs() { KArgs p = (KArgs)__builtin_amdgcn_kernarg_segment_ptr(); asm volatile("" : "+s"(p)); return p; }
#define ENV() \
    KArgs A_ = kargs(); \
    Frame F; { int t_ = threadIdx.x; asm volatile("" : "+v"(t_)); int b_ = blockIdx.x; asm volatile("" : "+s"(b_)); \
        { LAS unsigned char* l_ = (LAS unsigned char*)lds_raw; asm volatile("" : "+s"(l_)); F.lds = l_; } F.MISC = (volatile LAS unsigned*)(F.lds + MISC_OFF); F.tid = t_; F.lane = t_ & 63; F.wave = __builtin_amdgcn_readfirstlane(t_ >> 6); \
        F.G = gridDim.x; F.bid = b_; F.gtid = b_ * NTHR + t_; F.gthreads = F.G * NTHR; F.gwave = b_ * NWAVES + F.wave; F.gwaves = F.G * NWAVES; F.ws = A_->ws; F.ctl = (unsigned*)(A_->ws + WS_CTL); } \
    unsigned char* ws = A_->ws; typedef const float* cfp_; const __attribute__((address_space(4))) cfp_* in = A_->in; \
    float* XA = (float*)(ws + WS_XA); float* XB = A_->out; bf16* XBF = (bf16*)(ws + WS_XBF); \
    bf16* QK = (bf16*)(ws + WS_QK); bf16* V = (bf16*)(ws + WS_V); float* GA = (float*)(ws + WS_GA); \
    bf16* MRG = QK; bf16* U = QK; const f32x2* rope = (const f32x2*)(ws + WS_ROPE); \
    unsigned char* mt = ws + WS_META; \
    float* mHA = (float*)(mt + MT_HA); float* mHB = (float*)(mt + MT_HB); bf16* mXB = (bf16*)(mt + MT_XB); bf16* mQK = (bf16*)(mt + MT_QK); bf16* mV = (bf16*)(mt + MT_V); \
    bf16* mSIG = (bf16*)(mt + MT_SIG); float* mGA = (float*)(mt + MT_GA); bf16* mMRG = (bf16*)(mt + MT_MRG); bf16* mU = (bf16*)(mt + MT_U); float* mY = (float*)(mt + MT_Y); \
    bf16* mO = (bf16*)(mt + MT_O); int* mTokE = (int*)(mt + MT_TOK); float* mTokW = (float*)(mt + MT_TOK + 128); \
    int* perm = (int*)(ws + WS_MOE); int* tok_slot = (int*)(ws + WS_MOE + 2 * MiB); float* tok_w = (float*)(ws + WS_MOE + 2 * MiB + 512 * 1024); \
    const bf16* B1t = (const bf16*)(ws + WS_W + W_B1); const bf16* B2t = (const bf16*)(ws + WS_W + W_B2); const bf16* PAt = (const bf16*)(ws + WS_W + W_PA); \
    const bf16* PBt = (const bf16*)(ws + WS_W + W_PB); const bf16* Ot = (const bf16*)(ws + WS_W + W_O); const bf16* FGU = (const bf16*)(ws + WS_W + W_F); \
    const bf16* FDd = (const bf16*)(ws + WS_W + W_FD_DENSE); const bf16* FDm = (const bf16*)(ws + WS_W + W_FD_MOE); \
    const float* hin = (l == 0) ? in[I_X] : (l == 1 ? XB : XA); float* x1buf = (l < 2) ? XA : XB; float* x2buf = (l == 0) ? XB : XA; \
    bf16* SIG = (bf16*)x1buf; bf16* Y = (bf16*)((l == 1) ? XB : XA); \
    const float* mhin = (l == 0) ? in[I_META] : (l == 1 ? mHB : mHA); float* mx1 = (l < 2) ? mHA : mHB; float* mx2 = (l == 0) ? mHB : mHA; \
    (void)XA; (void)XB; (void)XBF; (void)QK; (void)V; (void)GA; (void)MRG; (void)U; (void)rope; (void)mHA; (void)mHB; (void)mXB; (void)mQK; (void)mV; (void)mSIG; (void)mGA; (void)mMRG; (void)mU; (void)mY; \
    (void)mO; (void)mTokE; (void)mTokW; (void)perm; (void)tok_slot; (void)tok_w; (void)B1t; (void)B2t; (void)PAt; (void)PBt; (void)Ot; (void)FGU; (void)FDd; (void)FDm; (void)hin; (void)x1buf; (void)x2buf; \
    (void)SIG; (void)Y; (void)mhin; (void)mx1; (void)mx2; (void)in

__global__ void __launch_bounds__(NTHR, 2) fwd_kernel(Args args) {
    extern __shared__ __attribute__((aligned(16))) unsigned char lds_raw[];
    const int lo = args.ph_lo, hi = args.ph_hi;
    const bool multi = (hi - lo) > 1;
    {
        volatile LAS unsigned* MISC0 = (volatile LAS unsigned*)((LAS unsigned char*)lds_raw + MISC_OFF);
        for (int u = threadIdx.x; u < 256; u += NTHR) MISC0[u] = 0u;
        __syncthreads();
        if (multi) (void)xcd_barrier_post((unsigned*)(args.ws + WS_CTL) + CW_BAR, MISC0);
    }
#ifndef PH_MASK
#define PH_MASK 0xFFF
#endif
#define INS(slot, k) ((((PH_MASK) >> (slot)) & 1) && lo <= (k) && (k) < hi)
#define IN(k) (lo <= (k) && (k) < hi)
#define SEAM(k) do { if (IN(k) && IN((k) + 1)) { KArgs B_ = kargs(); XcdBarrier bar; bar.bar = (unsigned*)(B_->ws + WS_CTL) + CW_BAR; bar.x = xb_xcc_id(); \
        bar.st = (volatile LAS unsigned*)((LAS unsigned char*)lds_raw + MISC_OFF); xcd_barrier(bar); } } while (0)

    for (int l = 0; l < DEPTH; ++l) {
        const int pb = l * NPH;
        if (hi <= pb || lo >= pb + NPH) continue;
        const bool moe = (l & 1) != 0; const int l2 = l >> 1;
        if (INS(0, pb + 0)) { ENV();
            int rot = 0;
            const float* win = in[I_WIN] + (size_t)l * D * NIN;
            cvt_job(F, rot, win, nullptr, 1, 0, NIN, 0, D, N1, (bf16*)B1t);
            cvt_job(F, rot, win, nullptr, 2, 0, NIN, 0, D, 2048, (bf16*)B2t);
            cvt_job(F, rot, in[I_WPA] + (size_t)l * D * D, nullptr, 0, 0, D, 0, D, D, (bf16*)PAt);
            cvt_job(F, rot, in[I_WPB] + (size_t)l * D * D, nullptr, 0, 0, D, 0, D, D, (bf16*)PBt);
            cvt_job(F, rot, in[I_WO] + (size_t)l * D * D, nullptr, 0, 0, D, 0, D, D, (bf16*)Ot);
            if (!moe) {
                cvt_job(F, rot, in[I_FG] + (size_t)l2 * D * DFF, in[I_FU] + (size_t)l2 * D * DFF, 3, 0, DFF, 0, D, 2 * DFF, (bf16*)FGU);
                cvt_job(F, rot, in[I_FD] + (size_t)l2 * DFF * D, nullptr, 0, 0, D, 0, DFF, D, (bf16*)FDd);
            } else {
                for (int e = 0; e < NEXP; ++e)
                    for (int hf = 0; hf < 2; ++hf) {
                        const float* wg = in[I_MG] + ((size_t)l2 * NEXP + e) * D * DFFE; const float* wu = in[I_MU] + ((size_t)l2 * NEXP + e) * D * DFFE;
                        cvt_job(F, rot, wg, wu, 3, hf * HFF, DFFE, 0, D, DFFE, (bf16*)FGU + (size_t)(e * 2 + hf) * DFFE * D);
                        cvt_job(F, rot, in[I_MD] + ((size_t)l2 * NEXP + e) * DFFE * D, nullptr, 0, 0, D, hf * HFF, HFF, D, (bf16*)FDm + (size_t)(e * 2 + hf) * D * HFF);
                    }
                if (F.gtid < NEXP) F.ctl[CW_CNT + 64 * F.gtid] = 0u;
            }
            if (l == 0) {
                for (int i = F.gtid; i < 2064 * 64; i += F.gthreads) { const int pos = i >> 6, k = i & 63; const float inv = powf(10000.0f, -(float)k / 64.0f); const float ang = (float)pos * inv;
                    float sn, cs; sincosf(ang, &sn, &cs); ((f32x2*)rope)[i] = (f32x2){cs, sn}; }
                const float* x = in[I_X];
                for (size_t i = (size_t)F.gtid * 4; i < (size_t)M * D; i += (size_t)F.gthreads * 4) store_bf4(XBF + i, *(const f32x4*)(x + i));
                for (int i = F.gtid * 4; i < NMETA * D; i += F.gthreads * 4) store_bf4(mXB + i, *(const f32x4*)(in[I_META] + i));
            }
        }
        SEAM(pb + 0);

        if (INS(1, pb + 1)) { ENV();
            const float* bg = in[I_BGATE] + (size_t)l * 2 * D;
            { F1 f{mQK, mV, mSIG, mGA, rope, bg, 15, 0};
              naive_gemm(F, NMETA, N1, D, [=](int r) { return mXB + (size_t)r * D; }, [=](int, int c) { return B1t + (size_t)c * D; }, f); }
            pg8::SchedDense S; S.init(M, N1, F.G, F.bid, XBF, D * 2, B1t, D * 2);
            pg8::EpiEl<F1> E{F1{QK, V, SIG, GA, rope, bg, 2047, 16}};
            pg8::gemm_phase<pg8::EpiEl<F1>, pg8::SchedDense>(F.lds, F.tid, S, E, D, D * 2, D * 2);
        }
        SEAM(pb + 1);

        if (INS(2, pb + 2)) { ENV();
            MixArgs ma{QK, V, GA, mQK, mV, mGA, mO, in[I_WA2] + (size_t)l * 16 * 512, in[I_BA] + (size_t)l * 512, in[I_GNG] + (size_t)l * 256,
                       in[I_RNG] + (size_t)l * 1024, in[I_RNB] + (size_t)l * 1024, 0};
#if MIXER_FAST
            if (PROBE_DUP & 2) { ma.dry = 1; mixer_fast(F, ma); ma.dry = 0; }
            mixer_fast(F, ma);
#else
            if (PROBE_DUP & 2) { ma.dry = 1; mixer_phase(F, ma); ma.dry = 0; }
            mixer_phase(F, ma);
#endif
        }
        SEAM(pb + 2);

        if (INS(3, pb + 3)) { ENV();
            { F2 f{mO, mV}; naive_gemm(F, NMETA, 2048, D, [=](int r) { return mXB + (size_t)r * D; }, [=](int, int c) { return B2t + (size_t)c * D; }, f); }
            pg8::SchedDense S; S.init(M, 2048, F.G, F.bid, XBF, D * 2, B2t, D * 2);
            pg8::EpiEl<F2> E{F2{V, V}};
            pg8::gemm_phase<pg8::EpiEl<F2>, pg8::SchedDense>(F.lds, F.tid, S, E, D, D * 2, D * 2);
        }
        SEAM(pb + 3);

        if (INS(4, pb + 4)) { ENV();
#pragma unroll 1
            for (int pass = 0; pass < 2; ++pass) {
                const bf16* Wt = pass ? PBt : PAt;
                { F3 f{mMRG, mSIG, pass}; const bf16* mA = mV + pass * 1024; naive_gemm(F, NMETA, D, D, [=](int r) { return mA + (size_t)r * 2048; }, [=](int, int c) { return Wt + (size_t)c * D; }, f); }
                pg8::SchedDense S; S.init(M, D, F.G, F.bid, V + pass * 1024, 2048 * 2, Wt, D * 2);
                pg8::EpiEl<F3> E{F3{MRG, SIG, pass}};
                pg8::gemm_phase<pg8::EpiEl<F3>, pg8::SchedDense>(F.lds, F.tid, S, E, D, 2048 * 2, D * 2);
            }
        }
        SEAM(pb + 4);

        if (INS(5, pb + 5)) { ENV();
            { F4 f{mhin, mx1}; naive_gemm(F, NMETA, D, D, [=](int r) { return mMRG + (size_t)r * D; }, [=](int, int c) { return Ot + (size_t)c * D; }, f); }
            pg8::SchedDense S; S.init(M, D, F.G, F.bid, MRG, D * 2, Ot, D * 2);
            pg8::EpiEl<F4> E{F4{hin, x1buf}};
            pg8::gemm_phase<pg8::EpiEl<F4>, pg8::SchedDense>(F.lds, F.tid, S, E, D, D * 2, D * 2);
        }
        SEAM(pb + 5);

        if (INS(6, pb + 6)) { ENV();
            const float* g = in[I_LN1G] + (size_t)l * D; const float* bb = in[I_LN1B] + (size_t)l * D;
            const float* wrt = in[I_RT] + (size_t)l2 * D * NEXP;
#pragma unroll 1
            for (int rep = (PROBE_DUP & 4) ? 0 : 1; rep < 2; ++rep)
            for (int r = F.gwave; r < M + NMETA; r += F.gwaves) { const int dry = (rep == 0);
                const bool ism = r >= M; const int rr = ism ? r - M : r;
                float* p = ism ? mx1 + (size_t)rr * D : x1buf + (size_t)rr * D; bf16* pbf = ism ? mXB + (size_t)rr * D : XBF + (size_t)rr * D;
                f32x4 v[4]; row_load(v, p, F.lane); ln_vals(v, g, bb, F.lane); row_store(v, p, pbf, F.lane, dry);
                if (moe) {
                    int e1, e2; float w1, w2; route_row(v, wrt, F.lane, e1, e2, w1, w2);
                    if (F.lane == 0 && !dry) {
                        if (ism) { mTokE[rr * 2] = e1; mTokE[rr * 2 + 1] = e2; mTokW[rr * 2] = w1; mTokW[rr * 2 + 1] = w2; }
                        else {
                            const unsigned r1 = atomicAdd(F.ctl + CW_CNT + 64 * e1, 1u), r2 = atomicAdd(F.ctl + CW_CNT + 64 * e2, 1u);
                            perm[e1 * M + (int)r1] = rr; perm[e2 * M + (int)r2] = rr;
                            tok_slot[rr * 2] = (e1 << 16) | (int)r1; tok_slot[rr * 2 + 1] = (e2 << 16) | (int)r2; tok_w[rr * 2] = w1; tok_w[rr * 2 + 1] = w2;
                        }
                    }
                }
            }
        }
        SEAM(pb + 6);

        if (!moe) {
            if (INS(7, pb + 7)) { ENV();
                { F5 f{mU, DFF}; naive_gemm(F, NMETA, 2 * DFF, D, [=](int r) { return mXB + (size_t)r * D; }, [=](int, int c) { return FGU + (size_t)c * D; }, f); }
                pg8::SchedDense S; S.init(M, 2 * DFF, F.G, F.bid, XBF, D * 2, FGU, D * 2);
                pg8::EpiEl<F5> E{F5{U, DFF}};
                pg8::gemm_phase<pg8::EpiEl<F5>, pg8::SchedDense>(F.lds, F.tid, S, E, D, D * 2, D * 2);
            }
            SEAM(pb + 7);
            if (INS(8, pb + 8)) { ENV();
                { F4 f{mx1, mx2}; naive_gemm(F, NMETA, D, DFF, [=](int r) { return mU + (size_t)r * DFF; }, [=](int, int c) { return FDd + (size_t)c * DFF; }, f); }
                pg8::SchedDense S; S.init(M, D, F.G, F.bid, U, DFF * 2, FDd, DFF * 2);
                pg8::EpiEl<F4> E{F4{x1buf, x2buf}};
                pg8::gemm_phase<pg8::EpiEl<F4>, pg8::SchedDense>(F.lds, F.tid, S, E, DFF, DFF * 2, DFF * 2);
            }
            SEAM(pb + 8);
            SEAM(pb + 9);
            SEAM(pb + 10);
            if (INS(11, pb + 11)) { ENV();
                const float* g = in[I_LN2G] + (size_t)l * D; const float* bb = in[I_LN2B] + (size_t)l * D;
    #pragma unroll 1
            for (int rep = (PROBE_DUP & 4) ? 0 : 1; rep < 2; ++rep)
            for (int r = F.gwave; r < M + NMETA; r += F.gwaves) { const int dry = (rep == 0);
                    const bool ism = r >= M; const int rr = ism ? r - M : r;
                    float* p = ism ? mx2 + (size_t)rr * D : x2buf + (size_t)rr * D; bf16* pbf = ism ? mXB + (size_t)rr * D : XBF + (size_t)rr * D;
                    f32x4 v[4]; row_load(v, p, F.lane); ln_vals(v, g, bb, F.lane); row_store(v, p, pbf, F.lane, dry);
                }
            }
            SEAM(pb + 11);
        } else {
            if (lo <= pb + 11 && hi > pb + 7) { ENV();
                if (F.tid == 0) {
                    unsigned ts = 0, cb = 0;
                    for (int e = 0; e < NEXP; ++e) { const unsigned c = __hip_atomic_load(F.ctl + CW_CNT + 64 * e, __ATOMIC_RELAXED, __HIP_MEMORY_SCOPE_AGENT);
                        F.MISC[16 + e] = c; F.MISC[24 + e] = ts; F.MISC[40 + e] = cb; ts += (c + 255u) >> 8; cb += c; }
                    F.MISC[32] = ts;
                }
                __syncthreads();
            }
#pragma unroll 1
            for (int hf = 0; hf < 2; ++hf) {
                if (INS(9, pb + 7 + 2 * hf)) { ENV();
                    { F5 f{mU, HFF};
                      naive_gemm(F, 2 * NMETA, 2 * HFF, D, [=](int r) { return mXB + (size_t)(r >> 1) * D; },
                                 [=](int r, int c) { return FGU + ((size_t)(mTokE[r] * 2 + hf) * DFFE + c) * D; }, f); }
                    SchedMoeUp S{F.MISC, perm, (const char*)XBF, (const char*)FGU, F.G, F.bid, hf};
                    pg8::EpiEl<F5> E{F5{U, HFF}};
                    pg8::gemm_phase<pg8::EpiEl<F5>, SchedMoeUp>(F.lds, F.tid, S, E, D, D * 2, D * 2);
                }
                SEAM(pb + 7 + 2 * hf);
                if (INS(10, pb + 8 + 2 * hf)) { ENV();
                    { F6Mm f{mY, hf};
                      naive_gemm(F, 2 * NMETA, D, HFF, [=](int r) { return mU + (size_t)r * HFF; },
                                 [=](int r, int c) { return FDm + ((size_t)(mTokE[r] * 2 + hf) * D + c) * HFF; }, f); }
                    SchedMoeDown S{F.MISC, (const char*)U, (const char*)FDm, F.G, F.bid, hf};
                    pg8::EpiEl<F6M> E{F6M{Y, hf}};
                    pg8::gemm_phase<pg8::EpiEl<F6M>, SchedMoeDown>(F.lds, F.tid, S, E, HFF, HFF * 2, HFF * 2);
                }
                SEAM(pb + 8 + 2 * hf);
            }
            if (INS(11, pb + 11)) { ENV();
                const float* g = in[I_LN2G] + (size_t)l * D; const float* bb = in[I_LN2B] + (size_t)l * D;
    #pragma unroll 1
            for (int rep = (PROBE_DUP & 4) ? 0 : 1; rep < 2; ++rep)
            for (int r = F.gwave; r < M + NMETA; r += F.gwaves) { const int dry = (rep == 0);
                    const bool ism = r >= M; const int rr = ism ? r - M : r;
                    float* p = ism ? mx1 + (size_t)rr * D : x1buf + (size_t)rr * D; bf16* pbf = ism ? mXB + (size_t)rr * D : XBF + (size_t)rr * D;
                    f32x4 v[4]; row_load(v, p, F.lane);
                    if (ism) {
                        const float w1 = mTokW[rr * 2], w2 = mTokW[rr * 2 + 1];
#pragma unroll
                        for (int j = 0; j < 4; ++j) { const f32x4 y1 = *(const f32x4*)(mY + (size_t)(rr * 2) * D + 4 * F.lane + 256 * j), y2 = *(const f32x4*)(mY + (size_t)(rr * 2 + 1) * D + 4 * F.lane + 256 * j);
                            v[j] = v[j] * ALPHA + y1 * w1 + y2 * w2; }
                    } else {
                        const int s1 = tok_slot[rr * 2], s2 = tok_slot[rr * 2 + 1]; const float w1 = tok_w[rr * 2], w2 = tok_w[rr * 2 + 1];
                        const size_t y1r = (size_t)F.MISC[40 + (s1 >> 16)] + (size_t)(s1 & 0xffff), y2r = (size_t)F.MISC[40 + (s2 >> 16)] + (size_t)(s2 & 0xffff);
#pragma unroll
                        for (int j = 0; j < 4; ++j) { const f32x4 y1 = load_bf4(Y + y1r * D + 4 * F.lane + 256 * j), y2 = load_bf4(Y + y2r * D + 4 * F.lane + 256 * j);
                            v[j] = v[j] * ALPHA + y1 * w1 + y2 * w2; }
                    }
                    ln_vals(v, g, bb, F.lane); row_store(v, p, pbf, F.lane, dry);
                }
            }
            SEAM(pb + 11);
        }
    }
#undef IN
#undef SEAM
}

extern "C" void kernel_launch(void* const* d_in, const int* in_sizes, int n_in, void* d_out, int out_size, void* d_ws, size_t ws_size, hipStream_t stream) {
    static int grid = 0;
    if (grid == 0) {
        if (n_in != 23 || in_sizes[0] != M * D || out_size != M * D || ws_size < WS_END) { fprintf(stderr, "kernel_launch: unexpected shapes / workspace (%d inputs, ws %zu)\n", n_in, ws_size); grid = -1; return; }
        int dev = 0, cus = 0, per_cu = 0;
        if (hipGetDevice(&dev) != hipSuccess || hipDeviceGetAttribute(&cus, hipDeviceAttributeMultiprocessorCount, dev) != hipSuccess) { grid = -1; return; }
        if (hipFuncSetAttribute((const void*)fwd_kernel, hipFuncAttributeMaxDynamicSharedMemorySize, LDS_BYTES) != hipSuccess) { fprintf(stderr, "kernel_launch: hipFuncSetAttribute failed\n"); grid = -1; return; }
        if (hipOccupancyMaxActiveBlocksPerMultiprocessor(&per_cu, (const void*)fwd_kernel, NTHR, LDS_BYTES) != hipSuccess || per_cu < 1) fprintf(stderr, "kernel_launch: occupancy query says %d\n", per_cu);
        (void)hipGetLastError();
        grid = cus;
    }
    if (grid < 0) return;
    if (hipMemsetAsync((char*)d_ws + WS_CTL, 0, CTL_ZERO_BYTES, stream) != hipSuccess) return;
    Args a{};
    for (int i = 0; i < 23; ++i) a.in[i] = (const float*)d_in[i];
    a.out = (float*)d_out; a.ws = (unsigned char*)d_ws;
#if N_LAUNCH_MODE == 1
    a.ph_lo = 0; a.ph_hi = NPHASES;
    hipLaunchKernelGGL(fwd_kernel, dim3(grid), dim3(NTHR), LDS_BYTES, stream, a);
#else
    for (int p = 0; p < NPHASES; ++p) {
        const int l = p / NPH, s = p % NPH;
        if ((l & 1) == 0 && (s == 9 || s == 10)) continue;
        a.ph_lo = p; a.ph_hi = p + 1;
        hipLaunchKernelGGL(fwd_kernel, dim3(grid), dim3(NTHR), LDS_BYTES, stream, a);
    }
#endif
}
```

```cpp
#include <hip/hip_runtime.h>
#include <cstdio>
#include <cstdint>

#ifndef N_LAUNCH_MODE
#define N_LAUNCH_MODE 1
#endif

#ifndef MIXER_FAST
#define MIXER_FAST 1
#endif
#ifndef PROBE_DUP
#define PROBE_DUP 0
#endif
#define LAS __attribute__((address_space(3)))
typedef unsigned short bf16;
typedef short bf16x8 __attribute__((ext_vector_type(8)));
typedef float f32x4 __attribute__((ext_vector_type(4)));
typedef float f32x2 __attribute__((ext_vector_type(2)));
typedef unsigned u32x4 __attribute__((ext_vector_type(4)));
typedef unsigned u32x2 __attribute__((ext_vector_type(2)));

constexpr int D = 1024, NB = 32, SEQ = 2048, DEPTH = 4, NMETA = 16;
constexpr int M = NB * SEQ;
constexpr int NIN = 8208;
constexpr int N1 = 6400;
constexpr int DFF = 2816, DFFE = 3584, NEXP = 8, HFF = 1792;
constexpr float ALPHA = 1.681792830507429f;
constexpr float QSCALE = 0.08838834764831845f;
constexpr float LN_EPS = 1e-5f, GN_EPS = 1e-6f;
constexpr int NPH = 12;
constexpr int NPHASES = DEPTH * NPH;

constexpr size_t MiB = 1u << 20;
constexpr size_t WS_CTL = 0, CTL_ZERO_BYTES = 1 * MiB;
constexpr size_t WS_ROPE = 1 * MiB;
constexpr size_t WS_META = 3 * MiB;
constexpr size_t WS_MOE = 4 * MiB;
constexpr size_t WS_GA = 8 * MiB;
constexpr size_t WS_W = 12 * MiB;
constexpr size_t WS_XA = 204 * MiB;
constexpr size_t WS_XBF = 460 * MiB;
constexpr size_t WS_QK = 588 * MiB;
constexpr size_t WS_V = 844 * MiB;
constexpr size_t WS_META2 = 1100 * MiB;
constexpr size_t WS_END = 1102 * MiB;
constexpr size_t W_B1 = 0;
constexpr size_t W_B2 = W_B1 + (size_t)N1 * D * 2;
constexpr size_t W_PA = W_B2 + (size_t)2048 * D * 2;
constexpr size_t W_PB = W_PA + (size_t)D * D * 2;
constexpr size_t W_O = W_PB + (size_t)D * D * 2;
constexpr size_t W_F = W_O + (size_t)D * D * 2;
constexpr size_t W_FD_DENSE = W_F + (size_t)2 * DFF * D * 2;
constexpr size_t W_FD_MOE = W_F + (size_t)NEXP * 2 * DFFE * D * 2;
static_assert(W_FD_MOE + (size_t)NEXP * 2 * D * HFF * 2 <= 192 * MiB, "weights fit");
constexpr size_t MT_HA = 0, MT_HB = 65536, MT_XB = 131072, MT_QK = 163840, MT_V = 229376, MT_SIG = 294912, MT_GA = 360448, MT_MRG = 364544,
                 MT_U = 397312  , MT_Y = 512000  , MT_TOK = 643072  , MT_O = 644096  ;
static_assert(MT_O + 65536 <= MiB, "meta map");
constexpr int CW_CNT = 1024;
constexpr int CW_BAR = 4096;

constexpr int RING_BYTES = 131072;
constexpr int LDS_BYTES = 147456;
constexpr int MISC_OFF = LDS_BYTES - 1024;
constexpr int NWAVES = 8, NTHR = 512;

__device__ __forceinline__ unsigned f2bf(float f) { unsigned u = __builtin_bit_cast(unsigned, f); return (u + 0x7fffu + ((u >> 16) & 1u)) >> 16; }
__device__ __forceinline__ float bf2f(unsigned h) { return __builtin_bit_cast(float, (h & 0xffffu) << 16); }
typedef __bf16 bf16x2_t __attribute__((ext_vector_type(2)));
__device__ __forceinline__ unsigned pk2(float lo, float hi) { const f32x2 v = {lo, hi}; return __builtin_bit_cast(unsigned, __builtin_convertvector(v, bf16x2_t)); }
__device__ __forceinline__ unsigned pk2_sw(float lo, float hi) { return pk2(lo, hi); }
__device__ __forceinline__ void store_bf4(bf16* p, f32x4 v) { u32x2 w; w.x = pk2(v[0], v[1]); w.y = pk2(v[2], v[3]); *(u32x2*)p = w; }
__device__ __forceinline__ f32x4 load_bf4(const bf16* p) { const u32x2 w = *(const u32x2*)p; return (f32x4){bf2f(w.x), bf2f(w.x >> 16), bf2f(w.y), bf2f(w.y >> 16)}; }
__device__ __forceinline__ void store_bf8(bf16* p, f32x4 lo, f32x4 hi) { u32x4 w; w.x = pk2(lo[0], lo[1]); w.y = pk2(lo[2], lo[3]); w.z = pk2(hi[0], hi[1]); w.w = pk2(hi[2], hi[3]); *(u32x4*)p = w; }
__device__ __forceinline__ void load_bf8(const bf16* p, f32x4& lo, f32x4& hi) { const u32x4 w = *(const u32x4*)p; lo = (f32x4){bf2f(w.x), bf2f(w.x >> 16), bf2f(w.y), bf2f(w.y >> 16)}; hi = (f32x4){bf2f(w.z), bf2f(w.z >> 16), bf2f(w.w), bf2f(w.w >> 16)}; }
__device__ __forceinline__ float sigmoidf_(float x) { return __builtin_amdgcn_rcpf(1.0f + __expf(-x)); }
__device__ __forceinline__ float siluf_(float x) { return x * __builtin_amdgcn_rcpf(1.0f + __expf(-x)); }
__device__ __forceinline__ float wave_sum(float v) {
#pragma unroll
    for (int o = 1; o < 64; o <<= 1) v += __shfl_xor(v, o);
    return v;
}
#define LDS_WAIT() asm volatile("s_waitcnt lgkmcnt(0)" ::: "memory")
#define VM_WAIT() asm volatile("s_waitcnt vmcnt(0)" ::: "memory")

namespace pg8 {
constexpr int BM = 256, BK = 64, HALF = 128, HTB = HALF * BK * 2, STAGE_BYTES = 8 * HTB, NXCD = 8, WGM = 8;
__host__ __device__ __forceinline__ int lds_byte(int r, int c) { const int st = (r >> 4) * 2 + (c >> 5), rr = r & 15, cc = c & 31, ob = rr * 64 + cc * 2; return st * 1024 + (ob ^ (((ob >> 9) & 1) << 5)); }
__host__ __device__ __forceinline__ void stage_rc(int b, int& R, int& C) { const int st = b / 1024, sb = b % 1024, swz = sb ^ (((sb >> 9) & 1) << 5); R = (st >> 1) * 16 + swz / 64; C = (st & 1) * 32 + (swz % 64) / 2; }

__host__ __device__ __forceinline__ int perm32(int rho) { const int n = rho >> 4, i = rho & 15; return 8 * (i >> 2) + 4 * n + (i & 3); }
struct Unit { const char* A; const char* B; int row0, col0, e, nvalid; };

struct SchedDense {
    static constexpr bool GATHER = false;
    int nM, nN, nwg, G, c; const char* A; const char* Bt; unsigned lda, ldb;
    __device__ void init(int Mr, int Nc, int G_, int c_, const void* A_, unsigned lda_, const void* Bt_, unsigned ldb_) { nM = Mr / BM; nN = Nc / BM; nwg = nM * nN; G = G_; c = c_; A = (const char*)A_; Bt = (const char*)Bt_; lda = lda_; ldb = ldb_; }
    __device__ bool next(int i, Unit& u) const {
        const long L = (long)i * G + c; if (L >= nwg) return false;
        int wgid = (int)L; { const int q = nwg / NXCD, r = nwg % NXCD, xcd = wgid % NXCD, off = wgid / NXCD; wgid = (xcd < r ? xcd * (q + 1) : r * (q + 1) + (xcd - r) * q) + off; }
        const int nig = WGM * nN, gid = wgid / nig, fm = gid * WGM, gsz = (nM - fm) < WGM ? (nM - fm) : WGM;
        const int pm = fm + ((wgid % nig) % gsz), pn = (wgid % nig) / gsz;
        u.A = A + (size_t)pm * BM * lda; u.B = Bt + (size_t)pn * BM * ldb; u.row0 = pm * BM; u.col0 = pn * BM; u.e = 0; u.nvalid = BM; return true;
    }
    __device__ __forceinline__ unsigned a_off(const Unit&, int R, int h) const { return (unsigned)(h * HALF + R) * lda; }
};

template <class F> struct EpiEl {
    static constexpr bool PERM = false;
    F f;
    template <int MODE> __device__ __forceinline__ void loop(const f32x4 (&acc)[2][2][4][2], const Unit& u, int wr, int wc, int fr, int fq) const {
#pragma unroll
        for (int ai = 0; ai < 2; ++ai)
#pragma unroll
            for (int m = 0; m < 4; ++m) { const int r = ai * HALF + wr * 64 + m * 16 + fr;
#pragma unroll
                for (int bj = 0; bj < 2; ++bj)
#pragma unroll
                    for (int n = 0; n < 2; ++n) f.template at<MODE>(u, r, bj * HALF + wc * 32 + n * 16 + 4 * fq, acc[ai][bj][m][n]);
                asm volatile("" ::: "memory"); }
    }
    __device__ __forceinline__ void operator()(const f32x4 (&acc)[2][2][4][2], const Unit& u, int wr, int wc, int fr, int fq) const {
        if constexpr (F::NMODES == 1) loop<0>(acc, u, wr, wc, fr, fq);
        else {
            const int mode = __builtin_amdgcn_readfirstlane(f.mode(u));
            if (mode == 0) loop<0>(acc, u, wr, wc, fr, fq);
            else if (mode == 1) loop<1>(acc, u, wr, wc, fr, fq);
            else if (mode == 2) loop<2>(acc, u, wr, wc, fr, fq);
            else if (mode == 3) loop<3>(acc, u, wr, wc, fr, fq);
            else loop<4>(acc, u, wr, wc, fr, fq);
        }
    }
};

template <class F> struct EpiRow {
    static constexpr bool PERM = true;
    F f;
    template <int MODE> __device__ __forceinline__ void loop(const f32x4 (&acc)[2][2][4][2], const Unit& u, int wr, int wc, int fr, int fq) const {
#pragma unroll
        for (int ai = 0; ai < 2; ++ai)
#pragma unroll
            for (int m = 0; m < 4; ++m) { f.template row<MODE>(u, ai * HALF + wr * 64 + m * 16 + fr, wc * 32 + 8 * fq, acc[ai][0][m][0], acc[ai][0][m][1], acc[ai][1][m][0], acc[ai][1][m][1]);
                asm volatile("" ::: "memory"); }
    }
    __device__ __forceinline__ void operator()(const f32x4 (&acc)[2][2][4][2], const Unit& u, int wr, int wc, int fr, int fq) const {
        if constexpr (F::NMODES == 1) loop<0>(acc, u, wr, wc, fr, fq);
        else {
            const int mode = __builtin_amdgcn_readfirstlane(f.mode(u));
            if (mode == 0) loop<0>(acc, u, wr, wc, fr, fq);
            else if (mode == 1) loop<1>(acc, u, wr, wc, fr, fq);
            else if (mode == 2) loop<2>(acc, u, wr, wc, fr, fq);
            else if (mode == 3) loop<3>(acc, u, wr, wc, fr, fq);
            else loop<4>(acc, u, wr, wc, fr, fq);
        }
    }
};

template <class Epi, class Sched, bool ALIGN_EPI = true>
__device__ __forceinline__ void gemm_phase(LAS unsigned char* lds, const int tid, const Sched& S, const Epi& E, const int K, const unsigned lda, const unsigned ldb) {
    const int wid = __builtin_amdgcn_readfirstlane(tid >> 6), lane = tid & 63, wr = wid >> 2, wc = wid & 3, fr = lane & 15, fq = lane >> 4;
    const int nt = K / BK;
    int Rr[2], Cc[2]; unsigned voffA[2], voffB[2];
#pragma unroll
    for (int i = 0; i < 2; ++i) { int R, C; stage_rc(tid * 16 + i * 8192, R, C); Rr[i] = R; Cc[i] = C; const int Rb = Epi::PERM ? ((R & ~31) + perm32(R & 31)) : R; voffA[i] = (unsigned)R * lda + (unsigned)C * 2u; voffB[i] = (unsigned)Rb * ldb + (unsigned)C * 2u; }
    const size_t kstep = (size_t)(BK * 2);
    const size_t hstepA = (size_t)HALF * lda, hstepB = (size_t)HALF * ldb;
    const unsigned ldsw = (unsigned)wid * 1024u;
    const int aoff = lds_byte(wr * 64 + fr, fq * 8), boff = lds_byte(wc * 32 + fr, fq * 8);
#define PG8_SA(b, h) (((b) * 2 + (h)) * HTB)
#define PG8_SB(b, h) ((4 + (b) * 2 + (h)) * HTB)
#define PG8_STAGE_B(bufoff, gbase) do { _Pragma("unroll") for (int _i = 0; _i < 2; ++_i) \
        __builtin_amdgcn_global_load_lds((const unsigned*)((const char*)(gbase) + voffB[_i]), (LAS unsigned*)(lds + (bufoff) + ldsw + _i * 8192), 16, 0, 0); } while (0)
#define PG8_STAGE_A(bufoff, gbase, h, ox) do { _Pragma("unroll") for (int _i = 0; _i < 2; ++_i) { \
        const char* _p = Sched::GATHER ? ((const char*)(gbase) + (ox)[h][_i]) : ((const char*)(gbase) + (h) * hstepA + voffA[_i]); \
        __builtin_amdgcn_global_load_lds((const unsigned*)_p, (LAS unsigned*)(lds + (bufoff) + ldsw + _i * 8192), 16, 0, 0); } } while (0)
#define PG8_LDA(dst, b, h) do { _Pragma("unroll") for (int m = 0; m < 4; ++m) _Pragma("unroll") for (int k = 0; k < 2; ++k) dst[m][k] = *(const LAS bf16x8*)(lds + PG8_SA(b, h) + aoff + m * 2048 + k * 1024); } while (0)
#define PG8_LDB(dst, b, h) do { _Pragma("unroll") for (int n = 0; n < 2; ++n) _Pragma("unroll") for (int k = 0; k < 2; ++k) dst[n][k] = *(const LAS bf16x8*)(lds + PG8_SB(b, h) + boff + n * 2048 + k * 1024); } while (0)
#define PG8_MMA(ai, bj, At, Bt) do { __builtin_amdgcn_s_setprio(1); _Pragma("unroll") for (int m = 0; m < 4; ++m) _Pragma("unroll") for (int n = 0; n < 2; ++n) _Pragma("unroll") for (int k = 0; k < 2; ++k) \
        acc[ai][bj][m][n] = __builtin_amdgcn_mfma_f32_16x16x32_bf16(Bt[n][k], At[m][k], acc[ai][bj][m][n], 0, 0, 0); __builtin_amdgcn_s_setprio(0); } while (0)
#define PG8_WAIT_V(n) asm volatile("s_waitcnt vmcnt(" #n ")" ::: "memory")
#define PG8_WAIT_L(n) asm volatile("s_waitcnt lgkmcnt(" #n ")" ::: "memory")
#define PG8_BAR __builtin_amdgcn_s_barrier()
#define PG8_SCHED __builtin_amdgcn_sched_barrier(0)
    Unit cur, nxt; int ui = 0;
    if (!S.next(0, cur)) return;
    f32x4 acc[2][2][4][2];
#pragma unroll
    for (int a = 0; a < 2; ++a)
#pragma unroll
        for (int b = 0; b < 2; ++b)
#pragma unroll
            for (int m = 0; m < 4; ++m)
#pragma unroll
                for (int n = 0; n < 2; ++n) acc[a][b][m][n] = (f32x4){0.f, 0.f, 0.f, 0.f};
    bf16x8 At[4][2], B0[2][2], B1[2][2];
    unsigned oc[2][2];
#pragma unroll
    for (int h = 0; h < 2; ++h)
#pragma unroll
        for (int i = 0; i < 2; ++i) oc[h][i] = Sched::GATHER ? (S.a_off(cur, Rr[i], h) + (unsigned)Cc[i] * 2u) : 0u;
    const char* cA = cur.A; const char* cB = cur.B;
    PG8_STAGE_B(PG8_SB(0, 0), cB); PG8_STAGE_B(PG8_SB(0, 1), cB + hstepB); PG8_STAGE_A(PG8_SA(0, 0), cA, 0, oc); PG8_STAGE_A(PG8_SA(0, 1), cA, 1, oc);
    if (wr == 1) PG8_BAR;
    PG8_WAIT_V(2); PG8_BAR;
    PG8_STAGE_B(PG8_SB(1, 0), cB + kstep); PG8_STAGE_A(PG8_SA(1, 0), cA + kstep, 0, oc); PG8_STAGE_B(PG8_SB(1, 1), cB + hstepB + kstep);
    PG8_WAIT_V(6); PG8_BAR;
    for (;;) {
        const bool has_next = S.next(ui + 1, nxt);
        const char* nA = has_next ? nxt.A : cA; const char* nB = has_next ? nxt.B : cB;
        for (int t = 0; t < nt; t += 2) {
            const bool last = (t == nt - 2);
            const char* a1 = cA + (size_t)(t + 1) * kstep;
            const char* a2 = last ? nA : cA + (size_t)(t + 2) * kstep; const char* b2 = last ? nB : cB + (size_t)(t + 2) * kstep;
            const char* a3 = a2 + kstep; const char* b3 = b2 + kstep;
            PG8_LDB(B0, 0, 0); PG8_LDB(B1, 0, 1); PG8_SCHED; PG8_LDA(At, 0, 0); PG8_STAGE_A(PG8_SA(1, 1), a1, 1, oc);
            if constexpr (Sched::GATHER) { if (last && has_next) {
#pragma unroll
                for (int h = 0; h < 2; ++h)
#pragma unroll
                    for (int i = 0; i < 2; ++i) oc[h][i] = S.a_off(nxt, Rr[i], h) + (unsigned)Cc[i] * 2u; } }
            PG8_WAIT_V(8); PG8_WAIT_L(0); PG8_BAR; PG8_MMA(0, 0, At, B0); PG8_MMA(0, 1, At, B1); PG8_BAR; PG8_SCHED;
            PG8_LDA(At, 0, 1); PG8_STAGE_B(PG8_SB(0, 0), b2); PG8_STAGE_B(PG8_SB(0, 1), b2 + hstepB); PG8_STAGE_A(PG8_SA(0, 0), a2, 0, oc);
            PG8_WAIT_V(8); PG8_WAIT_L(0); PG8_BAR; PG8_MMA(1, 0, At, B0); PG8_MMA(1, 1, At, B1); PG8_BAR; PG8_SCHED;
            PG8_LDB(B0, 1, 0); PG8_LDB(B1, 1, 1); PG8_SCHED; PG8_LDA(At, 1, 0); PG8_STAGE_A(PG8_SA(0, 1), a2, 1, oc);
            PG8_WAIT_V(8); PG8_WAIT_L(0); PG8_BAR; PG8_MMA(0, 0, At, B0); PG8_MMA(0, 1, At, B1); PG8_BAR; PG8_SCHED;
            PG8_LDA(At, 1, 1); PG8_STAGE_B(PG8_SB(1, 0), b3); PG8_STAGE_B(PG8_SB(1, 1), b3 + hstepB); PG8_STAGE_A(PG8_SA(1, 0), a3, 0, oc);
            PG8_WAIT_V(8); PG8_WAIT_L(0); PG8_BAR; PG8_MMA(1, 0, At, B0); PG8_MMA(1, 1, At, B1); PG8_BAR; PG8_SCHED;
        }
        if constexpr (ALIGN_EPI) { if (wr == 0) PG8_BAR; }
        E(acc, cur, wr, wc, fr, fq);
        if (!has_next) break;
#pragma unroll
        for (int a = 0; a < 2; ++a)
#pragma unroll
            for (int b = 0; b < 2; ++b)
#pragma unroll
                for (int m = 0; m < 4; ++m)
#pragma unroll
                    for (int n = 0; n < 2; ++n) acc[a][b][m][n] = (f32x4){0.f, 0.f, 0.f, 0.f};
        cur = nxt; cA = nA; cB = nB; ++ui;
        if constexpr (ALIGN_EPI) { if (wr == 1) PG8_BAR; }
    }
    PG8_WAIT_V(0);
    if constexpr (!ALIGN_EPI) { if (wr == 0) PG8_BAR; }
    PG8_BAR;
#undef PG8_SA
#undef PG8_SB
#undef PG8_STAGE_A
#undef PG8_STAGE_B
#undef PG8_LDA
#undef PG8_LDB
#undef PG8_MMA
#undef PG8_WAIT_V
#undef PG8_WAIT_L
#undef PG8_BAR
#undef PG8_SCHED
}
}

#define XB_TMO      128
#define XB_XCNT(j)  (256  + 64 * (j))
#define XB_XSUB(j)  (1280 + 64 * (j))
#define XB_XGEN(j)  (2304 + 64 * (j))
#define XB_TOP      3328
#define XB_TOPGEN   3392
#define XCD_BAR_WORDS 3456
#define XB_SPIN_CAP (1u << 18)
__device__ __forceinline__ unsigned xb_ld(unsigned* p)              { return __hip_atomic_load(p, __ATOMIC_RELAXED, __HIP_MEMORY_SCOPE_AGENT); }
__device__ __forceinline__ unsigned xb_add(unsigned* p, unsigned v) { return __hip_atomic_fetch_add(p, v, __ATOMIC_RELAXED, __HIP_MEMORY_SCOPE_AGENT); }
__device__ __forceinline__ unsigned xb_xcc_id() { return (unsigned)__builtin_amdgcn_s_getreg((3 << 11) | 20) & 0xFu; }
#define XB_SPIN(cond, bar) do { unsigned _sp = 0; while (cond) { __builtin_amdgcn_s_sleep(1); \
    if ((++_sp & 255u) == 0u) { if (xb_ld(&(bar)[XB_TMO])) break; if (_sp > XB_SPIN_CAP) { atomicAdd(&(bar)[XB_TMO], 1u); break; } } } } while (0)
struct XcdBarrier { unsigned* bar; unsigned x; volatile LAS unsigned* st; };
__device__ __forceinline__ XcdBarrier xcd_barrier_post(unsigned* bar, volatile LAS unsigned* st) {
    XcdBarrier b; b.bar = bar; b.x = xb_xcc_id(); b.st = st;
    if (threadIdx.x == 0) (void)xb_add(&bar[XB_XCNT(b.x)], 1u);
    return b;
}
__device__ __forceinline__ void xcd_barrier_complete(unsigned* bar, unsigned x, unsigned& nloc, unsigned& nx) {
    const unsigned G = gridDim.x * gridDim.y * gridDim.z;
    unsigned sum, cnt, mine, sp = 0u;
    for (;;) {
        sum = 0u; cnt = 0u; mine = 0u;
#pragma unroll
        for (unsigned j = 0; j < 16; ++j) { const unsigned c = xb_ld(&bar[XB_XCNT(j)]); sum += c; cnt += (c > 0u) ? 1u : 0u; mine = (j == x) ? c : mine; }
        if (sum == G) break;
        __builtin_amdgcn_s_sleep(1);
        if ((++sp & 255u) == 0u) { if (xb_ld(&bar[XB_TMO])) break; if (sp > XB_SPIN_CAP) { atomicAdd(&bar[XB_TMO], 1u); break; } }
    }
    nloc = mine > 0u ? mine : 1u; nx = cnt > 0u ? cnt : 1u;
}
__device__ __forceinline__ void xcd_barrier(const XcdBarrier& b) {
    asm volatile("s_waitcnt vmcnt(0)" ::: "memory");
    __syncthreads();
    if (threadIdx.x == 0) {
        unsigned* bar = b.bar;
        __builtin_amdgcn_s_waitcnt(0);
        unsigned nloc = b.st[0], nx = b.st[1];
        if (nloc == 0u) { xcd_barrier_complete(bar, b.x, nloc, nx); b.st[0] = nloc; b.st[1] = nx; }
        const unsigned old = xb_add(&bar[XB_XSUB(b.x)], 1u);
        const unsigned gen = old / nloc;
        if (old + 1u == (gen + 1u) * nloc) {
            __builtin_amdgcn_fence(__ATOMIC_RELEASE, "agent");
            asm volatile("s_waitcnt vmcnt(0)" ::: "memory");
            const unsigned og = xb_add(&bar[XB_TOP], 1u);
            const unsigned tg = og / nx;
            if (og + 1u == (tg + 1u) * nx) xb_add(&bar[XB_TOPGEN], 1u);
            else XB_SPIN(xb_ld(&bar[XB_TOPGEN]) == tg, bar);
            __builtin_amdgcn_fence(__ATOMIC_ACQUIRE, "agent");
            xb_add(&bar[XB_XGEN(b.x)], 1u);
            asm volatile("s_waitcnt vmcnt(0)" ::: "memory");
        } else {
            XB_SPIN(xb_ld(&bar[XB_XGEN(b.x)]) == gen, bar);
            __builtin_amdgcn_fence(__ATOMIC_ACQUIRE, "agent");
            asm volatile("s_waitcnt vmcnt(0)" ::: "memory");
        }
    }
    __syncthreads();
}

struct Args { const float* in[23]; float* out; unsigned char* ws; int ph_lo, ph_hi; };
enum { I_X = 0, I_META, I_WIN, I_BGATE, I_WA2, I_BA, I_GNG, I_RNG, I_RNB, I_WPA, I_WPB, I_WO, I_LN1G, I_LN1B, I_FG, I_FU, I_FD, I_RT, I_MG, I_MU, I_MD, I_LN2G, I_LN2B };

struct Frame {
    LAS unsigned char* lds; volatile LAS unsigned* MISC; unsigned* ctl;
    int tid, lane, wave, G, bid, gtid, gthreads, gwave, gwaves;
    unsigned char* ws;
};

template <class AR, class BR, class F>
__device__ __forceinline__ void naive_gemm(const Frame& Fr, int nrows, int ncols, int K, AR arow, BR brow, F f) {
    const int nc4 = ncols >> 2;
#pragma unroll 1
    for (int rep = (PROBE_DUP & 1) ? 0 : 1; rep < 2; ++rep)
    for (int idx = Fr.gtid; idx < nrows * nc4; idx += Fr.gthreads) {
        const int row = idx / nc4, c0 = (idx % nc4) * 4;
        const bf16* a = arow(row);
        f32x4 acc = (f32x4){0.f, 0.f, 0.f, 0.f};
#pragma unroll
        for (int j = 0; j < 4; ++j) {
            const bf16* b = brow(row, c0 + j);
            float s = 0.f;
            for (int k = 0; k < K; k += 8) {
                const u32x4 av = *(const u32x4*)(a + k), bv = *(const u32x4*)(b + k);
                s += bf2f(av.x) * bf2f(bv.x) + bf2f(av.x >> 16) * bf2f(bv.x >> 16) + bf2f(av.y) * bf2f(bv.y) + bf2f(av.y >> 16) * bf2f(bv.y >> 16)
                   + bf2f(av.z) * bf2f(bv.z) + bf2f(av.z >> 16) * bf2f(bv.z >> 16) + bf2f(av.w) * bf2f(bv.w) + bf2f(av.w >> 16) * bf2f(bv.w >> 16);
            }
            acc[j] = s;
        }
        if (rep == 0) { if (acc[0] + acc[1] + acc[2] + acc[3] == 1.2345678e30f) *(f32x4*)(Fr.ws + WS_META + MT_Y) = acc; continue; }
        pg8::Unit u; u.A = nullptr; u.B = nullptr; u.row0 = 0; u.col0 = c0 & ~255; u.e = 0; u.nvalid = nrows;
        const int cc = c0 & 255;
        if constexpr (F::NMODES == 1) f.template at<0>(u, row, cc, acc);
        else { const int mode = f.mode(u);
            if (mode == 0) f.template at<0>(u, row, cc, acc); else if (mode == 1) f.template at<1>(u, row, cc, acc); else if (mode == 2) f.template at<2>(u, row, cc, acc);
            else if (mode == 3) f.template at<3>(u, row, cc, acc); else f.template at<4>(u, row, cc, acc); }
    }
}

template <class AR, class BC, class FM>
__device__ __forceinline__ void meta_gemm(const Frame& Fr, int nouter, int ncols, int K, AR arow, BC bcol, FM fmk) {
    const int ntile = ncols >> 4, ntask = nouter * ntile, kw = K >> 3;
    const int lane = Fr.lane, l16 = lane & 15, quad = lane >> 4;
    LAS f32x4* part = (LAS f32x4*)Fr.lds;
#pragma unroll 1
    for (int rep = (PROBE_DUP & 1) ? 0 : 1; rep < 2; ++rep)
#pragma unroll 1
    for (int task = Fr.bid; task < ntask; task += Fr.G) {
        const int o = task / ntile, c0 = (task - o * ntile) * 16;
        const bf16* ap = arow(o, l16) + Fr.wave * kw + 8 * quad; const bf16* bp = bcol(o, c0 + l16) + Fr.wave * kw + 8 * quad;
        f32x4 acc = (f32x4){0.f, 0.f, 0.f, 0.f};
        for (int k = 0; k < kw; k += 32) { const bf16x8 av = *(const bf16x8*)(ap + k), bv = *(const bf16x8*)(bp + k); acc = __builtin_amdgcn_mfma_f32_16x16x32_bf16(bv, av, acc, 0, 0, 0); }
        part[Fr.wave * 64 + lane] = acc;
        __syncthreads();
        if (Fr.wave == 0) {
            f32x4 t = part[lane];
#pragma unroll
            for (int w = 1; w < 8; ++w) t = t + part[w * 64 + lane];
            if (rep == 1) {
                auto f = fmk(o);
                pg8::Unit u; u.A = nullptr; u.B = nullptr; u.row0 = 0; u.col0 = c0 & ~255; u.e = 0; u.nvalid = 16;
                const int cc = (c0 & 255) + 4 * quad;
                if constexpr (decltype(f)::NMODES == 1) f.template at<0>(u, l16, cc, t);
                else { const int mode = f.mode(u);
                    if (mode == 0) f.template at<0>(u, l16, cc, t); else if (mode == 1) f.template at<1>(u, l16, cc, t); else if (mode == 2) f.template at<2>(u, l16, cc, t);
                    else if (mode == 3) f.template at<3>(u, l16, cc, t); else f.template at<4>(u, l16, cc, t); }
            }
        }
        __syncthreads();
    }
}

template <class AR, class BC, class FM>
__device__ __forceinline__ void meta_gemm_pair(const Frame& Fr, int nouter, int nff, int K, AR arow, BC bcol, FM fmk) {
    const int ntile = nff >> 4, ntask = nouter * ntile, kw = K >> 3;
    const int lane = Fr.lane, l16 = lane & 15, quad = lane >> 4;
    LAS f32x4* part = (LAS f32x4*)Fr.lds;
#pragma unroll 1
    for (int rep = (PROBE_DUP & 1) ? 0 : 1; rep < 2; ++rep)
#pragma unroll 1
    for (int task = Fr.bid; task < ntask; task += Fr.G) {
        const int o = task / ntile, f0 = (task - o * ntile) * 16, wrow = 256 * (f0 >> 7) + (f0 & 127);
        const bf16* ap = arow(o, l16) + Fr.wave * kw + 8 * quad; const bf16* bp = bcol(o, wrow + l16) + Fr.wave * kw + 8 * quad; const bf16* bp2 = bp + (size_t)128 * K;
        f32x4 ag = (f32x4){0.f, 0.f, 0.f, 0.f}, au = ag;
        for (int k = 0; k < kw; k += 32) { const bf16x8 av = *(const bf16x8*)(ap + k), bg = *(const bf16x8*)(bp + k), bu = *(const bf16x8*)(bp2 + k);
            ag = __builtin_amdgcn_mfma_f32_16x16x32_bf16(bg, av, ag, 0, 0, 0); au = __builtin_amdgcn_mfma_f32_16x16x32_bf16(bu, av, au, 0, 0, 0); }
        part[Fr.wave * 64 + lane] = ag; part[512 + Fr.wave * 64 + lane] = au;
        __syncthreads();
        if (Fr.wave == 0) {
            f32x4 tg = part[lane], tu = part[512 + lane];
#pragma unroll
            for (int w = 1; w < 8; ++w) { tg = tg + part[w * 64 + lane]; tu = tu + part[512 + w * 64 + lane]; }
            if (rep == 1) { auto f = fmk(o); f.pair(l16, f0 + 4 * quad, tg, tu); }
        }
        __syncthreads();
    }
}

struct F1 {
    static constexpr int NMODES = 5;
    bf16* QK; bf16* V; bf16* SIG; float* GA; const f32x2* rope; const float* bg; int posmask, posbase;
    __device__ __forceinline__ int mode(const pg8::Unit& u) const { const int c = u.col0; return c < 1024 ? 0 : (c < 2048 ? 1 : (c < 4096 ? 2 : (c < 6144 ? 3 : 4))); }
    template <int MODE> __device__ __forceinline__ void at(const pg8::Unit& u, int r, int c, f32x4 v) const {
        const int row = u.row0 + r, col = u.col0 + c;
        if (MODE == 0) { const float s = col < 512 ? QSCALE : 1.f; store_bf4(QK + (size_t)row * 2048 + col, v * s); }
        else if (MODE == 1) {
            const int j = (col - 1024) & 127, pos = (row & posmask) + posbase; const f32x2 c0 = rope[pos * 64 + (j >> 1)], c1 = rope[pos * 64 + (j >> 1) + 1];
            const float s = col >= 1536 ? QSCALE : 1.f;
            f32x4 o; o[0] = (v[0] * c0.x - v[1] * c0.y) * s; o[1] = (v[0] * c0.y + v[1] * c0.x) * s; o[2] = (v[2] * c1.x - v[3] * c1.y) * s; o[3] = (v[2] * c1.y + v[3] * c1.x) * s;
            store_bf4(QK + (size_t)row * 2048 + col, o);
        }
        else if (MODE == 2) store_bf4(V + (size_t)row * 2048 + (col - 2048), v);
        else if (MODE == 3) { const int cc = col - 4096; const f32x4 b = *(const f32x4*)(bg + cc);
            f32x4 o; o[0] = sigmoidf_(v[0] + b[0]); o[1] = sigmoidf_(v[1] + b[1]); o[2] = sigmoidf_(v[2] + b[2]); o[3] = sigmoidf_(v[3] + b[3]);
            store_bf4(SIG + (size_t)row * 2048 + cc, o); }
        else { if (col < 6160) *(f32x4*)(GA + (size_t)row * 16 + (col - 6144)) = v; }
    }
    template <int MODE> __device__ __forceinline__ void half8(int row, int col, f32x4 lo, f32x4 hi) const {
        if (MODE == 0) { const float s = col < 512 ? QSCALE : 1.f; store_bf8(QK + (size_t)row * 2048 + col, lo * s, hi * s); }
        else if (MODE == 1) {
            const int j = (col - 1024) & 127, pos = (row & posmask) + posbase; const f32x4* rp = (const f32x4*)(rope + pos * 64 + (j >> 1)); const f32x4 t0 = rp[0], t1 = rp[1];
            const float s = col >= 1536 ? QSCALE : 1.f;
            f32x4 o0, o1;
            o0[0] = (lo[0] * t0[0] - lo[1] * t0[1]) * s; o0[1] = (lo[0] * t0[1] + lo[1] * t0[0]) * s; o0[2] = (lo[2] * t0[2] - lo[3] * t0[3]) * s; o0[3] = (lo[2] * t0[3] + lo[3] * t0[2]) * s;
            o1[0] = (hi[0] * t1[0] - hi[1] * t1[1]) * s; o1[1] = (hi[0] * t1[1] + hi[1] * t1[0]) * s; o1[2] = (hi[2] * t1[2] - hi[3] * t1[3]) * s; o1[3] = (hi[2] * t1[3] + hi[3] * t1[2]) * s;
            store_bf8(QK + (size_t)row * 2048 + col, o0, o1);
        }
        else if (MODE == 2) store_bf8(V + (size_t)row * 2048 + (col - 2048), lo, hi);
        else if (MODE == 3) { const int cc = col - 4096; const f32x4 b0 = *(const f32x4*)(bg + cc), b1 = *(const f32x4*)(bg + cc + 4);
            f32x4 o0, o1;
#pragma unroll
            for (int i = 0; i < 4; ++i) { o0[i] = sigmoidf_(lo[i] + b0[i]); o1[i] = sigmoidf_(hi[i] + b1[i]); }
            store_bf8(SIG + (size_t)row * 2048 + cc, o0, o1); }
        else { if (col < 6160) { *(f32x4*)(GA + (size_t)row * 16 + (col - 6144)) = lo; *(f32x4*)(GA + (size_t)row * 16 + (col - 6144) + 4) = hi; } }
    }
    template <int MODE> __device__ __forceinline__ void row(const pg8::Unit& u, int r, int c8, f32x4 a0, f32x4 a1, f32x4 b0, f32x4 b1) const {
        half8<MODE>(u.row0 + r, u.col0 + c8, a0, a1); half8<MODE>(u.row0 + r, u.col0 + 128 + c8, b0, b1);
    }
};
struct F2 {
    static constexpr int NMODES = 1;
    const bf16* O; bf16* V;
    template <int MODE> __device__ __forceinline__ void at(const pg8::Unit& u, int r, int c, f32x4 v) const {
        const size_t off = (size_t)(u.row0 + r) * 2048 + u.col0 + c; bf16* p = V + off; const f32x4 o = load_bf4(O + off);
        f32x4 w; w[0] = siluf_(v[0]) * o[0]; w[1] = siluf_(v[1]) * o[1]; w[2] = siluf_(v[2]) * o[2]; w[3] = siluf_(v[3]) * o[3];
        store_bf4(p, w);
    }
    __device__ __forceinline__ void half8(size_t off, f32x4 lo, f32x4 hi) const {
        f32x4 o0, o1; load_bf8(O + off, o0, o1);
#pragma unroll
        for (int i = 0; i < 4; ++i) { o0[i] *= siluf_(lo[i]); o1[i] *= siluf_(hi[i]); }
        store_bf8(V + off, o0, o1);
    }
    template <int MODE> __device__ __forceinline__ void row(const pg8::Unit& u, int r, int c8, f32x4 a0, f32x4 a1, f32x4 b0, f32x4 b1) const {
        const size_t off = (size_t)(u.row0 + r) * 2048 + u.col0 + c8; half8(off, a0, a1); half8(off + 128, b0, b1);
    }
};
struct F3 {
    static constexpr int NMODES = 1;
    bf16* MRG; const bf16* SIG; int second;
    template <int MODE> __device__ __forceinline__ void at(const pg8::Unit& u, int r, int c, f32x4 v) const {
        const int row = u.row0 + r, col = u.col0 + c; bf16* p = MRG + (size_t)row * 1024 + col;
        const f32x4 g = load_bf4(SIG + (size_t)row * 2048 + second * 1024 + col); f32x4 o = g * v;
        if (second) o = o + load_bf4(p);
        store_bf4(p, o);
    }
    __device__ __forceinline__ void half8(int row, int col, f32x4 lo, f32x4 hi) const {
        bf16* p = MRG + (size_t)row * 1024 + col; f32x4 g0, g1; load_bf8(SIG + (size_t)row * 2048 + second * 1024 + col, g0, g1);
        f32x4 o0 = g0 * lo, o1 = g1 * hi;
        if (second) { f32x4 m0, m1; load_bf8(p, m0, m1); o0 = o0 + m0; o1 = o1 + m1; }
        store_bf8(p, o0, o1);
    }
    template <int MODE> __device__ __forceinline__ void row(const pg8::Unit& u, int r, int c8, f32x4 a0, f32x4 a1, f32x4 b0, f32x4 b1) const {
        half8(u.row0 + r, u.col0 + c8, a0, a1); half8(u.row0 + r, u.col0 + 128 + c8, b0, b1);
    }
};
struct F4 {
    static constexpr int NMODES = 1;
    const float* RES; float* OUT;
    template <int MODE> __device__ __forceinline__ void at(const pg8::Unit& u, int r, int c, f32x4 v) const {
        const size_t o = (size_t)(u.row0 + r) * 1024 + u.col0 + c; const f32x4 h = *(const f32x4*)(RES + o);
        *(f32x4*)(OUT + o) = h * ALPHA + v;
    }
};
struct F5 {
    static constexpr int NMODES = 1;
    bf16* U; int ldu;
    template <int MODE> __device__ __forceinline__ void row(const pg8::Unit& u, int r, int c8, f32x4 a0, f32x4 a1, f32x4 b0, f32x4 b1) const {
        f32x4 o0, o1;
#pragma unroll
        for (int i = 0; i < 4; ++i) { o0[i] = siluf_(a0[i]) * b0[i]; o1[i] = siluf_(a1[i]) * b1[i]; }
        store_bf8(U + (size_t)(u.row0 + r) * ldu + (u.col0 >> 1) + c8, o0, o1);
    }
    __device__ __forceinline__ void pair(int r, int f, f32x4 g, f32x4 uu) const {
        f32x4 o; o[0] = siluf_(g[0]) * uu[0]; o[1] = siluf_(g[1]) * uu[1]; o[2] = siluf_(g[2]) * uu[2]; o[3] = siluf_(g[3]) * uu[3];
        store_bf4(U + (size_t)r * ldu + f, o);
    }
};
struct F6M {
    static constexpr int NMODES = 1;
    bf16* Y; int second;
    template <int MODE> __device__ __forceinline__ void at(const pg8::Unit& u, int r, int c, f32x4 v) const {
        if (r >= u.nvalid) return;
        bf16* p = Y + (size_t)(u.row0 + r) * 1024 + u.col0 + c;
        if (second) v = v + load_bf4(p);
        store_bf4(p, v);
    }
    template <int MODE> __device__ __forceinline__ void row(const pg8::Unit& u, int r, int c8, f32x4 a0, f32x4 a1, f32x4 b0, f32x4 b1) const {
        if (r >= u.nvalid) return;
        bf16* p = Y + (size_t)(u.row0 + r) * 1024 + u.col0 + c8;
        if (second) { f32x4 m0, m1; load_bf8(p, m0, m1); a0 = a0 + m0; a1 = a1 + m1; load_bf8(p + 128, m0, m1); b0 = b0 + m0; b1 = b1 + m1; }
        store_bf8(p, a0, a1); store_bf8(p + 128, b0, b1);
    }
};
struct F6Mm {
    static constexpr int NMODES = 1;
    float* Y; int second;
    template <int MODE> __device__ __forceinline__ void at(const pg8::Unit& u, int r, int c, f32x4 v) const {
        float* p = Y + (size_t)r * 1024 + u.col0 + c;
        if (second) v = v + *(const f32x4*)p;
        *(f32x4*)p = v;
    }
};

struct SchedMoeUp {
    static constexpr bool GATHER = true;
    volatile LAS unsigned* T; const int* perm; const char* A; const char* W; int G, c, hf;
    __device__ bool next(int i, pg8::Unit& u) const {
        const int TT = (int)T[32]; const long L = (long)i * G + c; if (L >= (long)TT * 14) return false;
        const int gt = (int)(L / 14), pn = (int)(L % 14); int e = 0;
#pragma unroll
        for (int j = 1; j < 8; ++j) e += (gt >= (int)T[24 + j]) ? 1 : 0;
        u.A = A; u.B = W + ((size_t)(e * 2 + hf) * DFFE + (size_t)pn * 256) * (D * 2); u.row0 = gt * 256; u.col0 = pn * 256; u.e = e; u.nvalid = gt - (int)T[24 + e];
        return true;
    }
    __device__ __forceinline__ unsigned a_off(const pg8::Unit& u, int R, int h) const {
        const int rank = u.nvalid * 256 + h * 128 + R, cnt = (int)T[16 + u.e];
        const int tok = perm[u.e * M + (rank < cnt ? rank : 0)];
        return (unsigned)tok * (unsigned)(D * 2);
    }
};
struct SchedMoeDown {
    static constexpr bool GATHER = false;
    volatile LAS unsigned* T; const char* A; const char* W; int G, c, hf;
    __device__ bool next(int i, pg8::Unit& u) const {
        const int TT = (int)T[32]; const long L = (long)i * G + c; if (L >= (long)TT * 4) return false;
        const int gt = (int)(L / 4), pn = (int)(L % 4); int e = 0;
#pragma unroll
        for (int j = 1; j < 8; ++j) e += (gt >= (int)T[24 + j]) ? 1 : 0;
        const int ti = gt - (int)T[24 + e], cnt = (int)T[16 + e];
        u.A = A + (size_t)gt * 256 * (HFF * 2); u.B = W + ((size_t)(e * 2 + hf) * D + (size_t)pn * 256) * (HFF * 2);
        u.row0 = (int)T[40 + e] + ti * 256; u.col0 = pn * 256; u.e = e; u.nvalid = (cnt - ti * 256) < 256 ? (cnt - ti * 256) : 256;
        return true;
    }
    __device__ __forceinline__ unsigned a_off(const pg8::Unit&, int R, int h) const { return (unsigned)(h * 128 + R) * (unsigned)(HFF * 2); }
};

__device__ __forceinline__ int map_b1(int n) {
    if (n < 1024) return n;
    if (n < 2048) { const int t = n - 1024, blk = t >> 9, hh = (t >> 7) & 3, j = t & 127; return (blk ? 3600 : 3088) + hh * 128 + (j >> 1) + 64 * (j & 1); }
    if (n < 3072) return 1024 + (n - 2048);
    if (n < 4096) return 4112 + (n - 3072);
    if (n < 5120) return 6160 + (n - 4096);
    if (n < 6144) return 7184 + (n - 5120);
    if (n < 6160) return 3072 + (n - 6144);
    return -1;
}
__device__ __forceinline__ int map_b2(int n) { return n < 1024 ? 2048 + n : 5136 + (n - 1024); }
__device__ __forceinline__ void cvt_item(const float* W, const float* W2, int kind, int foff, int ldsrc, int koff, int K, bf16* WT, LAS float* scr, int item, int lane) {
    const int nkb = K / 64, nb = item / nkb, kb = item % nkb, k0 = 64 * kb, n0 = 32 * nb;
    const int n = n0 + (lane & 31);
    int col; const float* src = W;
    if (kind == 0) col = n; else if (kind == 1) col = map_b1(n); else if (kind == 2) col = map_b2(n);
    else { col = foff + 128 * (n >> 8) + (n & 127); if (n & 128) src = W2; }
#pragma unroll 8
    for (int i = 0; i < 32; ++i) { const int kk = 2 * i + (lane >> 5); scr[kk * 33 + (lane & 31)] = (col >= 0) ? src[(size_t)(koff + k0 + kk) * ldsrc + col] : 0.f; }
    LDS_WAIT(); asm volatile("" ::: "memory");
    const int c = lane & 7;
#pragma unroll
    for (int j = 0; j < 4; ++j) { const int nn = (lane >> 3) + 8 * j; const LAS float* s = scr + (8 * c) * 33 + nn;
        u32x4 o; o.x = pk2(s[0 * 33], s[1 * 33]); o.y = pk2(s[2 * 33], s[3 * 33]); o.z = pk2(s[4 * 33], s[5 * 33]); o.w = pk2(s[6 * 33], s[7 * 33]);
        *(u32x4*)(WT + (size_t)(n0 + nn) * K + k0 + 8 * c) = o; }
    LDS_WAIT(); asm volatile("" ::: "memory");
}
__device__ __forceinline__ void cvt_job(const Frame& F, int& rot, const float* W, const float* W2, int kind, int foff, int ldsrc, int koff, int K, int Nnew, bf16* WT) {
    LAS float* scr = (LAS float*)(F.lds + F.wave * 16384);
    const int items = (K / 64) * (Nnew / 32);
    int start = F.gwave - rot; if (start < 0) start += F.gwaves;
    for (int it = start; it < items; it += F.gwaves) cvt_item(W, W2, kind, foff, ldsrc, koff, K, WT, scr, it, F.lane);
    rot = (rot + items) % F.gwaves;
}

__device__ __forceinline__ void ln_vals(f32x4 (&v)[4], const float* g, const float* b, int lane) {
    float s = 0.f;
#pragma unroll
    for (int j = 0; j < 4; ++j) s += (v[j][0] + v[j][1]) + (v[j][2] + v[j][3]);
    const float mean = wave_sum(s) * (1.f / D); float s2 = 0.f;
#pragma unroll
    for (int j = 0; j < 4; ++j) { v[j] = v[j] - mean; s2 += (v[j][0] * v[j][0] + v[j][1] * v[j][1]) + (v[j][2] * v[j][2] + v[j][3] * v[j][3]); }
    const float rstd = 1.f / sqrtf(wave_sum(s2) * (1.f / D) + LN_EPS);
#pragma unroll
    for (int j = 0; j < 4; ++j) { const f32x4 gg = *(const f32x4*)(g + 4 * lane + 256 * j), bb = *(const f32x4*)(b + 4 * lane + 256 * j); v[j] = v[j] * rstd * gg + bb; }
}
__device__ __forceinline__ void row_load(f32x4 (&v)[4], const float* p, int lane) {
#pragma unroll
    for (int j = 0; j < 4; ++j) v[j] = *(const f32x4*)(p + 4 * lane + 256 * j);
}
__device__ __forceinline__ void row_store(const f32x4 (&v)[4], float* p, bf16* pb, int lane, int dry = 0) {
    if (dry) return;
#pragma unroll
    for (int j = 0; j < 4; ++j) { *(f32x4*)(p + 4 * lane + 256 * j) = v[j]; store_bf4(pb + 4 * lane + 256 * j, v[j]); }
}
__device__ __forceinline__ void route_row(const f32x4 (&v)[4], const float* wr, int lane, int& e1, int& e2, float& w1, float& w2) {
    float lg[8];
#pragma unroll
    for (int e = 0; e < 8; ++e) lg[e] = 0.f;
#pragma unroll
    for (int j = 0; j < 4; ++j)
#pragma unroll
        for (int q = 0; q < 4; ++q) { const float* w = wr + (size_t)(4 * lane + 256 * j + q) * 8; const f32x4 wa = *(const f32x4*)w, wb = *(const f32x4*)(w + 4); const float x = v[j][q];
            lg[0] += x * wa[0]; lg[1] += x * wa[1]; lg[2] += x * wa[2]; lg[3] += x * wa[3]; lg[4] += x * wb[0]; lg[5] += x * wb[1]; lg[6] += x * wb[2]; lg[7] += x * wb[3]; }
#pragma unroll
    for (int e = 0; e < 8; ++e) lg[e] = wave_sum(lg[e]);
    int a = 0; float la = lg[0];
#pragma unroll
    for (int e = 1; e < 8; ++e) if (lg[e] > la) { la = lg[e]; a = e; }
    int b = -1; float lb = -3.0e38f;
#pragma unroll
    for (int e = 0; e < 8; ++e) if (e != a && lg[e] > lb) { lb = lg[e]; b = e; }
    const float t = __expf(lb - la);
    e1 = a; e2 = b; w1 = 1.f / (1.f + t); w2 = t / (1.f + t);
}

constexpr int MX_QIN = 0, MX_KIN = 33792, MX_P = 67584, MX_OB = 84224, MX_VT = 100608  ;
constexpr int MX_GA = 133376, MX_SEG = 137472  , MX_DEC = 139520  , MX_END = 140032;
static_assert(MX_END <= MISC_OFF, "mixer LDS below the MISC words");
struct MixArgs {
    bf16* QK; bf16* V; const float* GA;
    bf16* mQK; bf16* mV; const float* mGA; bf16* mO;
    const float* wa2; const float* ba; const float* gng; const float* rng; const float* rnb;
    int dry;
};
__device__ __forceinline__ void mixer_phase(const Frame& F, const MixArgs& a) {
    LAS float* qin = (LAS float*)(F.lds + MX_QIN); LAS float* kin = (LAS float*)(F.lds + MX_KIN); LAS float* P = (LAS float*)(F.lds + MX_P);
    LAS float* ob = (LAS float*)(F.lds + MX_OB); LAS bf16* vt = (LAS bf16*)(F.lds + MX_VT); LAS float* bc = (LAS float*)(F.lds + MX_P);
    LAS float* gab = (LAS float*)(F.lds + MX_GA); LAS float* seg = (LAS float*)(F.lds + MX_SEG); LAS float* dec = (LAS float*)(F.lds + MX_DEC);
    const int tid = F.tid, lane = F.lane, wave = F.wave, vv = tid & 255, dh = tid >> 8;
    for (int it = F.bid; it < NB * 8; it += F.G) {
        const int b = it >> 3, type = (it >> 2) & 1, head = it & 3;
        const int qcol = (type ? 1024 : 0) + head * 128, kcol = qcol + 512, vcol = type * 1024 + head * 256;
        const float lng = __logf(1.0f - exp2f(-5.0f - (float)head));
        float S[64];
#pragma unroll
        for (int i = 0; i < 64; ++i) S[i] = 0.f;
        const int gd = tid & 127, gi = tid >> 7;
        float wa[16]; float bad = 0.f;
        if (type == 0) {
#pragma unroll
            for (int r = 0; r < 16; ++r) wa[r] = a.wa2[r * 512 + head * 128 + gd];
            bad = a.ba[head * 128 + gd];
        } else {
#pragma unroll
            for (int r = 0; r < 16; ++r) wa[r] = 0.f;
        }
#pragma unroll 1
        for (int ch = -1; ch < 32; ++ch) {
            const bool meta = ch < 0;
            const bf16* qkb = meta ? a.mQK : a.QK + (size_t)(b * SEQ + ch * 64) * 2048;
            bf16* vb = meta ? a.mV : a.V + (size_t)(b * SEQ + ch * 64) * 2048;
            const float* gb = meta ? a.mGA : a.GA + (size_t)(b * SEQ + ch * 64) * 16;
            const int roff = meta ? 48 : 0;
            __syncthreads();
            for (int e = tid; e < 64 * 32; e += NTHR) {
                const int i = e >> 5, c4 = (e & 31) * 4; f32x4 q = (f32x4){0.f, 0.f, 0.f, 0.f}, k = q;
                if (i >= roff) { q = load_bf4(qkb + (size_t)(i - roff) * 2048 + qcol + c4); k = load_bf4(qkb + (size_t)(i - roff) * 2048 + kcol + c4); }
                *(LAS f32x4*)(qin + i * 132 + c4) = q; *(LAS f32x4*)(kin + i * 132 + c4) = k;
            }
            for (int e = tid; e < 64 * 64; e += NTHR) {
                const int i = e >> 6, c4 = (e & 63) * 4; u32x2 w; w.x = 0u; w.y = 0u;
                if (i >= roff) w = *(const u32x2*)(vb + (size_t)(i - roff) * 2048 + vcol + c4);
                *(LAS u32x2*)(vt + i * 256 + c4) = w;
            }
            if (type == 0) for (int e = tid; e < 64 * 16; e += NTHR) { const int i = e >> 4; gab[e] = (i >= roff) ? gb[(size_t)(i - roff) * 16 + (e & 15)] : 0.f; }
            __syncthreads();
            if (type == 0) {
                float run = 0.f;
#pragma unroll 4
                for (int ii = 0; ii < 16; ++ii) { const int i = gi * 16 + ii; float pre = bad;
#pragma unroll
                    for (int r = 0; r < 16; ++r) pre += gab[i * 16 + r] * wa[r];
                    const float ls = fminf(pre, 0.f) - log1pf(__expf(-fabsf(pre)));
                    run += (i >= roff) ? ls * (1.0f / 16.0f) : 0.f; bc[i * 128 + gd] = run; }
                seg[gi * 128 + gd] = run;
                __syncthreads();
                float off = 0.f;
#pragma unroll
                for (int g = 0; g < 4; ++g) off += (g < gi) ? seg[g * 128 + gd] : 0.f;
                if (gi == 3) dec[gd] = __expf(off + run);
#pragma unroll 4
                for (int ii = 0; ii < 16; ++ii) { const int i = gi * 16 + ii; const float bb = bc[i * 128 + gd] + off;
                    qin[i * 132 + gd] *= __expf(bb); kin[i * 132 + gd] *= __expf(-bb); }
            } else {
#pragma unroll 4
                for (int ii = 0; ii < 16; ++ii) { const int i = gi * 16 + ii; const float bb = (float)(i + 1) * lng;
                    qin[i * 132 + gd] *= __expf(bb); kin[i * 132 + gd] *= __expf(-bb); }
                if (gi == 3) dec[gd] = __expf(64.0f * lng);
            }
            __syncthreads();
            {
                const int i = tid >> 3, j0 = (tid & 7) * 8; float sc[8];
#pragma unroll
                for (int jj = 0; jj < 8; ++jj) sc[jj] = 0.f;
                for (int d4 = 0; d4 < 128; d4 += 4) { const f32x4 q = *(const LAS f32x4*)(qin + i * 132 + d4);
#pragma unroll
                    for (int jj = 0; jj < 8; ++jj) { const f32x4 k = *(const LAS f32x4*)(kin + (j0 + jj) * 132 + d4); sc[jj] += (q[0] * k[0] + q[1] * k[1]) + (q[2] * k[2] + q[3] * k[3]); } }
                __syncthreads();
#pragma unroll
                for (int jj = 0; jj < 8; ++jj) P[i * 65 + j0 + jj] = (j0 + jj <= i) ? sc[jj] : 0.f;
            }
            __syncthreads();
#pragma unroll 1
            for (int p = 0; p < 8; ++p) {
#pragma unroll 1
                for (int ii = 0; ii < 8; ++ii) { const int i = p * 8 + ii; float s = 0.f;
#pragma unroll
                    for (int d4 = 0; d4 < 64; d4 += 4) { const f32x4 q = *(const LAS f32x4*)(qin + i * 132 + dh * 64 + d4); s += (q[0] * S[d4] + q[1] * S[d4 + 1]) + (q[2] * S[d4 + 2] + q[3] * S[d4 + 3]); }
                    const int jlo = dh ? (i >> 1) + 1 : 0, jhi = dh ? i : (i >> 1);
                    for (int j = jlo; j <= jhi; ++j) s += P[i * 65 + j] * bf2f(vt[j * 256 + vv]);
                    ob[(dh * 8 + ii) * 256 + vv] = s; }
                __syncthreads();
                {
                    const int ii = wave, i = p * 8 + ii;
                    const f32x4 o = *(const LAS f32x4*)(ob + ii * 256 + lane * 4) + *(const LAS f32x4*)(ob + (8 + ii) * 256 + lane * 4);
                    f32x4 y;
                    if (type == 0) {
                        const float ss = wave_sum((o[0] * o[0] + o[1] * o[1]) + (o[2] * o[2] + o[3] * o[3]));
                        const float rs = 1.0f / sqrtf(ss * (1.0f / 256.0f) + LN_EPS);
                        const f32x4 g = *(const f32x4*)(a.gng + lane * 4); y = o * rs * g;
                    } else {
                        const float mu = wave_sum((o[0] + o[1]) + (o[2] + o[3])) * (1.0f / 256.0f); const f32x4 dd = o - mu;
                        const float var = wave_sum((dd[0] * dd[0] + dd[1] * dd[1]) + (dd[2] * dd[2] + dd[3] * dd[3])) * (1.0f / 256.0f);
                        const float rs = 1.0f / sqrtf(var + GN_EPS);
                        const f32x4 g = *(const f32x4*)(a.rng + head * 256 + lane * 4), bb = *(const f32x4*)(a.rnb + head * 256 + lane * 4); y = dd * rs * g + bb;
                    }
                    if (i >= roff && (!meta || b == 0) && !a.dry) store_bf4((meta ? a.mO : vb) + (size_t)(i - roff) * 2048 + vcol + lane * 4, y);
                }
                __syncthreads();
            }
#pragma unroll 1
            for (int j = 0; j < 64; ++j) { const float vj = bf2f(vt[j * 256 + vv]);
#pragma unroll
                for (int d4 = 0; d4 < 64; d4 += 4) { const f32x4 k = *(const LAS f32x4*)(kin + j * 132 + dh * 64 + d4); S[d4] += k[0] * vj; S[d4 + 1] += k[1] * vj; S[d4 + 2] += k[2] * vj; S[d4 + 3] += k[3] * vj; } }
#pragma unroll
            for (int d4 = 0; d4 < 64; d4 += 4) { const f32x4 dc = *(const LAS f32x4*)(dec + dh * 64 + d4); S[d4] *= dc[0]; S[d4 + 1] *= dc[1]; S[d4 + 2] *= dc[2]; S[d4 + 3] *= dc[3]; }
        }
    }
    __syncthreads();
}

typedef float f32x16 __attribute__((ext_vector_type(16)));
typedef short s16x4 __attribute__((ext_vector_type(4)));
constexpr int QROW = 272, PROW = 144, KTROW = 144, OROWF = 260;
constexpr int FM_QIN = 0, FM_KIN = 17408, FM_PT = 34816, FM_KT = 44032  , FM_OT = 0  ,
              FM_VS = 66560  , FM_SEG = 99328, FM_DEC = 101376, FM_END = 101888;
static_assert(FM_KT + 128 * KTROW <= FM_VS && FM_END <= MISC_OFF, "fast mixer LDS map");
__device__ __forceinline__ bf16x8 pack8(float a0, float a1, float a2, float a3, float a4, float a5, float a6, float a7) {
    u32x4 p; p.x = pk2_sw(a0, a1); p.y = pk2_sw(a2, a3); p.z = pk2_sw(a4, a5); p.w = pk2_sw(a6, a7); return __builtin_bit_cast(bf16x8, p);
}
__device__ __forceinline__ void mixer_fast(const Frame& F, const MixArgs& a) {
    LAS unsigned char* L = F.lds;
    LAS float* seg = (LAS float*)(L + FM_SEG); LAS float* dec = (LAS float*)(L + FM_DEC); LAS float* ot = (LAS float*)(L + FM_OT);
    const int tid0 = F.tid, wave = F.wave;
    const int gi = __builtin_amdgcn_readfirstlane(tid0 >> 7);
    LAS unsigned char* slab = L + FM_VS + wave * 4096;
    for (int it = F.bid; it < NB * 8; it += F.G) {
        int tid = tid0; asm volatile("" : "+v"(tid));
        int lane = tid & 63, gd = tid & 127, l32 = lane & 31, hh = lane >> 5, l16 = lane & 15, quad = lane >> 4;
        const int b = it >> 3, type = (it >> 2) & 1, head = it & 3;
        const int qcol = (type ? 1024 : 0) + head * 128, kcol = qcol + 512, vcol = type * 1024 + head * 256;
        const float lng = __logf(1.0f - exp2f(-5.0f - (float)head));
        f32x16 S[4];
#pragma unroll
        for (int T = 0; T < 4; ++T)
#pragma unroll
            for (int r = 0; r < 16; ++r) S[T][r] = 0.f;
        unsigned qk[16];
        { const unsigned qoff = (unsigned)(qcol + gd) * 2u, koff = (unsigned)(kcol + gd) * 2u;
#pragma unroll
        for (int ii = 0; ii < 16; ++ii) qk[ii] = 0u;
        if (gi == 3) {
#pragma unroll
            for (int ii = 0; ii < 16; ++ii) { const char* rb = (const char*)a.mQK + (size_t)ii * 4096; qk[ii] = (unsigned)*(const bf16*)(rb + qoff) | ((unsigned)*(const bf16*)(rb + koff) << 16); }
        } }
        {
            const u32x4 z = (u32x4){0u, 0u, 0u, 0u};
#pragma unroll
            for (int j = 0; j < 3; ++j) *(LAS u32x4*)(slab + j * 1024 + lane * 16) = z;
            __builtin_amdgcn_global_load_lds((const unsigned*)(a.mV + (size_t)(lane >> 2) * 2048 + vcol + 32 * wave + 8 * (lane & 3)), (LAS unsigned*)(slab + 3 * 1024), 16, 0, 0);
        }
#pragma unroll 1
        for (int ch = -1; ch < 32; ++ch) {
            const bool meta = ch < 0;
            bf16* vb = meta ? a.mV : a.V + (size_t)(b * SEQ + ch * 64) * 2048;
            const float* gb = meta ? a.mGA : a.GA + (size_t)(b * SEQ + ch * 64) * 16;
            const int roff = meta ? 48 : 0;
            int gio = gi; asm volatile("" : "+s"(gio));
            tid = tid0; asm volatile("" : "+v"(tid));
            lane = tid & 63; gd = tid & 127; l32 = lane & 31; hh = lane >> 5; l16 = lane & 15; quad = lane >> 4;
            const unsigned qoff = (unsigned)(qcol + gd) * 2u, koff = (unsigned)(kcol + gd) * 2u;
            float bcs[16]; float run = 0.f;
            if (type == 0) {
                float wa[16]; const float bad = a.ba[head * 128 + gd];
#pragma unroll
                for (int r = 0; r < 16; ++r) wa[r] = a.wa2[r * 512 + head * 128 + gd];
#pragma unroll
                for (int ii = 0; ii < 16; ++ii) { const int c = gio * 16 + ii; float ls = 0.f;
                    if (c >= roff) { const float* gr = gb + (size_t)(c - roff) * 16; float pre = bad;
#pragma unroll
                        for (int r = 0; r < 16; ++r) pre += gr[r] * wa[r];
                        ls = (fminf(pre, 0.f) - __logf(1.0f + __expf(-fabsf(pre)))) * (1.0f / 16.0f); }
                    run += ls; bcs[ii] = run; }
                seg[gio * 128 + gd] = run;
            } else {
#pragma unroll
                for (int ii = 0; ii < 16; ++ii) bcs[ii] = (float)(gio * 16 + ii + 1) * lng;
            }
            __syncthreads();
            float off = 0.f;
            if (type == 0) {
#pragma unroll
                for (int g = 0; g < 4; ++g) off += (g < gio) ? seg[g * 128 + gd] : 0.f;
                if (gio == 3) dec[gd] = __expf(off + run);
            } else if (gio == 3) dec[gd] = __expf(64.0f * lng);
            {
                unsigned kt[8];
#pragma unroll
                for (int ii = 0; ii < 16; ++ii) { const int c = gio * 16 + ii; const float bb = bcs[ii] + off; const float eb = __expf(bb), en = __expf(-bb);
                    const unsigned qv = f2bf(bf2f(qk[ii]) * eb), kv = f2bf(bf2f(qk[ii] >> 16) * en);
                    *(LAS bf16*)(L + FM_QIN + c * QROW + gd * 2) = (bf16)qv; *(LAS bf16*)(L + FM_KIN + c * QROW + gd * 2) = (bf16)kv;
                    if (ii & 1) kt[ii >> 1] |= kv << 16; else kt[ii >> 1] = kv; }
                *(LAS u32x4*)(L + FM_KT + gd * KTROW + gio * 32) = (u32x4){kt[0], kt[1], kt[2], kt[3]};
                *(LAS u32x4*)(L + FM_KT + gd * KTROW + gio * 32 + 16) = (u32x4){kt[4], kt[5], kt[6], kt[7]};
            }
            __syncthreads();
#pragma unroll 1
            for (int tt = wave; tt < 10; tt += 8) {
                const int ti = (tt >= 6) ? 3 : (tt >= 3) ? 2 : (tt >= 1) ? 1 : 0, tj = tt - ti * (ti + 1) / 2;
                f32x4 pacc = (f32x4){0.f, 0.f, 0.f, 0.f};
#pragma unroll
                for (int ks = 0; ks < 4; ++ks) {
                    const bf16x8 A = *(const LAS bf16x8*)(L + FM_QIN + (16 * ti + l16) * QROW + (32 * ks + 8 * quad) * 2);
                    const bf16x8 B = *(const LAS bf16x8*)(L + FM_KIN + (16 * tj + l16) * QROW + (32 * ks + 8 * quad) * 2);
                    pacc = __builtin_amdgcn_mfma_f32_16x16x32_bf16(A, B, pacc, 0, 0, 0);
                }
#pragma unroll
                for (int jj = 0; jj < 4; ++jj) { const int row = 16 * ti + 4 * quad + jj, col = 16 * tj + l16;
                    *(LAS bf16*)(L + FM_PT + row * PROW + col * 2) = (bf16)f2bf((col > row) ? 0.f : pacc[jj]); }
            }
            if (wave == 2 || wave == 3) {
                const int ti = (wave == 2) ? 0 : 2, tj = ti + 1;
#pragma unroll
                for (int jj = 0; jj < 4; ++jj) *(LAS bf16*)(L + FM_PT + (16 * ti + 4 * quad + jj) * PROW + (16 * tj + l16) * 2) = (bf16)0;
            }
            if (ch < 31) { const bf16* nq = a.QK + (size_t)(b * SEQ + (ch + 1) * 64 + gi * 16) * 2048;
#pragma unroll
                for (int ii = 0; ii < 16; ++ii) { const char* rb = (const char*)nq + (size_t)ii * 4096; qk[ii] = (unsigned)*(const bf16*)(rb + qoff) | ((unsigned)*(const bf16*)(rb + koff) << 16); } }
            asm volatile("s_waitcnt vmcnt(0)" ::: "memory");
            __syncthreads();
            bf16x8 vf[4];
            {
                const unsigned base = (unsigned)(size_t)(slab + (8 * hh + (l16 >> 2)) * 64 + 32 * (quad & 1) + 8 * (l16 & 3));
                s16x4 t0, t1, t2, t3, t4, t5, t6, t7;
                asm volatile("ds_read_b64_tr_b16 %0, %8\n\tds_read_b64_tr_b16 %1, %8 offset:256\n\tds_read_b64_tr_b16 %2, %8 offset:1024\n\tds_read_b64_tr_b16 %3, %8 offset:1280\n\t"
                             "ds_read_b64_tr_b16 %4, %8 offset:2048\n\tds_read_b64_tr_b16 %5, %8 offset:2304\n\tds_read_b64_tr_b16 %6, %8 offset:3072\n\tds_read_b64_tr_b16 %7, %8 offset:3328\n\ts_waitcnt lgkmcnt(0)"
                             : "=&v"(t0), "=&v"(t1), "=&v"(t2), "=&v"(t3), "=&v"(t4), "=&v"(t5), "=&v"(t6), "=&v"(t7) : "v"(base) : "memory");
                vf[0] = (bf16x8){t0[0], t0[1], t0[2], t0[3], t1[0], t1[1], t1[2], t1[3]}; vf[1] = (bf16x8){t2[0], t2[1], t2[2], t2[3], t3[0], t3[1], t3[2], t3[3]};
                vf[2] = (bf16x8){t4[0], t4[1], t4[2], t4[3], t5[0], t5[1], t5[2], t5[3]}; vf[3] = (bf16x8){t6[0], t6[1], t6[2], t6[3], t7[0], t7[1], t7[2], t7[3]};
            }
            __builtin_amdgcn_sched_barrier(0);
            f32x16 O[2];
#pragma unroll
            for (int mt = 0; mt < 2; ++mt)
#pragma unroll
                for (int r = 0; r < 16; ++r) O[mt][r] = 0.f;
#pragma unroll
            for (int mt = 0; mt < 2; ++mt)
#pragma unroll
                for (int ks = 0; ks < 2 * mt + 2; ++ks) {
                    const bf16x8 A = *(const LAS bf16x8*)(L + FM_PT + (32 * mt + l32) * PROW + (16 * ks + 8 * hh) * 2);
                    O[mt] = __builtin_amdgcn_mfma_f32_32x32x16_bf16(A, vf[ks], O[mt], 0, 0, 0);
                }
#pragma unroll
            for (int T = 0; T < 4; ++T)
#pragma unroll
                for (int s2 = 0; s2 < 2; ++s2) {
                    const bf16x8 Bs = pack8(S[T][8 * s2], S[T][8 * s2 + 1], S[T][8 * s2 + 2], S[T][8 * s2 + 3], S[T][8 * s2 + 4], S[T][8 * s2 + 5], S[T][8 * s2 + 6], S[T][8 * s2 + 7]);
#pragma unroll
                    for (int mt = 0; mt < 2; ++mt) {
                        const LAS unsigned char* qp = L + FM_QIN + (32 * mt + l32) * QROW + (32 * T + 16 * s2 + 4 * hh) * 2;
                        const u32x2 lo = *(const LAS u32x2*)qp, hi = *(const LAS u32x2*)(qp + 16);
                        const bf16x8 A = __builtin_bit_cast(bf16x8, (u32x4){lo.x, lo.y, hi.x, hi.y});
                        O[mt] = __builtin_amdgcn_mfma_f32_32x32x16_bf16(A, Bs, O[mt], 0, 0, 0);
                    }
                    __builtin_amdgcn_sched_barrier(0);
                }
#pragma unroll
            for (int T = 0; T < 4; ++T) {
#pragma unroll
                for (int ks = 0; ks < 4; ++ks) {
                    const bf16x8 A = *(const LAS bf16x8*)(L + FM_KT + (32 * T + l32) * KTROW + (16 * ks + 8 * hh) * 2);
                    S[T] = __builtin_amdgcn_mfma_f32_32x32x16_bf16(A, vf[ks], S[T], 0, 0, 0);
                }
#pragma unroll
                for (int q4 = 0; q4 < 4; ++q4) { const f32x4 dc = *(const LAS f32x4*)(dec + 32 * T + 8 * q4 + 4 * hh);
                    S[T][4 * q4] *= dc[0]; S[T][4 * q4 + 1] *= dc[1]; S[T][4 * q4 + 2] *= dc[2]; S[T][4 * q4 + 3] *= dc[3]; }
                __builtin_amdgcn_sched_barrier(0);
            }
            if (ch < 31) { const bf16* nv = a.V + (size_t)(b * SEQ + (ch + 1) * 64) * 2048 + vcol + 32 * wave + 8 * (lane & 3);
                asm volatile("s_waitcnt lgkmcnt(0)" ::: "memory");
#pragma unroll
                for (int j = 0; j < 4; ++j) __builtin_amdgcn_global_load_lds((const unsigned*)(nv + (size_t)(16 * j + (lane >> 2)) * 2048), (LAS unsigned*)(slab + j * 1024), 16, 0, 0); }
            __syncthreads();
#pragma unroll
            for (int mt = 0; mt < 2; ++mt)
#pragma unroll
                for (int r = 0; r < 16; ++r) ot[(32 * mt + (r & 3) + 8 * (r >> 2) + 4 * hh) * OROWF + 32 * wave + l32] = O[mt][r];
            __syncthreads();
#pragma unroll 2
            for (int rr = 0; rr < 8; ++rr) {
                const int i = wave * 8 + rr;
                const f32x4 o = *(const LAS f32x4*)(ot + i * OROWF + lane * 4);
                f32x4 y;
                if (type == 0) {
                    const float ss = wave_sum((o[0] * o[0] + o[1] * o[1]) + (o[2] * o[2] + o[3] * o[3]));
                    const float rs = __builtin_amdgcn_rsqf(ss * (1.0f / 256.0f) + LN_EPS);
                    const f32x4 g = *(const f32x4*)(a.gng + lane * 4); y = o * rs * g;
                } else {
                    const float mu = wave_sum((o[0] + o[1]) + (o[2] + o[3])) * (1.0f / 256.0f); const f32x4 dd = o - mu;
                    const float var = wave_sum((dd[0] * dd[0] + dd[1] * dd[1]) + (dd[2] * dd[2] + dd[3] * dd[3])) * (1.0f / 256.0f);
                    const float rs = __builtin_amdgcn_rsqf(var + GN_EPS);
                    const f32x4 g = *(const f32x4*)(a.rng + head * 256 + lane * 4), bb = *(const f32x4*)(a.rnb + head * 256 + lane * 4); y = dd * rs * g + bb;
                }
                if (i >= roff && (!meta || b == 0) && !a.dry) store_bf4((meta ? a.mO : vb) + (size_t)(i - roff) * 2048 + vcol + lane * 4, y);
            }
        }
        __syncthreads();
    }
}

typedef const __attribute__((address_space(4))) Args* KArgs;
__device__ __forceinline__ KArgs kargs() { KArgs p = (KArgs)__builtin_amdgcn_kernarg_segment_ptr(); asm volatile("" : "+s"(p)); return p; }
#define ENV() \
    KArgs A_ = kargs(); \
    Frame F; { int t_ = threadIdx.x; asm volatile("" : "+v"(t_)); int b_ = blockIdx.x; asm volatile("" : "+s"(b_)); \
        { LAS unsigned char* l_ = (LAS unsigned char*)lds_raw; asm volatile("" : "+s"(l_)); F.lds = l_; } F.MISC = (volatile LAS unsigned*)(F.lds + MISC_OFF); F.tid = t_; F.lane = t_ & 63; F.wave = __builtin_amdgcn_readfirstlane(t_ >> 6); \
        F.G = gridDim.x; F.bid = b_; F.gtid = b_ * NTHR + t_; F.gthreads = F.G * NTHR; F.gwave = b_ * NWAVES + F.wave; F.gwaves = F.G * NWAVES; F.ws = A_->ws; F.ctl = (unsigned*)(A_->ws + WS_CTL); } \
    unsigned char* ws = A_->ws; typedef const float* cfp_; const __attribute__((address_space(4))) cfp_* in = A_->in; \
    float* XA = (float*)(ws + WS_XA); float* XB = A_->out; bf16* XBF = (bf16*)(ws + WS_XBF); \
    bf16* QK = (bf16*)(ws + WS_QK); bf16* V = (bf16*)(ws + WS_V); float* GA = (float*)(ws + WS_GA); \
    bf16* MRG = QK; bf16* U = QK; const f32x2* rope = (const f32x2*)(ws + WS_ROPE); \
    unsigned char* mt = ws + WS_META; \
    float* mHA = (float*)(mt + MT_HA); float* mHB = (float*)(mt + MT_HB); bf16* mXB = (bf16*)(mt + MT_XB); bf16* mQK = (bf16*)(mt + MT_QK); bf16* mV = (bf16*)(mt + MT_V); \
    bf16* mSIG = (bf16*)(mt + MT_SIG); float* mGA = (float*)(mt + MT_GA); bf16* mMRG = (bf16*)(mt + MT_MRG); bf16* mU = (bf16*)(mt + MT_U); float* mY = (float*)(mt + MT_Y); \
    bf16* mUall = (bf16*)(ws + WS_META2); float* mYall = (float*)(ws + WS_META2 + 512 * 1024); (void)mUall; (void)mYall; \
    bf16* mO = (bf16*)(mt + MT_O); int* mTokE = (int*)(mt + MT_TOK); float* mTokW = (float*)(mt + MT_TOK + 128); \
    int* perm = (int*)(ws + WS_MOE); int* tok_slot = (int*)(ws + WS_MOE + 2 * MiB); float* tok_w = (float*)(ws + WS_MOE + 2 * MiB + 512 * 1024); \
    const bf16* B1t = (const bf16*)(ws + WS_W + W_B1); const bf16* B2t = (const bf16*)(ws + WS_W + W_B2); const bf16* PAt = (const bf16*)(ws + WS_W + W_PA); \
    const bf16* PBt = (const bf16*)(ws + WS_W + W_PB); const bf16* Ot = (const bf16*)(ws + WS_W + W_O); const bf16* FGU = (const bf16*)(ws + WS_W + W_F); \
    const bf16* FDd = (const bf16*)(ws + WS_W + W_FD_DENSE); const bf16* FDm = (const bf16*)(ws + WS_W + W_FD_MOE); \
    const float* hin = (l == 0) ? in[I_X] : (l == 1 ? XB : XA); float* x1buf = (l < 2) ? XA : XB; float* x2buf = (l == 0) ? XB : XA; \
    bf16* SIG = (bf16*)x1buf; bf16* Y = (bf16*)((l == 1) ? XB : XA); \
    const float* mhin = (l == 0) ? in[I_META] : (l == 1 ? mHB : mHA); float* mx1 = (l < 2) ? mHA : mHB; float* mx2 = (l == 0) ? mHB : mHA; \
    (void)XA; (void)XB; (void)XBF; (void)QK; (void)V; (void)GA; (void)MRG; (void)U; (void)rope; (void)mHA; (void)mHB; (void)mXB; (void)mQK; (void)mV; (void)mSIG; (void)mGA; (void)mMRG; (void)mU; (void)mY; \
    (void)mO; (void)mTokE; (void)mTokW; (void)perm; (void)tok_slot; (void)tok_w; (void)B1t; (void)B2t; (void)PAt; (void)PBt; (void)Ot; (void)FGU; (void)FDd; (void)FDm; (void)hin; (void)x1buf; (void)x2buf; \
    (void)SIG; (void)Y; (void)mhin; (void)mx1; (void)mx2; (void)in

__global__ void __launch_bounds__(NTHR, 2) fwd_kernel(Args args) {
    extern __shared__ __attribute__((aligned(16))) unsigned char lds_raw[];
    const int lo = args.ph_lo, hi = args.ph_hi;
    const bool multi = (hi - lo) > 1;
    {
        volatile LAS unsigned* MISC0 = (volatile LAS unsigned*)((LAS unsigned char*)lds_raw + MISC_OFF);
        for (int u = threadIdx.x; u < 256; u += NTHR) MISC0[u] = 0u;
        __syncthreads();
        if (multi) (void)xcd_barrier_post((unsigned*)(args.ws + WS_CTL) + CW_BAR, MISC0);
    }
#ifndef PH_MASK
#define PH_MASK 0xFFF
#endif
#define INS(slot, k) ((((PH_MASK) >> (slot)) & 1) && lo <= (k) && (k) < hi)
#define IN(k) (lo <= (k) && (k) < hi)
#define SEAM(k) do { if (IN(k) && IN((k) + 1)) { KArgs B_ = kargs(); XcdBarrier bar; bar.bar = (unsigned*)(B_->ws + WS_CTL) + CW_BAR; bar.x = xb_xcc_id(); \
        bar.st = (volatile LAS unsigned*)((LAS unsigned char*)lds_raw + MISC_OFF); xcd_barrier(bar); } } while (0)

    for (int l = 0; l < DEPTH; ++l) {
        const int pb = l * NPH;
        if (hi <= pb || lo >= pb + NPH) continue;
        const bool moe = (l & 1) != 0; const int l2 = l >> 1;
        if (INS(0, pb + 0)) { ENV();
            int rot = 0;
            const float* win = in[I_WIN] + (size_t)l * D * NIN;
            cvt_job(F, rot, win, nullptr, 1, 0, NIN, 0, D, N1, (bf16*)B1t);
            cvt_job(F, rot, win, nullptr, 2, 0, NIN, 0, D, 2048, (bf16*)B2t);
            cvt_job(F, rot, in[I_WPA] + (size_t)l * D * D, nullptr, 0, 0, D, 0, D, D, (bf16*)PAt);
            cvt_job(F, rot, in[I_WPB] + (size_t)l * D * D, nullptr, 0, 0, D, 0, D, D, (bf16*)PBt);
            cvt_job(F, rot, in[I_WO] + (size_t)l * D * D, nullptr, 0, 0, D, 0, D, D, (bf16*)Ot);
            if (!moe) {
                cvt_job(F, rot, in[I_FG] + (size_t)l2 * D * DFF, in[I_FU] + (size_t)l2 * D * DFF, 3, 0, DFF, 0, D, 2 * DFF, (bf16*)FGU);
                cvt_job(F, rot, in[I_FD] + (size_t)l2 * DFF * D, nullptr, 0, 0, D, 0, DFF, D, (bf16*)FDd);
            } else {
                for (int e = 0; e < NEXP; ++e)
                    for (int hf = 0; hf < 2; ++hf) {
                        const float* wg = in[I_MG] + ((size_t)l2 * NEXP + e) * D * DFFE; const float* wu = in[I_MU] + ((size_t)l2 * NEXP + e) * D * DFFE;
                        cvt_job(F, rot, wg, wu, 3, hf * HFF, DFFE, 0, D, DFFE, (bf16*)FGU + (size_t)(e * 2 + hf) * DFFE * D);
                        cvt_job(F, rot, in[I_MD] + ((size_t)l2 * NEXP + e) * DFFE * D, nullptr, 0, 0, D, hf * HFF, HFF, D, (bf16*)FDm + (size_t)(e * 2 + hf) * D * HFF);
                    }
                if (F.gtid < NEXP) F.ctl[CW_CNT + 64 * F.gtid] = 0u;
            }
            if (l == 0) {
                for (int i = F.gtid; i < 2064 * 64; i += F.gthreads) { const int pos = i >> 6, k = i & 63; const float inv = powf(10000.0f, -(float)k / 64.0f); const float ang = (float)pos * inv;
                    float sn, cs; sincosf(ang, &sn, &cs); ((f32x2*)rope)[i] = (f32x2){cs, sn}; }
                const float* x = in[I_X];
                for (size_t i = (size_t)F.gtid * 4; i < (size_t)M * D; i += (size_t)F.gthreads * 4) store_bf4(XBF + i, *(const f32x4*)(x + i));
                for (int i = F.gtid * 4; i < NMETA * D; i += F.gthreads * 4) store_bf4(mXB + i, *(const f32x4*)(in[I_META] + i));
            }
        }
        SEAM(pb + 0);

        if (INS(1, pb + 1)) { ENV();
            const float* bg = in[I_BGATE] + (size_t)l * 2 * D;
            { F1 f{mQK, mV, mSIG, mGA, rope, bg, 15, 0};
              meta_gemm(F, 1, N1, D, [=](int, int r) { return mXB + (size_t)r * D; }, [=](int, int c) { return B1t + (size_t)c * D; }, [=](int) { return f; }); }
            pg8::SchedDense S; S.init(M, N1, F.G, F.bid, XBF, D * 2, B1t, D * 2);
            pg8::EpiRow<F1> E{F1{QK, V, SIG, GA, rope, bg, 2047, 16}};
            pg8::gemm_phase<pg8::EpiRow<F1>, pg8::SchedDense>(F.lds, F.tid, S, E, D, D * 2, D * 2);
        }
        SEAM(pb + 1);

        if (INS(2, pb + 2)) { ENV();
            MixArgs ma{QK, V, GA, mQK, mV, mGA, mO, in[I_WA2] + (size_t)l * 16 * 512, in[I_BA] + (size_t)l * 512, in[I_GNG] + (size_t)l * 256,
                       in[I_RNG] + (size_t)l * 1024, in[I_RNB] + (size_t)l * 1024, 0};
#if MIXER_FAST
            if (PROBE_DUP & 2) { ma.dry = 1; mixer_fast(F, ma); ma.dry = 0; }
            mixer_fast(F, ma);
#else
            if (PROBE_DUP & 2) { ma.dry = 1; mixer_phase(F, ma); ma.dry = 0; }
            mixer_phase(F, ma);
#endif
        }
        SEAM(pb + 2);

        if (INS(3, pb + 3)) { ENV();
            { F2 f{mO, mV}; meta_gemm(F, 1, 2048, D, [=](int, int r) { return mXB + (size_t)r * D; }, [=](int, int c) { return B2t + (size_t)c * D; }, [=](int) { return f; }); }
            pg8::SchedDense S; S.init(M, 2048, F.G, F.bid, XBF, D * 2, B2t, D * 2);
            pg8::EpiRow<F2> E{F2{V, V}};
            pg8::gemm_phase<pg8::EpiRow<F2>, pg8::SchedDense>(F.lds, F.tid, S, E, D, D * 2, D * 2);
        }
        SEAM(pb + 3);

        if (INS(4, pb + 4)) { ENV();
#pragma unroll 1
            for (int pass = 0; pass < 2; ++pass) {
                const bf16* Wt = pass ? PBt : PAt;
                { F3 f{mMRG, mSIG, pass}; const bf16* mA = mV + pass * 1024; meta_gemm(F, 1, D, D, [=](int, int r) { return mA + (size_t)r * 2048; }, [=](int, int c) { return Wt + (size_t)c * D; }, [=](int) { return f; }); }
                pg8::SchedDense S; S.init(M, D, F.G, F.bid, V + pass * 1024, 2048 * 2, Wt, D * 2);
                pg8::EpiRow<F3> E{F3{MRG, SIG, pass}};
                pg8::gemm_phase<pg8::EpiRow<F3>, pg8::SchedDense>(F.lds, F.tid, S, E, D, 2048 * 2, D * 2);
            }
        }
        SEAM(pb + 4);

        if (INS(5, pb + 5)) { ENV();
            { F4 f{mhin, mx1}; meta_gemm(F, 1, D, D, [=](int, int r) { return mMRG + (size_t)r * D; }, [=](int, int c) { return Ot + (size_t)c * D; }, [=](int) { return f; }); }
            pg8::SchedDense S; S.init(M, D, F.G, F.bid, MRG, D * 2, Ot, D * 2);
            pg8::EpiEl<F4> E{F4{hin, x1buf}};
            pg8::gemm_phase<pg8::EpiEl<F4>, pg8::SchedDense>(F.lds, F.tid, S, E, D, D * 2, D * 2);
        }
        SEAM(pb + 5);

        if (INS(6, pb + 6)) { ENV();
            const float* g = in[I_LN1G] + (size_t)l * D; const float* bb = in[I_LN1B] + (size_t)l * D;
            const float* wrt = in[I_RT] + (size_t)l2 * D * NEXP;
#pragma unroll 1
            for (int rep = (PROBE_DUP & 4) ? 0 : 1; rep < 2; ++rep)
            for (int r = F.gwave; r < M + NMETA; r += F.gwaves) { const int dry = (rep == 0);
                const bool ism = r >= M; const int rr = ism ? r - M : r;
                float* p = ism ? mx1 + (size_t)rr * D : x1buf + (size_t)rr * D; bf16* pbf = ism ? mXB + (size_t)rr * D : XBF + (size_t)rr * D;
                f32x4 v[4]; row_load(v, p, F.lane); ln_vals(v, g, bb, F.lane); row_store(v, p, pbf, F.lane, dry);
                if (moe) {
                    int e1, e2; float w1, w2; route_row(v, wrt, F.lane, e1, e2, w1, w2);
                    if (F.lane == 0 && !dry) {
                        if (ism) { mTokE[rr * 2] = e1; mTokE[rr * 2 + 1] = e2; mTokW[rr * 2] = w1; mTokW[rr * 2 + 1] = w2; }
                        else {
                            const unsigned r1 = atomicAdd(F.ctl + CW_CNT + 64 * e1, 1u), r2 = atomicAdd(F.ctl + CW_CNT + 64 * e2, 1u);
                            perm[e1 * M + (int)r1] = rr; perm[e2 * M + (int)r2] = rr;
                            tok_slot[rr * 2] = (e1 << 16) | (int)r1; tok_slot[rr * 2 + 1] = (e2 << 16) | (int)r2; tok_w[rr * 2] = w1; tok_w[rr * 2 + 1] = w2;
                        }
                    }
                }
            }
        }
        SEAM(pb + 6);

        if (!moe) {
            if (INS(7, pb + 7)) { ENV();
                { F5 f{mU, DFF}; meta_gemm_pair(F, 1, DFF, D, [=](int, int r) { return mXB + (size_t)r * D; }, [=](int, int c) { return FGU + (size_t)c * D; }, [=](int) { return f; }); }
                pg8::SchedDense S; S.init(M, 2 * DFF, F.G, F.bid, XBF, D * 2, FGU, D * 2);
                pg8::EpiRow<F5> E{F5{U, DFF}};
                pg8::gemm_phase<pg8::EpiRow<F5>, pg8::SchedDense>(F.lds, F.tid, S, E, D, D * 2, D * 2);
            }
            SEAM(pb + 7);
            if (INS(8, pb + 8)) { ENV();
                { F4 f{mx1, mx2}; meta_gemm(F, 1, D, DFF, [=](int, int r) { return mU + (size_t)r * DFF; }, [=](int, int c) { return FDd + (size_t)c * DFF; }, [=](int) { return f; }); }
                pg8::SchedDense S; S.init(M, D, F.G, F.bid, U, DFF * 2, FDd, DFF * 2);
                pg8::EpiEl<F4> E{F4{x1buf, x2buf}};
                pg8::gemm_phase<pg8::EpiEl<F4>, pg8::SchedDense>(F.lds, F.tid, S, E, DFF, DFF * 2, DFF * 2);
            }
            SEAM(pb + 8);
            if (INS(11, pb + 11)) { ENV();
                const float* g = in[I_LN2G] + (size_t)l * D; const float* bb = in[I_LN2B] + (size_t)l * D;
    #pragma unroll 1
            for (int rep = (PROBE_DUP & 4) ? 0 : 1; rep < 2; ++rep)
            for (int r = F.gwave; r < M + NMETA; r += F.gwaves) { const int dry = (rep == 0);
                    const bool ism = r >= M; const int rr = ism ? r - M : r;
                    float* p = ism ? mx2 + (size_t)rr * D : x2buf + (size_t)rr * D; bf16* pbf = ism ? mXB + (size_t)rr * D : XBF + (size_t)rr * D;
                    f32x4 v[4]; row_load(v, p, F.lane); ln_vals(v, g, bb, F.lane); row_store(v, p, pbf, F.lane, dry);
                }
            }
            SEAM(pb + 11);
        } else {
            if (lo <= pb + 11 && hi > pb + 7) { ENV();
                if (F.tid == 0) {
                    unsigned ts = 0, cb = 0;
                    for (int e = 0; e < NEXP; ++e) { const unsigned c = __hip_atomic_load(F.ctl + CW_CNT + 64 * e, __ATOMIC_RELAXED, __HIP_MEMORY_SCOPE_AGENT);
                        F.MISC[16 + e] = c; F.MISC[24 + e] = ts; F.MISC[40 + e] = cb; ts += (c + 255u) >> 8; cb += c; }
                    F.MISC[32] = ts;
                }
                __syncthreads();
            }
#pragma unroll 1
            for (int hf = 0; hf < 2; ++hf) {
                if (INS(9, pb + 7 + 2 * hf)) { ENV();
                    meta_gemm_pair(F, NEXP, HFF, D, [=](int, int r) { return mXB + (size_t)r * D; }, [=](int e, int c) { return FGU + ((size_t)(e * 2 + hf) * DFFE + c) * D; },
                              [=](int e) { return F5{mUall + (size_t)e * NMETA * HFF, HFF}; });
                    SchedMoeUp S{F.MISC, perm, (const char*)XBF, (const char*)FGU, F.G, F.bid, hf};
                    pg8::EpiRow<F5> E{F5{U, HFF}};
                    pg8::gemm_phase<pg8::EpiRow<F5>, SchedMoeUp>(F.lds, F.tid, S, E, D, D * 2, D * 2);
                }
                SEAM(pb + 7 + 2 * hf);
                if (INS(10, pb + 8 + 2 * hf)) { ENV();
                    meta_gemm(F, NEXP, D, HFF, [=](int e, int r) { return mUall + ((size_t)e * NMETA + r) * HFF; }, [=](int e, int c) { return FDm + ((size_t)(e * 2 + hf) * D + c) * HFF; },
                              [=](int e) { return F6Mm{mYall + (size_t)e * NMETA * D, hf}; });
                    SchedMoeDown S{F.MISC, (const char*)U, (const char*)FDm, F.G, F.bid, hf};
                    pg8::EpiRow<F6M> E{F6M{Y, hf}};
                    pg8::gemm_phase<pg8::EpiRow<F6M>, SchedMoeDown>(F.lds, F.tid, S, E, HFF, HFF * 2, HFF * 2);
                }
                SEAM(pb + 8 + 2 * hf);
            }
            if (INS(11, pb + 11)) { ENV();
                const float* g = in[I_LN2G] + (size_t)l * D; const float* bb = in[I_LN2B] + (size_t)l * D;
    #pragma unroll 1
            for (int rep = (PROBE_DUP & 4) ? 0 : 1; rep < 2; ++rep)
            for (int r = F.gwave; r < M + NMETA; r += F.gwaves) { const int dry = (rep == 0);
                    const bool ism = r >= M; const int rr = ism ? r - M : r;
                    float* p = ism ? mx1 + (size_t)rr * D : x1buf + (size_t)rr * D; bf16* pbf = ism ? mXB + (size_t)rr * D : XBF + (size_t)rr * D;
                    f32x4 v[4]; row_load(v, p, F.lane);
                    if (ism) {
                        const float w1 = mTokW[rr * 2], w2 = mTokW[rr * 2 + 1];
                        const int me1 = mTokE[rr * 2], me2 = mTokE[rr * 2 + 1];
#pragma unroll
                        for (int j = 0; j < 4; ++j) { const f32x4 y1 = *(const f32x4*)(mYall + ((size_t)me1 * NMETA + rr) * D + 4 * F.lane + 256 * j), y2 = *(const f32x4*)(mYall + ((size_t)me2 * NMETA + rr) * D + 4 * F.lane + 256 * j);
                            v[j] = v[j] * ALPHA + y1 * w1 + y2 * w2; }
                    } else {
                        const int s1 = tok_slot[rr * 2], s2 = tok_slot[rr * 2 + 1]; const float w1 = tok_w[rr * 2], w2 = tok_w[rr * 2 + 1];
                        const size_t y1r = (size_t)F.MISC[40 + (s1 >> 16)] + (size_t)(s1 & 0xffff), y2r = (size_t)F.MISC[40 + (s2 >> 16)] + (size_t)(s2 & 0xffff);
#pragma unroll
                        for (int j = 0; j < 4; ++j) { const f32x4 y1 = load_bf4(Y + y1r * D + 4 * F.lane + 256 * j), y2 = load_bf4(Y + y2r * D + 4 * F.lane + 256 * j);
                            v[j] = v[j] * ALPHA + y1 * w1 + y2 * w2; }
                    }
                    ln_vals(v, g, bb, F.lane); row_store(v, p, pbf, F.lane, dry);
                }
            }
            SEAM(pb + 11);
        }
    }
#undef IN
#undef SEAM
}

extern "C" void kernel_launch(void* const* d_in, const int* in_sizes, int n_in, void* d_out, int out_size, void* d_ws, size_t ws_size, hipStream_t stream) {
    static int grid = 0;
    if (grid == 0) {
        if (n_in != 23 || in_sizes[0] != M * D || out_size != M * D || ws_size < WS_END) { fprintf(stderr, "kernel_launch: unexpected shapes / workspace (%d inputs, ws %zu)\n", n_in, ws_size); grid = -1; return; }
        int dev = 0, cus = 0, per_cu = 0;
        if (hipGetDevice(&dev) != hipSuccess || hipDeviceGetAttribute(&cus, hipDeviceAttributeMultiprocessorCount, dev) != hipSuccess) { grid = -1; return; }
        if (hipFuncSetAttribute((const void*)fwd_kernel, hipFuncAttributeMaxDynamicSharedMemorySize, LDS_BYTES) != hipSuccess) { fprintf(stderr, "kernel_launch: hipFuncSetAttribute failed\n"); grid = -1; return; }
        if (hipOccupancyMaxActiveBlocksPerMultiprocessor(&per_cu, (const void*)fwd_kernel, NTHR, LDS_BYTES) != hipSuccess || per_cu < 1) fprintf(stderr, "kernel_launch: occupancy query says %d\n", per_cu);
        (void)hipGetLastError();
        grid = cus;
    }
    if (grid < 0) return;
    if (hipMemsetAsync((char*)d_ws + WS_CTL, 0, CTL_ZERO_BYTES, stream) != hipSuccess) return;
    Args a{};
    for (int i = 0; i < 23; ++i) a.in[i] = (const float*)d_in[i];
    a.out = (float*)d_out; a.ws = (unsigned char*)d_ws;
#if N_LAUNCH_MODE == 1
    a.ph_lo = 0; a.ph_hi = NPHASES;
    hipLaunchKernelGGL(fwd_kernel, dim3(grid), dim3(NTHR), LDS_BYTES, stream, a);
#else
    for (int p = 0; p < NPHASES; ++p) {
        const int l = p / NPH, s = p % NPH;
        if ((l & 1) == 0 && (s == 9 || s == 10)) continue;
        a.ph_lo = p; a.ph_hi = p + 1;
        hipLaunchKernelGGL(fwd_kernel, dim3(grid), dim3(NTHR), LDS_BYTES, stream, a);
    }
#endif
}
```

```cpp
#include <hip/hip_runtime.h>
#include <cstdio>
#include <cstdint>

#ifndef N_LAUNCH_MODE
#define N_LAUNCH_MODE 1
#endif

#ifndef MIXER_FAST
#define MIXER_FAST 1
#endif
#ifndef PROBE_DUP
#define PROBE_DUP 0
#endif
#define LAS __attribute__((address_space(3)))
typedef unsigned short bf16;
typedef short bf16x8 __attribute__((ext_vector_type(8)));
typedef float f32x4 __attribute__((ext_vector_type(4)));
typedef float f32x2 __attribute__((ext_vector_type(2)));
typedef unsigned u32x4 __attribute__((ext_vector_type(4)));
typedef unsigned u32x2 __attribute__((ext_vector_type(2)));

constexpr int D = 1024, NB = 32, SEQ = 2048, DEPTH = 4, NMETA = 16;
constexpr int M = NB * SEQ;
constexpr int NIN = 8208;
constexpr int N1 = 6400;
constexpr int DFF = 2816, DFFE = 3584, NEXP = 8, HFF = 1792;
constexpr float ALPHA = 1.681792830507429f;
constexpr float QSCALE = 0.08838834764831845f;
constexpr float LN_EPS = 1e-5f, GN_EPS = 1e-6f;
constexpr int NPH = 12;
constexpr int NPHASES = DEPTH * NPH;

constexpr size_t MiB = 1u << 20;
constexpr size_t WS_CTL = 0, CTL_ZERO_BYTES = 1 * MiB;
constexpr size_t WS_ROPE = 1 * MiB;
constexpr size_t WS_META = 3 * MiB;
constexpr size_t WS_MOE = 4 * MiB;
constexpr size_t WS_GA = 8 * MiB;
constexpr size_t WS_W = 12 * MiB;
constexpr size_t WS_XA = 204 * MiB;
constexpr size_t WS_XBF = 460 * MiB;
constexpr size_t WS_QK = 588 * MiB;
constexpr size_t WS_V = 844 * MiB;
constexpr size_t WS_META2 = 1100 * MiB;
constexpr size_t WS_END = 1102 * MiB;
constexpr size_t W_B1 = 0;
constexpr size_t W_B2 = W_B1 + (size_t)N1 * D * 2;
constexpr size_t W_PA = W_B2 + (size_t)2048 * D * 2;
constexpr size_t W_PB = W_PA + (size_t)D * D * 2;
constexpr size_t W_O = W_PB + (size_t)D * D * 2;
constexpr size_t W_F = W_O + (size_t)D * D * 2;
constexpr size_t W_FD_DENSE = W_F + (size_t)2 * DFF * D * 2;
constexpr size_t W_FD_MOE = W_F + (size_t)NEXP * 2 * DFFE * D * 2;
static_assert(W_FD_MOE + (size_t)NEXP * 2 * D * HFF * 2 <= 192 * MiB, "weights fit");
constexpr size_t MT_HA = 0, MT_HB = 65536, MT_XB = 131072, MT_QK = 163840, MT_V = 229376, MT_SIG = 294912, MT_GA = 360448, MT_MRG = 364544,
                 MT_U = 397312  , MT_Y = 512000  , MT_TOK = 643072  , MT_O = 644096  ;
static_assert(MT_O + 65536 <= MiB, "meta map");
constexpr int CW_CNT = 1024;
constexpr int CW_BAR = 4096;

constexpr int RING_BYTES = 131072;
constexpr int LDS_BYTES = 147456;
constexpr int MISC_OFF = LDS_BYTES - 1024;
constexpr int NWAVES = 8, NTHR = 512;

__device__ __forceinline__ unsigned f2bf(float f) { unsigned u = __builtin_bit_cast(unsigned, f); return (u + 0x7fffu + ((u >> 16) & 1u)) >> 16; }
__device__ __forceinline__ float bf2f(unsigned h) { return __builtin_bit_cast(float, (h & 0xffffu) << 16); }
typedef __bf16 bf16x2_t __attribute__((ext_vector_type(2)));
__device__ __forceinline__ unsigned pk2(float lo, float hi) { const f32x2 v = {lo, hi}; return __builtin_bit_cast(unsigned, __builtin_convertvector(v, bf16x2_t)); }
__device__ __forceinline__ unsigned pk2_sw(float lo, float hi) { return pk2(lo, hi); }
__device__ __forceinline__ void store_bf4(bf16* p, f32x4 v) { u32x2 w; w.x = pk2(v[0], v[1]); w.y = pk2(v[2], v[3]); *(u32x2*)p = w; }
__device__ __forceinline__ f32x4 load_bf4(const bf16* p) { const u32x2 w = *(const u32x2*)p; return (f32x4){bf2f(w.x), bf2f(w.x >> 16), bf2f(w.y), bf2f(w.y >> 16)}; }
__device__ __forceinline__ void store_bf8(bf16* p, f32x4 lo, f32x4 hi) { u32x4 w; w.x = pk2(lo[0], lo[1]); w.y = pk2(lo[2], lo[3]); w.z = pk2(hi[0], hi[1]); w.w = pk2(hi[2], hi[3]); *(u32x4*)p = w; }
__device__ __forceinline__ void load_bf8(const bf16* p, f32x4& lo, f32x4& hi) { const u32x4 w = *(const u32x4*)p; lo = (f32x4){bf2f(w.x), bf2f(w.x >> 16), bf2f(w.y), bf2f(w.y >> 16)}; hi = (f32x4){bf2f(w.z), bf2f(w.z >> 16), bf2f(w.w), bf2f(w.w >> 16)}; }
__device__ __forceinline__ float sigmoidf_(float x) { return __builtin_amdgcn_rcpf(1.0f + __expf(-x)); }
__device__ __forceinline__ float siluf_(float x) { return x * __builtin_amdgcn_rcpf(1.0f + __expf(-x)); }
template <int CTRL> __device__ __forceinline__ float dpp_f(float v) { return __builtin_bit_cast(float, __builtin_amdgcn_update_dpp(0, __builtin_bit_cast(int, v), CTRL, 0xF, 0xF, true)); }
__device__ __forceinline__ float wave_sum(float v) {
    v += dpp_f<0xB1>(v);
    v += dpp_f<0x4E>(v);
    v += dpp_f<0x141>(v);
    v += dpp_f<0x140>(v);
    const int iv = __builtin_bit_cast(int, v);
    const float r0 = __builtin_bit_cast(float, __builtin_amdgcn_readlane(iv, 0)), r1 = __builtin_bit_cast(float, __builtin_amdgcn_readlane(iv, 16)),
                r2 = __builtin_bit_cast(float, __builtin_amdgcn_readlane(iv, 32)), r3 = __builtin_bit_cast(float, __builtin_amdgcn_readlane(iv, 48));
    return (r0 + r1) + (r2 + r3);
}
#define LDS_WAIT() asm volatile("s_waitcnt lgkmcnt(0)" ::: "memory")
#define VM_WAIT() asm volatile("s_waitcnt vmcnt(0)" ::: "memory")

namespace pg8 {
constexpr int BM = 256, BK = 64, HALF = 128, HTB = HALF * BK * 2, STAGE_BYTES = 8 * HTB, NXCD = 8, WGM = 8, IDX_OFF = STAGE_BYTES  ;
__host__ __device__ __forceinline__ int lds_byte(int r, int c) { const int st = (r >> 4) * 2 + (c >> 5), rr = r & 15, cc = c & 31, ob = rr * 64 + cc * 2; return st * 1024 + (ob ^ (((ob >> 9) & 1) << 5)); }
__host__ __device__ __forceinline__ void stage_rc(int b, int& R, int& C) { const int st = b / 1024, sb = b % 1024, swz = sb ^ (((sb >> 9) & 1) << 5); R = (st >> 1) * 16 + swz / 64; C = (st & 1) * 32 + (swz % 64) / 2; }

__host__ __device__ __forceinline__ int perm32(int rho) { const int n = rho >> 4, i = rho & 15; return 8 * (i >> 2) + 4 * n + (i & 3); }
struct Unit { const char* A; const char* B; int row0, col0, e, nvalid; };

struct SchedDense {
    static constexpr bool GATHER = false;
    int nM, nN, nwg, G, c; const char* A; const char* Bt; unsigned lda, ldb;
    __device__ void init(int Mr, int Nc, int G_, int c_, const void* A_, unsigned lda_, const void* Bt_, unsigned ldb_) { nM = Mr / BM; nN = Nc / BM; nwg = nM * nN; G = G_; c = c_; A = (const char*)A_; Bt = (const char*)Bt_; lda = lda_; ldb = ldb_; }
    __device__ bool next(int i, Unit& u) const {
        const long L = (long)i * G + c; if (L >= nwg) return false;
        int wgid = (int)L; { const int q = nwg / NXCD, r = nwg % NXCD, xcd = wgid % NXCD, off = wgid / NXCD; wgid = (xcd < r ? xcd * (q + 1) : r * (q + 1) + (xcd - r) * q) + off; }
        const int nig = WGM * nN, gid = wgid / nig, fm = gid * WGM, gsz = (nM - fm) < WGM ? (nM - fm) : WGM;
        const int pm = fm + ((wgid % nig) % gsz), pn = (wgid % nig) / gsz;
        u.A = A + (size_t)pm * BM * lda; u.B = Bt + (size_t)pn * BM * ldb; u.row0 = pm * BM; u.col0 = pn * BM; u.e = 0; u.nvalid = BM; return true;
    }
    __device__ __forceinline__ unsigned a_off(const Unit&, int R, int h) const { return (unsigned)(h * HALF + R) * lda; }
};

template <class F> struct EpiEl {
    static constexpr bool PERM = false;
    F f;
    template <int MODE> __device__ __forceinline__ void loop(const f32x4 (&acc)[2][2][4][2], const Unit& u, int wr, int wc, int fr, int fq) const {
#pragma unroll
        for (int ai = 0; ai < 2; ++ai)
#pragma unroll
            for (int m = 0; m < 4; ++m) { const int r = ai * HALF + wr * 64 + m * 16 + fr;
#pragma unroll
                for (int bj = 0; bj < 2; ++bj)
#pragma unroll
                    for (int n = 0; n < 2; ++n) f.template at<MODE>(u, r, bj * HALF + wc * 32 + n * 16 + 4 * fq, acc[ai][bj][m][n]);
                asm volatile("" ::: "memory"); }
    }
    __device__ __forceinline__ void operator()(const f32x4 (&acc)[2][2][4][2], const Unit& u, int wr, int wc, int fr, int fq) const {
        if constexpr (F::NMODES == 1) loop<0>(acc, u, wr, wc, fr, fq);
        else {
            const int mode = __builtin_amdgcn_readfirstlane(f.mode(u));
            if (mode == 0) loop<0>(acc, u, wr, wc, fr, fq);
            else if (mode == 1) loop<1>(acc, u, wr, wc, fr, fq);
            else if (mode == 2) loop<2>(acc, u, wr, wc, fr, fq);
            else if (mode == 3) loop<3>(acc, u, wr, wc, fr, fq);
            else loop<4>(acc, u, wr, wc, fr, fq);
        }
    }
};

template <class F> struct EpiRow {
    static constexpr bool PERM = true;
    F f;
    template <int MODE> __device__ __forceinline__ void loop(const f32x4 (&acc)[2][2][4][2], const Unit& u, int wr, int wc, int fr, int fq) const {
#pragma unroll
        for (int ai = 0; ai < 2; ++ai)
#pragma unroll
            for (int m = 0; m < 4; ++m) { f.template row<MODE>(u, ai * HALF + wr * 64 + m * 16 + fr, wc * 32 + 8 * fq, acc[ai][0][m][0], acc[ai][0][m][1], acc[ai][1][m][0], acc[ai][1][m][1]);
                asm volatile("" ::: "memory"); }
    }
    __device__ __forceinline__ void operator()(const f32x4 (&acc)[2][2][4][2], const Unit& u, int wr, int wc, int fr, int fq) const {
        if constexpr (F::NMODES == 1) loop<0>(acc, u, wr, wc, fr, fq);
        else {
            const int mode = __builtin_amdgcn_readfirstlane(f.mode(u));
            if (mode == 0) loop<0>(acc, u, wr, wc, fr, fq);
            else if (mode == 1) loop<1>(acc, u, wr, wc, fr, fq);
            else if (mode == 2) loop<2>(acc, u, wr, wc, fr, fq);
            else if (mode == 3) loop<3>(acc, u, wr, wc, fr, fq);
            else loop<4>(acc, u, wr, wc, fr, fq);
        }
    }
};

template <class Epi, class Sched, bool ALIGN_EPI = true>
__device__ __forceinline__ void gemm_phase(LAS unsigned char* lds, const int tid, const Sched& S, const Epi& E, const int K, const unsigned lda, const unsigned ldb) {
    const int wid = __builtin_amdgcn_readfirstlane(tid >> 6), lane = tid & 63, wr = wid >> 2, wc = wid & 3, fr = lane & 15, fq = lane >> 4;
    const int nt = K / BK;
    int Rr[2], Cc[2]; unsigned voffA[2], voffB[2];
#pragma unroll
    for (int i = 0; i < 2; ++i) { int R, C; stage_rc(tid * 16 + i * 8192, R, C); Rr[i] = R; Cc[i] = C; const int Rb = Epi::PERM ? ((R & ~31) + perm32(R & 31)) : R; voffA[i] = (unsigned)R * lda + (unsigned)C * 2u; voffB[i] = (unsigned)Rb * ldb + (unsigned)C * 2u; }
    const size_t kstep = (size_t)(BK * 2);
    const size_t hstepA = (size_t)HALF * lda, hstepB = (size_t)HALF * ldb;
    const unsigned ldsw = (unsigned)wid * 1024u;
    const int aoff = lds_byte(wr * 64 + fr, fq * 8), boff = lds_byte(wc * 32 + fr, fq * 8);
#define PG8_SA(b, h) (((b) * 2 + (h)) * HTB)
#define PG8_SB(b, h) ((4 + (b) * 2 + (h)) * HTB)
#define PG8_STAGE_B(bufoff, gbase) do { _Pragma("unroll") for (int _i = 0; _i < 2; ++_i) \
        __builtin_amdgcn_global_load_lds((const unsigned*)((const char*)(gbase) + voffB[_i]), (LAS unsigned*)(lds + (bufoff) + ldsw + _i * 8192), 16, 0, 0); } while (0)
#define PG8_STAGE_A(bufoff, gbase, h, ox) do { _Pragma("unroll") for (int _i = 0; _i < 2; ++_i) { \
        const char* _p = Sched::GATHER ? ((const char*)(gbase) + (ox)[h][_i]) : ((const char*)(gbase) + (h) * hstepA + voffA[_i]); \
        __builtin_amdgcn_global_load_lds((const unsigned*)_p, (LAS unsigned*)(lds + (bufoff) + ldsw + _i * 8192), 16, 0, 0); } } while (0)
#define PG8_LDA(dst, b, h) do { _Pragma("unroll") for (int m = 0; m < 4; ++m) _Pragma("unroll") for (int k = 0; k < 2; ++k) dst[m][k] = *(const LAS bf16x8*)(lds + PG8_SA(b, h) + aoff + m * 2048 + k * 1024); } while (0)
#define PG8_LDB(dst, b, h) do { _Pragma("unroll") for (int n = 0; n < 2; ++n) _Pragma("unroll") for (int k = 0; k < 2; ++k) dst[n][k] = *(const LAS bf16x8*)(lds + PG8_SB(b, h) + boff + n * 2048 + k * 1024); } while (0)
#define PG8_MMA(ai, bj, At, Bt) do { __builtin_amdgcn_s_setprio(1); _Pragma("unroll") for (int m = 0; m < 4; ++m) _Pragma("unroll") for (int n = 0; n < 2; ++n) _Pragma("unroll") for (int k = 0; k < 2; ++k) \
        acc[ai][bj][m][n] = __builtin_amdgcn_mfma_f32_16x16x32_bf16(Bt[n][k], At[m][k], acc[ai][bj][m][n], 0, 0, 0); __builtin_amdgcn_s_setprio(0); } while (0)
#define PG8_WAIT_V(n) asm volatile("s_waitcnt vmcnt(" #n ")" ::: "memory")
#define PG8_WAIT_L(n) asm volatile("s_waitcnt lgkmcnt(" #n ")" ::: "memory")
#define PG8_BAR __builtin_amdgcn_s_barrier()
#define PG8_SCHED __builtin_amdgcn_sched_barrier(0)
    Unit cur, nxt; int ui = 0;
    if (!S.next(0, cur)) return;
    f32x4 acc[2][2][4][2];
#pragma unroll
    for (int a = 0; a < 2; ++a)
#pragma unroll
        for (int b = 0; b < 2; ++b)
#pragma unroll
            for (int m = 0; m < 4; ++m)
#pragma unroll
                for (int n = 0; n < 2; ++n) acc[a][b][m][n] = (f32x4){0.f, 0.f, 0.f, 0.f};
    bf16x8 At[4][2], B0[2][2], B1[2][2];
    unsigned oc[2][2];
#pragma unroll
    for (int h = 0; h < 2; ++h)
#pragma unroll
        for (int i = 0; i < 2; ++i) oc[h][i] = Sched::GATHER ? (S.a_off(cur, Rr[i], h) + (unsigned)Cc[i] * 2u) : 0u;
    const char* cA = cur.A; const char* cB = cur.B;
    PG8_STAGE_B(PG8_SB(0, 0), cB); PG8_STAGE_B(PG8_SB(0, 1), cB + hstepB); PG8_STAGE_A(PG8_SA(0, 0), cA, 0, oc); PG8_STAGE_A(PG8_SA(0, 1), cA, 1, oc);
    if (wr == 1) PG8_BAR;
    PG8_WAIT_V(2); PG8_BAR;
    PG8_STAGE_B(PG8_SB(1, 0), cB + kstep); PG8_STAGE_A(PG8_SA(1, 0), cA + kstep, 0, oc); PG8_STAGE_B(PG8_SB(1, 1), cB + hstepB + kstep);
    PG8_WAIT_V(6); PG8_BAR;
    for (;;) {
        const bool has_next = S.next(ui + 1, nxt);
        const char* nA = has_next ? nxt.A : cA; const char* nB = has_next ? nxt.B : cB;
        if constexpr (Sched::GATHER) {
            if (has_next && wid == 0)
                __builtin_amdgcn_global_load_lds((const unsigned*)(S.idx_base(nxt) + lane * 4), (LAS unsigned*)(lds + IDX_OFF), 16, 0, 0);
        }
        for (int t = 0; t < nt; t += 2) {
            const bool last = (t == nt - 2);
            const char* a1 = cA + (size_t)(t + 1) * kstep;
            const char* a2 = last ? nA : cA + (size_t)(t + 2) * kstep; const char* b2 = last ? nB : cB + (size_t)(t + 2) * kstep;
            const char* a3 = a2 + kstep; const char* b3 = b2 + kstep;
            PG8_LDB(B0, 0, 0); PG8_LDB(B1, 0, 1); PG8_SCHED; PG8_LDA(At, 0, 0); PG8_STAGE_A(PG8_SA(1, 1), a1, 1, oc);
            if constexpr (Sched::GATHER) { if (last && has_next) {
#pragma unroll
                for (int h = 0; h < 2; ++h)
#pragma unroll
                    for (int i = 0; i < 2; ++i) { const int rt = h * HALF + Rr[i]; const unsigned tok = *(const LAS unsigned*)(lds + IDX_OFF + (S.row_ok(nxt, rt) ? rt : 0) * 4);
                        oc[h][i] = tok * lda + (unsigned)Cc[i] * 2u; } } }
            PG8_WAIT_V(8); PG8_WAIT_L(0); PG8_BAR; PG8_MMA(0, 0, At, B0); PG8_MMA(0, 1, At, B1); PG8_BAR; PG8_SCHED;
            PG8_LDA(At, 0, 1); PG8_STAGE_B(PG8_SB(0, 0), b2); PG8_STAGE_B(PG8_SB(0, 1), b2 + hstepB); PG8_STAGE_A(PG8_SA(0, 0), a2, 0, oc);
            PG8_WAIT_V(8); PG8_WAIT_L(0); PG8_BAR; PG8_MMA(1, 0, At, B0); PG8_MMA(1, 1, At, B1); PG8_BAR; PG8_SCHED;
            PG8_LDB(B0, 1, 0); PG8_LDB(B1, 1, 1); PG8_SCHED; PG8_LDA(At, 1, 0); PG8_STAGE_A(PG8_SA(0, 1), a2, 1, oc);
            PG8_WAIT_V(8); PG8_WAIT_L(0); PG8_BAR; PG8_MMA(0, 0, At, B0); PG8_MMA(0, 1, At, B1); PG8_BAR; PG8_SCHED;
            PG8_LDA(At, 1, 1); PG8_STAGE_B(PG8_SB(1, 0), b3); PG8_STAGE_B(PG8_SB(1, 1), b3 + hstepB); PG8_STAGE_A(PG8_SA(1, 0), a3, 0, oc);
            PG8_WAIT_V(8); PG8_WAIT_L(0); PG8_BAR; PG8_MMA(1, 0, At, B0); PG8_MMA(1, 1, At, B1); PG8_BAR; PG8_SCHED;
        }
        if constexpr (ALIGN_EPI) { if (wr == 0) PG8_BAR; }
        E(acc, cur, wr, wc, fr, fq);
        if (!has_next) break;
#pragma unroll
        for (int a = 0; a < 2; ++a)
#pragma unroll
            for (int b = 0; b < 2; ++b)
#pragma unroll
                for (int m = 0; m < 4; ++m)
#pragma unroll
                    for (int n = 0; n < 2; ++n) acc[a][b][m][n] = (f32x4){0.f, 0.f, 0.f, 0.f};
        cur = nxt; cA = nA; cB = nB; ++ui;
        if constexpr (ALIGN_EPI) { if (wr == 1) PG8_BAR; }
    }
    PG8_WAIT_V(0);
    if constexpr (!ALIGN_EPI) { if (wr == 0) PG8_BAR; }
    PG8_BAR;
#undef PG8_SA
#undef PG8_SB
#undef PG8_STAGE_A
#undef PG8_STAGE_B
#undef PG8_LDA
#undef PG8_LDB
#undef PG8_MMA
#undef PG8_WAIT_V
#undef PG8_WAIT_L
#undef PG8_BAR
#undef PG8_SCHED
}
}

#define XB_TMO      128
#define XB_XCNT(j)  (256  + 64 * (j))
#define XB_XSUB(j)  (1280 + 64 * (j))
#define XB_XGEN(j)  (2304 + 64 * (j))
#define XB_TOP      3328
#define XB_TOPGEN   3392
#define XCD_BAR_WORDS 3456
#define XB_SPIN_CAP (1u << 18)
__device__ __forceinline__ unsigned xb_ld(unsigned* p)              { return __hip_atomic_load(p, __ATOMIC_RELAXED, __HIP_MEMORY_SCOPE_AGENT); }
__device__ __forceinline__ unsigned xb_add(unsigned* p, unsigned v) { return __hip_atomic_fetch_add(p, v, __ATOMIC_RELAXED, __HIP_MEMORY_SCOPE_AGENT); }
__device__ __forceinline__ unsigned xb_xcc_id() { return (unsigned)__builtin_amdgcn_s_getreg((3 << 11) | 20) & 0xFu; }
#define XB_SPIN(cond, bar) do { unsigned _sp = 0; while (cond) { __builtin_amdgcn_s_sleep(1); \
    if ((++_sp & 255u) == 0u) { if (xb_ld(&(bar)[XB_TMO])) break; if (_sp > XB_SPIN_CAP) { atomicAdd(&(bar)[XB_TMO], 1u); break; } } } } while (0)
struct XcdBarrier { unsigned* bar; unsigned x; volatile LAS unsigned* st; };
__device__ __forceinline__ XcdBarrier xcd_barrier_post(unsigned* bar, volatile LAS unsigned* st) {
    XcdBarrier b; b.bar = bar; b.x = xb_xcc_id(); b.st = st;
    if (threadIdx.x == 0) (void)xb_add(&bar[XB_XCNT(b.x)], 1u);
    return b;
}
__device__ __forceinline__ void xcd_barrier_complete(unsigned* bar, unsigned x, unsigned& nloc, unsigned& nx) {
    const unsigned G = gridDim.x * gridDim.y * gridDim.z;
    unsigned sum, cnt, mine, sp = 0u;
    for (;;) {
        sum = 0u; cnt = 0u; mine = 0u;
#pragma unroll
        for (unsigned j = 0; j < 16; ++j) { const unsigned c = xb_ld(&bar[XB_XCNT(j)]); sum += c; cnt += (c > 0u) ? 1u : 0u; mine = (j == x) ? c : mine; }
        if (sum == G) break;
        __builtin_amdgcn_s_sleep(1);
        if ((++sp & 255u) == 0u) { if (xb_ld(&bar[XB_TMO])) break; if (sp > XB_SPIN_CAP) { atomicAdd(&bar[XB_TMO], 1u); break; } }
    }
    nloc = mine > 0u ? mine : 1u; nx = cnt > 0u ? cnt : 1u;
}
__device__ __forceinline__ void xcd_barrier(const XcdBarrier& b) {
    asm volatile("s_waitcnt vmcnt(0)" ::: "memory");
    __syncthreads();
    if (threadIdx.x == 0) {
        unsigned* bar = b.bar;
        __builtin_amdgcn_s_waitcnt(0);
        unsigned nloc = b.st[0], nx = b.st[1];
        if (nloc == 0u) { xcd_barrier_complete(bar, b.x, nloc, nx); b.st[0] = nloc; b.st[1] = nx; }
        const unsigned old = xb_add(&bar[XB_XSUB(b.x)], 1u);
        const unsigned gen = old / nloc;
        if (old + 1u == (gen + 1u) * nloc) {
            __builtin_amdgcn_fence(__ATOMIC_RELEASE, "agent");
            asm volatile("s_waitcnt vmcnt(0)" ::: "memory");
            const unsigned og = xb_add(&bar[XB_TOP], 1u);
            const unsigned tg = og / nx;
            if (og + 1u == (tg + 1u) * nx) xb_add(&bar[XB_TOPGEN], 1u);
            else XB_SPIN(xb_ld(&bar[XB_TOPGEN]) == tg, bar);
            __builtin_amdgcn_fence(__ATOMIC_ACQUIRE, "agent");
            xb_add(&bar[XB_XGEN(b.x)], 1u);
            asm volatile("s_waitcnt vmcnt(0)" ::: "memory");
        } else {
            XB_SPIN(xb_ld(&bar[XB_XGEN(b.x)]) == gen, bar);
            __builtin_amdgcn_fence(__ATOMIC_ACQUIRE, "agent");
            asm volatile("s_waitcnt vmcnt(0)" ::: "memory");
        }
    }
    __syncthreads();
}

struct Args { const float* in[23]; float* out; unsigned char* ws; int ph_lo, ph_hi, li, pad; };
enum { I_X = 0, I_META, I_WIN, I_BGATE, I_WA2, I_BA, I_GNG, I_RNG, I_RNB, I_WPA, I_WPB, I_WO, I_LN1G, I_LN1B, I_FG, I_FU, I_FD, I_RT, I_MG, I_MU, I_MD, I_LN2G, I_LN2B };

struct Frame {
    LAS unsigned char* lds; volatile LAS unsigned* MISC; unsigned* ctl;
    int tid, lane, wave, G, bid, gtid, gthreads, gwave, gwaves;
    unsigned char* ws;
};

template <class AR, class BR, class F>
__device__ __forceinline__ void naive_gemm(const Frame& Fr, int nrows, int ncols, int K, AR arow, BR brow, F f) {
    const int nc4 = ncols >> 2;
#pragma unroll 1
    for (int rep = (PROBE_DUP & 1) ? 0 : 1; rep < 2; ++rep)
    for (int idx = Fr.gtid; idx < nrows * nc4; idx += Fr.gthreads) {
        const int row = idx / nc4, c0 = (idx % nc4) * 4;
        const bf16* a = arow(row);
        f32x4 acc = (f32x4){0.f, 0.f, 0.f, 0.f};
#pragma unroll
        for (int j = 0; j < 4; ++j) {
            const bf16* b = brow(row, c0 + j);
            float s = 0.f;
            for (int k = 0; k < K; k += 8) {
                const u32x4 av = *(const u32x4*)(a + k), bv = *(const u32x4*)(b + k);
                s += bf2f(av.x) * bf2f(bv.x) + bf2f(av.x >> 16) * bf2f(bv.x >> 16) + bf2f(av.y) * bf2f(bv.y) + bf2f(av.y >> 16) * bf2f(bv.y >> 16)
                   + bf2f(av.z) * bf2f(bv.z) + bf2f(av.z >> 16) * bf2f(bv.z >> 16) + bf2f(av.w) * bf2f(bv.w) + bf2f(av.w >> 16) * bf2f(bv.w >> 16);
            }
            acc[j] = s;
        }
        if (rep == 0) { if (acc[0] + acc[1] + acc[2] + acc[3] == 1.2345678e30f) *(f32x4*)(Fr.ws + WS_META + MT_Y) = acc; continue; }
        pg8::Unit u; u.A = nullptr; u.B = nullptr; u.row0 = 0; u.col0 = c0 & ~255; u.e = 0; u.nvalid = nrows;
        const int cc = c0 & 255;
        if constexpr (F::NMODES == 1) f.template at<0>(u, row, cc, acc);
        else { const int mode = f.mode(u);
            if (mode == 0) f.template at<0>(u, row, cc, acc); else if (mode == 1) f.template at<1>(u, row, cc, acc); else if (mode == 2) f.template at<2>(u, row, cc, acc);
            else if (mode == 3) f.template at<3>(u, row, cc, acc); else f.template at<4>(u, row, cc, acc); }
    }
}

template <class AR, class BC, class FM>
__device__ __forceinline__ void meta_gemm(const Frame& Fr, int nouter, int ncols, int K, AR arow, BC bcol, FM fmk) {
    const int ntile = ncols >> 4, ntask = nouter * ntile, kw = K >> 3;
    const int lane = Fr.lane, l16 = lane & 15, quad = lane >> 4;
    LAS f32x4* part = (LAS f32x4*)Fr.lds;
#pragma unroll 1
    for (int rep = (PROBE_DUP & 1) ? 0 : 1; rep < 2; ++rep)
#pragma unroll 1
    for (int task = Fr.bid; task < ntask; task += Fr.G) {
        const int o = task / ntile, c0 = (task - o * ntile) * 16;
        const bf16* ap = arow(o, l16) + Fr.wave * kw + 8 * quad; const bf16* bp = bcol(o, c0 + l16) + Fr.wave * kw + 8 * quad;
        f32x4 acc = (f32x4){0.f, 0.f, 0.f, 0.f};
        for (int k = 0; k < kw; k += 32) { const bf16x8 av = *(const bf16x8*)(ap + k), bv = *(const bf16x8*)(bp + k); acc = __builtin_amdgcn_mfma_f32_16x16x32_bf16(bv, av, acc, 0, 0, 0); }
        part[Fr.wave * 64 + lane] = acc;
        __syncthreads();
        if (Fr.wave == 0) {
            f32x4 t = part[lane];
#pragma unroll
            for (int w = 1; w < 8; ++w) t = t + part[w * 64 + lane];
            if (rep == 1) {
                auto f = fmk(o);
                pg8::Unit u; u.A = nullptr; u.B = nullptr; u.row0 = 0; u.col0 = c0 & ~255; u.e = 0; u.nvalid = 16;
                const int cc = (c0 & 255) + 4 * quad;
                if constexpr (decltype(f)::NMODES == 1) f.template at<0>(u, l16, cc, t);
                else { const int mode = f.mode(u);
                    if (mode == 0) f.template at<0>(u, l16, cc, t); else if (mode == 1) f.template at<1>(u, l16, cc, t); else if (mode == 2) f.template at<2>(u, l16, cc, t);
                    else if (mode == 3) f.template at<3>(u, l16, cc, t); else f.template at<4>(u, l16, cc, t); }
            }
        }
        __syncthreads();
    }
}

template <class AR, class BC, class FM>
__device__ __forceinline__ void meta_gemm_pair(const Frame& Fr, int nouter, int nff, int K, AR arow, BC bcol, FM fmk) {
    const int ntile = nff >> 4, ntask = nouter * ntile, kw = K >> 3;
    const int lane = Fr.lane, l16 = lane & 15, quad = lane >> 4;
    LAS f32x4* part = (LAS f32x4*)Fr.lds;
#pragma unroll 1
    for (int rep = (PROBE_DUP & 1) ? 0 : 1; rep < 2; ++rep)
#pragma unroll 1
    for (int task = Fr.bid; task < ntask; task += Fr.G) {
        const int o = task / ntile, f0 = (task - o * ntile) * 16, wrow = 256 * (f0 >> 7) + (f0 & 127);
        const bf16* ap = arow(o, l16) + Fr.wave * kw + 8 * quad; const bf16* bp = bcol(o, wrow + l16) + Fr.wave * kw + 8 * quad; const bf16* bp2 = bp + (size_t)128 * K;
        f32x4 ag = (f32x4){0.f, 0.f, 0.f, 0.f}, au = ag;
        for (int k = 0; k < kw; k += 32) { const bf16x8 av = *(const bf16x8*)(ap + k), bg = *(const bf16x8*)(bp + k), bu = *(const bf16x8*)(bp2 + k);
            ag = __builtin_amdgcn_mfma_f32_16x16x32_bf16(bg, av, ag, 0, 0, 0); au = __builtin_amdgcn_mfma_f32_16x16x32_bf16(bu, av, au, 0, 0, 0); }
        part[Fr.wave * 64 + lane] = ag; part[512 + Fr.wave * 64 + lane] = au;
        __syncthreads();
        if (Fr.wave == 0) {
            f32x4 tg = part[lane], tu = part[512 + lane];
#pragma unroll
            for (int w = 1; w < 8; ++w) { tg = tg + part[w * 64 + lane]; tu = tu + part[512 + w * 64 + lane]; }
            if (rep == 1) { auto f = fmk(o); f.pair(l16, f0 + 4 * quad, tg, tu); }
        }
        __syncthreads();
    }
}

struct F1 {
    static constexpr int NMODES = 5;
    bf16* QK; bf16* V; bf16* SIG; float* GA; const f32x2* rope; const float* bg; int posmask, posbase;
    __device__ __forceinline__ int mode(const pg8::Unit& u) const { const int c = u.col0; return c < 1024 ? 0 : (c < 2048 ? 1 : (c < 4096 ? 2 : (c < 6144 ? 3 : 4))); }
    template <int MODE> __device__ __forceinline__ void at(const pg8::Unit& u, int r, int c, f32x4 v) const {
        const int row = u.row0 + r, col = u.col0 + c;
        if (MODE == 0) { const float s = col < 512 ? QSCALE : 1.f; store_bf4(QK + (size_t)row * 2048 + col, v * s); }
        else if (MODE == 1) {
            const int j = (col - 1024) & 127, pos = (row & posmask) + posbase; const f32x2 c0 = rope[pos * 64 + (j >> 1)], c1 = rope[pos * 64 + (j >> 1) + 1];
            const float s = col >= 1536 ? QSCALE : 1.f;
            f32x4 o; o[0] = (v[0] * c0.x - v[1] * c0.y) * s; o[1] = (v[0] * c0.y + v[1] * c0.x) * s; o[2] = (v[2] * c1.x - v[3] * c1.y) * s; o[3] = (v[2] * c1.y + v[3] * c1.x) * s;
            store_bf4(QK + (size_t)row * 2048 + col, o);
        }
        else if (MODE == 2) store_bf4(V + (size_t)row * 2048 + (col - 2048), v);
        else if (MODE == 3) { const int cc = col - 4096; const f32x4 b = *(const f32x4*)(bg + cc);
            f32x4 o; o[0] = sigmoidf_(v[0] + b[0]); o[1] = sigmoidf_(v[1] + b[1]); o[2] = sigmoidf_(v[2] + b[2]); o[3] = sigmoidf_(v[3] + b[3]);
            store_bf4(SIG + (size_t)row * 2048 + cc, o); }
        else { if (col < 6160) *(f32x4*)(GA + (size_t)row * 16 + (col - 6144)) = v; }
    }
    template <int MODE> __device__ __forceinline__ void half8(int row, int col, f32x4 lo, f32x4 hi) const {
        if (MODE == 0) { const float s = col < 512 ? QSCALE : 1.f; store_bf8(QK + (size_t)row * 2048 + col, lo * s, hi * s); }
        else if (MODE == 1) {
            const int j = (col - 1024) & 127, pos = (row & posmask) + posbase; const f32x4* rp = (const f32x4*)(rope + pos * 64 + (j >> 1)); const f32x4 t0 = rp[0], t1 = rp[1];
            const float s = col >= 1536 ? QSCALE : 1.f;
            f32x4 o0, o1;
            o0[0] = (lo[0] * t0[0] - lo[1] * t0[1]) * s; o0[1] = (lo[0] * t0[1] + lo[1] * t0[0]) * s; o0[2] = (lo[2] * t0[2] - lo[3] * t0[3]) * s; o0[3] = (lo[2] * t0[3] + lo[3] * t0[2]) * s;
            o1[0] = (hi[0] * t1[0] - hi[1] * t1[1]) * s; o1[1] = (hi[0] * t1[1] + hi[1] * t1[0]) * s; o1[2] = (hi[2] * t1[2] - hi[3] * t1[3]) * s; o1[3] = (hi[2] * t1[3] + hi[3] * t1[2]) * s;
            store_bf8(QK + (size_t)row * 2048 + col, o0, o1);
        }
        else if (MODE == 2) store_bf8(V + (size_t)row * 2048 + (col - 2048), lo, hi);
        else if (MODE == 3) { const int cc = col - 4096; const f32x4 b0 = *(const f32x4*)(bg + cc), b1 = *(const f32x4*)(bg + cc + 4);
            f32x4 o0, o1;
#pragma unroll
            for (int i = 0; i < 4; ++i) { o0[i] = sigmoidf_(lo[i] + b0[i]); o1[i] = sigmoidf_(hi[i] + b1[i]); }
            store_bf8(SIG + (size_t)row * 2048 + cc, o0, o1); }
        else { if (col < 6160) { *(f32x4*)(GA + (size_t)row * 16 + (col - 6144)) = lo; *(f32x4*)(GA + (size_t)row * 16 + (col - 6144) + 4) = hi; } }
    }
    template <int MODE> __device__ __forceinline__ void row(const pg8::Unit& u, int r, int c8, f32x4 a0, f32x4 a1, f32x4 b0, f32x4 b1) const {
        half8<MODE>(u.row0 + r, u.col0 + c8, a0, a1); half8<MODE>(u.row0 + r, u.col0 + 128 + c8, b0, b1);
    }
};
struct F2 {
    static constexpr int NMODES = 1;
    const bf16* O; bf16* V;
    template <int MODE> __device__ __forceinline__ void at(const pg8::Unit& u, int r, int c, f32x4 v) const {
        const size_t off = (size_t)(u.row0 + r) * 2048 + u.col0 + c; bf16* p = V + off; const f32x4 o = load_bf4(O + off);
        f32x4 w; w[0] = siluf_(v[0]) * o[0]; w[1] = siluf_(v[1]) * o[1]; w[2] = siluf_(v[2]) * o[2]; w[3] = siluf_(v[3]) * o[3];
        store_bf4(p, w);
    }
    __device__ __forceinline__ void half8(size_t off, f32x4 lo, f32x4 hi) const {
        f32x4 o0, o1; load_bf8(O + off, o0, o1);
#pragma unroll
        for (int i = 0; i < 4; ++i) { o0[i] *= siluf_(lo[i]); o1[i] *= siluf_(hi[i]); }
        store_bf8(V + off, o0, o1);
    }
    template <int MODE> __device__ __forceinline__ void row(const pg8::Unit& u, int r, int c8, f32x4 a0, f32x4 a1, f32x4 b0, f32x4 b1) const {
        const size_t off = (size_t)(u.row0 + r) * 2048 + u.col0 + c8; half8(off, a0, a1); half8(off + 128, b0, b1);
    }
};
struct F3 {
    static constexpr int NMODES = 1;
    bf16* MRG; const bf16* SIG; int second;
    template <int MODE> __device__ __forceinline__ void at(const pg8::Unit& u, int r, int c, f32x4 v) const {
        const int row = u.row0 + r, col = u.col0 + c; bf16* p = MRG + (size_t)row * 1024 + col;
        const f32x4 g = load_bf4(SIG + (size_t)row * 2048 + second * 1024 + col); f32x4 o = g * v;
        if (second) o = o + load_bf4(p);
        store_bf4(p, o);
    }
    __device__ __forceinline__ void half8(int row, int col, f32x4 lo, f32x4 hi) const {
        bf16* p = MRG + (size_t)row * 1024 + col; f32x4 g0, g1; load_bf8(SIG + (size_t)row * 2048 + second * 1024 + col, g0, g1);
        f32x4 o0 = g0 * lo, o1 = g1 * hi;
        if (second) { f32x4 m0, m1; load_bf8(p, m0, m1); o0 = o0 + m0; o1 = o1 + m1; }
        store_bf8(p, o0, o1);
    }
    template <int MODE> __device__ __forceinline__ void row(const pg8::Unit& u, int r, int c8, f32x4 a0, f32x4 a1, f32x4 b0, f32x4 b1) const {
        half8(u.row0 + r, u.col0 + c8, a0, a1); half8(u.row0 + r, u.col0 + 128 + c8, b0, b1);
    }
};
struct F4 {
    static constexpr int NMODES = 1;
    const float* RES; float* OUT;
    template <int MODE> __device__ __forceinline__ void at(const pg8::Unit& u, int r, int c, f32x4 v) const {
        const size_t o = (size_t)(u.row0 + r) * 1024 + u.col0 + c; const f32x4 h = *(const f32x4*)(RES + o);
        *(f32x4*)(OUT + o) = h * ALPHA + v;
    }
};
struct F5 {
    static constexpr int NMODES = 1;
    bf16* U; int ldu;
    template <int MODE> __device__ __forceinline__ void row(const pg8::Unit& u, int r, int c8, f32x4 a0, f32x4 a1, f32x4 b0, f32x4 b1) const {
        f32x4 o0, o1;
#pragma unroll
        for (int i = 0; i < 4; ++i) { o0[i] = siluf_(a0[i]) * b0[i]; o1[i] = siluf_(a1[i]) * b1[i]; }
        store_bf8(U + (size_t)(u.row0 + r) * ldu + (u.col0 >> 1) + c8, o0, o1);
    }
    __device__ __forceinline__ void pair(int r, int f, f32x4 g, f32x4 uu) const {
        f32x4 o; o[0] = siluf_(g[0]) * uu[0]; o[1] = siluf_(g[1]) * uu[1]; o[2] = siluf_(g[2]) * uu[2]; o[3] = siluf_(g[3]) * uu[3];
        store_bf4(U + (size_t)r * ldu + f, o);
    }
};
struct F6M {
    static constexpr int NMODES = 1;
    bf16* Y; int second;
    template <int MODE> __device__ __forceinline__ void at(const pg8::Unit& u, int r, int c, f32x4 v) const {
        if (r >= u.nvalid) return;
        bf16* p = Y + (size_t)(u.row0 + r) * 1024 + u.col0 + c;
        if (second) v = v + load_bf4(p);
        store_bf4(p, v);
    }
    template <int MODE> __device__ __forceinline__ void row(const pg8::Unit& u, int r, int c8, f32x4 a0, f32x4 a1, f32x4 b0, f32x4 b1) const {
        if (r >= u.nvalid) return;
        bf16* p = Y + (size_t)(u.row0 + r) * 1024 + u.col0 + c8;
        if (second) { f32x4 m0, m1; load_bf8(p, m0, m1); a0 = a0 + m0; a1 = a1 + m1; load_bf8(p + 128, m0, m1); b0 = b0 + m0; b1 = b1 + m1; }
        store_bf8(p, a0, a1); store_bf8(p + 128, b0, b1);
    }
};
struct F6Mm {
    static constexpr int NMODES = 1;
    float* Y; int second;
    template <int MODE> __device__ __forceinline__ void at(const pg8::Unit& u, int r, int c, f32x4 v) const {
        float* p = Y + (size_t)r * 1024 + u.col0 + c;
        if (second) v = v + *(const f32x4*)p;
        *(f32x4*)p = v;
    }
};

struct SchedMoeUp {
    static constexpr bool GATHER = true;
    volatile LAS unsigned* T; const int* perm; const char* A; const char* W; int G, c, hf;
    __device__ bool next(int i, pg8::Unit& u) const {
        const int TT = (int)T[32]; const long L = (long)i * G + c; if (L >= (long)TT * 14) return false;
        const int gt = (int)(L / 14), pn = (int)(L % 14); int e = 0;
#pragma unroll
        for (int j = 1; j < 8; ++j) e += (gt >= (int)T[24 + j]) ? 1 : 0;
        u.A = A; u.B = W + ((size_t)(e * 2 + hf) * DFFE + (size_t)pn * 256) * (D * 2); u.row0 = gt * 256; u.col0 = pn * 256; u.e = e; u.nvalid = gt - (int)T[24 + e];
        return true;
    }
    __device__ __forceinline__ const int* idx_ptr(const pg8::Unit& u, int R, int h) const {
        const int rank = u.nvalid * 256 + h * 128 + R, cnt = (int)T[16 + u.e];
        return perm + u.e * M + (rank < cnt ? rank : 0);
    }
    __device__ __forceinline__ unsigned a_off(const pg8::Unit& u, int R, int h) const { return (unsigned)(*idx_ptr(u, R, h)) * (unsigned)(D * 2); }
    __device__ __forceinline__ const int* idx_base(const pg8::Unit& u) const { return perm + u.e * M + u.nvalid * 256; }
    __device__ __forceinline__ bool row_ok(const pg8::Unit& u, int rt) const { return u.nvalid * 256 + rt < (int)T[16 + u.e]; }
};
struct SchedMoeDown {
    static constexpr bool GATHER = false;
    volatile LAS unsigned* T; const char* A; const char* W; int G, c, hf;
    __device__ bool next(int i, pg8::Unit& u) const {
        const int TT = (int)T[32]; const long L = (long)i * G + c; if (L >= (long)TT * 4) return false;
        const int gt = (int)(L / 4), pn = (int)(L % 4); int e = 0;
#pragma unroll
        for (int j = 1; j < 8; ++j) e += (gt >= (int)T[24 + j]) ? 1 : 0;
        const int ti = gt - (int)T[24 + e], cnt = (int)T[16 + e];
        u.A = A + (size_t)gt * 256 * (HFF * 2); u.B = W + ((size_t)(e * 2 + hf) * D + (size_t)pn * 256) * (HFF * 2);
        u.row0 = (int)T[40 + e] + ti * 256; u.col0 = pn * 256; u.e = e; u.nvalid = (cnt - ti * 256) < 256 ? (cnt - ti * 256) : 256;
        return true;
    }
    __device__ __forceinline__ unsigned a_off(const pg8::Unit&, int R, int h) const { return (unsigned)(h * 128 + R) * (unsigned)(HFF * 2); }
};

__device__ __forceinline__ int map_b1(int n) {
    if (n < 1024) return n;
    if (n < 2048) { const int t = n - 1024, blk = t >> 9, hh = (t >> 7) & 3, j = t & 127; return (blk ? 3600 : 3088) + hh * 128 + (j >> 1) + 64 * (j & 1); }
    if (n < 3072) return 1024 + (n - 2048);
    if (n < 4096) return 4112 + (n - 3072);
    if (n < 5120) return 6160 + (n - 4096);
    if (n < 6144) return 7184 + (n - 5120);
    if (n < 6160) return 3072 + (n - 6144);
    return -1;
}
__device__ __forceinline__ int map_b2(int n) { return n < 1024 ? 2048 + n : 5136 + (n - 1024); }
__device__ __forceinline__ void cvt_item(const float* W, const float* W2, int kind, int foff, int ldsrc, int koff, int K, bf16* WT, LAS float* scr, int item, int lane) {
    const int nkb = K / 64, nb = item / nkb, kb = item % nkb, k0 = 64 * kb, n0 = 32 * nb;
    const int n = n0 + (lane & 31);
    int col; const float* src = W;
    if (kind == 0) col = n; else if (kind == 1) col = map_b1(n); else if (kind == 2) col = map_b2(n);
    else { col = foff + 128 * (n >> 8) + (n & 127); if (n & 128) src = W2; }
#pragma unroll 8
    for (int i = 0; i < 32; ++i) { const int kk = 2 * i + (lane >> 5); scr[kk * 33 + (lane & 31)] = (col >= 0) ? src[(size_t)(koff + k0 + kk) * ldsrc + col] : 0.f; }
    LDS_WAIT(); asm volatile("" ::: "memory");
    const int c = lane & 7;
#pragma unroll
    for (int j = 0; j < 4; ++j) { const int nn = (lane >> 3) + 8 * j; const LAS float* s = scr + (8 * c) * 33 + nn;
        u32x4 o; o.x = pk2(s[0 * 33], s[1 * 33]); o.y = pk2(s[2 * 33], s[3 * 33]); o.z = pk2(s[4 * 33], s[5 * 33]); o.w = pk2(s[6 * 33], s[7 * 33]);
        *(u32x4*)(WT + (size_t)(n0 + nn) * K + k0 + 8 * c) = o; }
    LDS_WAIT(); asm volatile("" ::: "memory");
}
__device__ __forceinline__ void cvt_job(const Frame& F, int& rot, const float* W, const float* W2, int kind, int foff, int ldsrc, int koff, int K, int Nnew, bf16* WT) {
    LAS float* scr = (LAS float*)(F.lds + F.wave * 16384);
    const int items = (K / 64) * (Nnew / 32);
    int start = F.gwave - rot; if (start < 0) start += F.gwaves;
    for (int it = start; it < items; it += F.gwaves) cvt_item(W, W2, kind, foff, ldsrc, koff, K, WT, scr, it, F.lane);
    rot = (rot + items) % F.gwaves;
}

__device__ __forceinline__ void ln_vals(f32x4 (&v)[4], const float* g, const float* b, int lane) {
    float s = 0.f;
#pragma unroll
    for (int j = 0; j < 4; ++j) s += (v[j][0] + v[j][1]) + (v[j][2] + v[j][3]);
    const float mean = wave_sum(s) * (1.f / D); float s2 = 0.f;
#pragma unroll
    for (int j = 0; j < 4; ++j) { v[j] = v[j] - mean; s2 += (v[j][0] * v[j][0] + v[j][1] * v[j][1]) + (v[j][2] * v[j][2] + v[j][3] * v[j][3]); }
    const float rstd = 1.f / sqrtf(wave_sum(s2) * (1.f / D) + LN_EPS);
#pragma unroll
    for (int j = 0; j < 4; ++j) { const f32x4 gg = *(const f32x4*)(g + 4 * lane + 256 * j), bb = *(const f32x4*)(b + 4 * lane + 256 * j); v[j] = v[j] * rstd * gg + bb; }
}
__device__ __forceinline__ void row_load(f32x4 (&v)[4], const float* p, int lane) {
#pragma unroll
    for (int j = 0; j < 4; ++j) v[j] = *(const f32x4*)(p + 4 * lane + 256 * j);
}
__device__ __forceinline__ void row_store(const f32x4 (&v)[4], float* p, bf16* pb, int lane, int dry = 0) {
    if (dry) return;
#pragma unroll
    for (int j = 0; j < 4; ++j) { *(f32x4*)(p + 4 * lane + 256 * j) = v[j]; store_bf4(pb + 4 * lane + 256 * j, v[j]); }
}
__device__ __forceinline__ void route_row(const f32x4 (&v)[4], const float* wr, int lane, int& e1, int& e2, float& w1, float& w2) {
    float lg[8];
#pragma unroll
    for (int e = 0; e < 8; ++e) lg[e] = 0.f;
#pragma unroll
    for (int j = 0; j < 4; ++j)
#pragma unroll
        for (int q = 0; q < 4; ++q) { const float* w = wr + (size_t)(4 * lane + 256 * j + q) * 8; const f32x4 wa = *(const f32x4*)w, wb = *(const f32x4*)(w + 4); const float x = v[j][q];
            lg[0] += x * wa[0]; lg[1] += x * wa[1]; lg[2] += x * wa[2]; lg[3] += x * wa[3]; lg[4] += x * wb[0]; lg[5] += x * wb[1]; lg[6] += x * wb[2]; lg[7] += x * wb[3]; }
#pragma unroll
    for (int e = 0; e < 8; ++e) lg[e] = wave_sum(lg[e]);
    int a = 0; float la = lg[0];
#pragma unroll
    for (int e = 1; e < 8; ++e) if (lg[e] > la) { la = lg[e]; a = e; }
    int b = -1; float lb = -3.0e38f;
#pragma unroll
    for (int e = 0; e < 8; ++e) if (e != a && lg[e] > lb) { lb = lg[e]; b = e; }
    const float t = __expf(lb - la);
    e1 = a; e2 = b; w1 = 1.f / (1.f + t); w2 = t / (1.f + t);
}

constexpr int MX_QIN = 0, MX_KIN = 33792, MX_P = 67584, MX_OB = 84224, MX_VT = 100608  ;
constexpr int MX_GA = 133376, MX_SEG = 137472  , MX_DEC = 139520  , MX_END = 140032;
static_assert(MX_END <= MISC_OFF, "mixer LDS below the MISC words");
struct MixArgs {
    bf16* QK; bf16* V; const float* GA;
    bf16* mQK; bf16* mV; const float* mGA; bf16* mO;
    const float* wa2; const float* ba; const float* gng; const float* rng; const float* rnb;
    int dry;
};
__device__ __forceinline__ void mixer_phase(const Frame& F, const MixArgs& a) {
    LAS float* qin = (LAS float*)(F.lds + MX_QIN); LAS float* kin = (LAS float*)(F.lds + MX_KIN); LAS float* P = (LAS float*)(F.lds + MX_P);
    LAS float* ob = (LAS float*)(F.lds + MX_OB); LAS bf16* vt = (LAS bf16*)(F.lds + MX_VT); LAS float* bc = (LAS float*)(F.lds + MX_P);
    LAS float* gab = (LAS float*)(F.lds + MX_GA); LAS float* seg = (LAS float*)(F.lds + MX_SEG); LAS float* dec = (LAS float*)(F.lds + MX_DEC);
    const int tid = F.tid, lane = F.lane, wave = F.wave, vv = tid & 255, dh = tid >> 8;
    for (int it = F.bid; it < NB * 8; it += F.G) {
        const int b = it >> 3, type = (it >> 2) & 1, head = it & 3;
        const int qcol = (type ? 1024 : 0) + head * 128, kcol = qcol + 512, vcol = type * 1024 + head * 256;
        const float lng = __logf(1.0f - exp2f(-5.0f - (float)head));
        float S[64];
#pragma unroll
        for (int i = 0; i < 64; ++i) S[i] = 0.f;
        const int gd = tid & 127, gi = tid >> 7;
        float wa[16]; float bad = 0.f;
        if (type == 0) {
#pragma unroll
            for (int r = 0; r < 16; ++r) wa[r] = a.wa2[r * 512 + head * 128 + gd];
            bad = a.ba[head * 128 + gd];
        } else {
#pragma unroll
            for (int r = 0; r < 16; ++r) wa[r] = 0.f;
        }
#pragma unroll 1
        for (int ch = -1; ch < 32; ++ch) {
            const bool meta = ch < 0;
            const bf16* qkb = meta ? a.mQK : a.QK + (size_t)(b * SEQ + ch * 64) * 2048;
            bf16* vb = meta ? a.mV : a.V + (size_t)(b * SEQ + ch * 64) * 2048;
            const float* gb = meta ? a.mGA : a.GA + (size_t)(b * SEQ + ch * 64) * 16;
            const int roff = meta ? 48 : 0;
            __syncthreads();
            for (int e = tid; e < 64 * 32; e += NTHR) {
                const int i = e >> 5, c4 = (e & 31) * 4; f32x4 q = (f32x4){0.f, 0.f, 0.f, 0.f}, k = q;
                if (i >= roff) { q = load_bf4(qkb + (size_t)(i - roff) * 2048 + qcol + c4); k = load_bf4(qkb + (size_t)(i - roff) * 2048 + kcol + c4); }
                *(LAS f32x4*)(qin + i * 132 + c4) = q; *(LAS f32x4*)(kin + i * 132 + c4) = k;
            }
            for (int e = tid; e < 64 * 64; e += NTHR) {
                const int i = e >> 6, c4 = (e & 63) * 4; u32x2 w; w.x = 0u; w.y = 0u;
                if (i >= roff) w = *(const u32x2*)(vb + (size_t)(i - roff) * 2048 + vcol + c4);
                *(LAS u32x2*)(vt + i * 256 + c4) = w;
            }
            if (type == 0) for (int e = tid; e < 64 * 16; e += NTHR) { const int i = e >> 4; gab[e] = (i >= roff) ? gb[(size_t)(i - roff) * 16 + (e & 15)] : 0.f; }
            __syncthreads();
            if (type == 0) {
                float run = 0.f;
#pragma unroll 4
                for (int ii = 0; ii < 16; ++ii) { const int i = gi * 16 + ii; float pre = bad;
#pragma unroll
                    for (int r = 0; r < 16; ++r) pre += gab[i * 16 + r] * wa[r];
                    const float ls = fminf(pre, 0.f) - log1pf(__expf(-fabsf(pre)));
                    run += (i >= roff) ? ls * (1.0f / 16.0f) : 0.f; bc[i * 128 + gd] = run; }
                seg[gi * 128 + gd] = run;
                __syncthreads();
                float off = 0.f;
#pragma unroll
                for (int g = 0; g < 4; ++g) off += (g < gi) ? seg[g * 128 + gd] : 0.f;
                if (gi == 3) dec[gd] = __expf(off + run);
#pragma unroll 4
                for (int ii = 0; ii < 16; ++ii) { const int i = gi * 16 + ii; const float bb = bc[i * 128 + gd] + off;
                    qin[i * 132 + gd] *= __expf(bb); kin[i * 132 + gd] *= __expf(-bb); }
            } else {
#pragma unroll 4
                for (int ii = 0; ii < 16; ++ii) { const int i = gi * 16 + ii; const float bb = (float)(i + 1) * lng;
                    qin[i * 132 + gd] *= __expf(bb); kin[i * 132 + gd] *= __expf(-bb); }
                if (gi == 3) dec[gd] = __expf(64.0f * lng);
            }
            __syncthreads();
            {
                const int i = tid >> 3, j0 = (tid & 7) * 8; float sc[8];
#pragma unroll
                for (int jj = 0; jj < 8; ++jj) sc[jj] = 0.f;
                for (int d4 = 0; d4 < 128; d4 += 4) { const f32x4 q = *(const LAS f32x4*)(qin + i * 132 + d4);
#pragma unroll
                    for (int jj = 0; jj < 8; ++jj) { const f32x4 k = *(const LAS f32x4*)(kin + (j0 + jj) * 132 + d4); sc[jj] += (q[0] * k[0] + q[1] * k[1]) + (q[2] * k[2] + q[3] * k[3]); } }
                __syncthreads();
#pragma unroll
                for (int jj = 0; jj < 8; ++jj) P[i * 65 + j0 + jj] = (j0 + jj <= i) ? sc[jj] : 0.f;
            }
            __syncthreads();
#pragma unroll 1
            for (int p = 0; p < 8; ++p) {
#pragma unroll 1
                for (int ii = 0; ii < 8; ++ii) { const int i = p * 8 + ii; float s = 0.f;
#pragma unroll
                    for (int d4 = 0; d4 < 64; d4 += 4) { const f32x4 q = *(const LAS f32x4*)(qin + i * 132 + dh * 64 + d4); s += (q[0] * S[d4] + q[1] * S[d4 + 1]) + (q[2] * S[d4 + 2] + q[3] * S[d4 + 3]); }
                    const int jlo = dh ? (i >> 1) + 1 : 0, jhi = dh ? i : (i >> 1);
                    for (int j = jlo; j <= jhi; ++j) s += P[i * 65 + j] * bf2f(vt[j * 256 + vv]);
                    ob[(dh * 8 + ii) * 256 + vv] = s; }
                __syncthreads();
                {
                    const int ii = wave, i = p * 8 + ii;
                    const f32x4 o = *(const LAS f32x4*)(ob + ii * 256 + lane * 4) + *(const LAS f32x4*)(ob + (8 + ii) * 256 + lane * 4);
                    f32x4 y;
                    if (type == 0) {
                        const float ss = wave_sum((o[0] * o[0] + o[1] * o[1]) + (o[2] * o[2] + o[3] * o[3]));
                        const float rs = 1.0f / sqrtf(ss * (1.0f / 256.0f) + LN_EPS);
                        const f32x4 g = *(const f32x4*)(a.gng + lane * 4); y = o * rs * g;
                    } else {
                        const float mu = wave_sum((o[0] + o[1]) + (o[2] + o[3])) * (1.0f / 256.0f); const f32x4 dd = o - mu;
                        const float var = wave_sum((dd[0] * dd[0] + dd[1] * dd[1]) + (dd[2] * dd[2] + dd[3] * dd[3])) * (1.0f / 256.0f);
                        const float rs = 1.0f / sqrtf(var + GN_EPS);
                        const f32x4 g = *(const f32x4*)(a.rng + head * 256 + lane * 4), bb = *(const f32x4*)(a.rnb + head * 256 + lane * 4); y = dd * rs * g + bb;
                    }
                    if (i >= roff && (!meta || b == 0) && !a.dry) store_bf4((meta ? a.mO : vb) + (size_t)(i - roff) * 2048 + vcol + lane * 4, y);
                }
                __syncthreads();
            }
#pragma unroll 1
            for (int j = 0; j < 64; ++j) { const float vj = bf2f(vt[j * 256 + vv]);
#pragma unroll
                for (int d4 = 0; d4 < 64; d4 += 4) { const f32x4 k = *(const LAS f32x4*)(kin + j * 132 + dh * 64 + d4); S[d4] += k[0] * vj; S[d4 + 1] += k[1] * vj; S[d4 + 2] += k[2] * vj; S[d4 + 3] += k[3] * vj; } }
#pragma unroll
            for (int d4 = 0; d4 < 64; d4 += 4) { const f32x4 dc = *(const LAS f32x4*)(dec + dh * 64 + d4); S[d4] *= dc[0]; S[d4 + 1] *= dc[1]; S[d4 + 2] *= dc[2]; S[d4 + 3] *= dc[3]; }
        }
    }
    __syncthreads();
}

typedef float f32x16 __attribute__((ext_vector_type(16)));
typedef short s16x4 __attribute__((ext_vector_type(4)));
constexpr int QROW = 272, PROW = 144, KTROW = 144, OROWF = 260;
constexpr int FM_QIN = 0, FM_KIN = 17408, FM_PT = 34816, FM_KT = 44032  , FM_OT = 0  ,
              FM_VS = 66560  , FM_SEG = 99328, FM_DEC = 101376, FM_GA = 101888  , FM_WA = 110080  , FM_NG = 118272  , FM_END = 120320;
static_assert(FM_KT + 128 * KTROW <= FM_VS && FM_END <= MISC_OFF, "fast mixer LDS map");
__device__ __forceinline__ bf16x8 pack8(float a0, float a1, float a2, float a3, float a4, float a5, float a6, float a7) {
    u32x4 p; p.x = pk2_sw(a0, a1); p.y = pk2_sw(a2, a3); p.z = pk2_sw(a4, a5); p.w = pk2_sw(a6, a7); return __builtin_bit_cast(bf16x8, p);
}
#define MIX_BAR() do { asm volatile("s_waitcnt lgkmcnt(0)" ::: "memory"); __builtin_amdgcn_s_barrier(); asm volatile("" ::: "memory"); } while (0)
__device__ __forceinline__ void mixer_fast(const Frame& F, const MixArgs& a) {
    LAS unsigned char* L = F.lds;
    LAS float* seg = (LAS float*)(L + FM_SEG); LAS float* dec = (LAS float*)(L + FM_DEC); LAS float* ot = (LAS float*)(L + FM_OT);
    const int tid0 = F.tid, wave = F.wave;
    const int gi = __builtin_amdgcn_readfirstlane(tid0 >> 7);
    LAS unsigned char* slab = L + FM_VS + wave * 4096;
    for (int it = F.bid; it < NB * 8; it += F.G) {
        int tid = tid0; asm volatile("" : "+v"(tid));
        int lane = tid & 63, gd = tid & 127, l32 = lane & 31, hh = lane >> 5, l16 = lane & 15, quad = lane >> 4;
        const int b = it >> 3, type = (it >> 2) & 1, head = it & 3;
        const int qcol = (type ? 1024 : 0) + head * 128, kcol = qcol + 512, vcol = type * 1024 + head * 256;
        const float lng = __logf(1.0f - exp2f(-5.0f - (float)head));
        f32x16 S[4];
#pragma unroll
        for (int T = 0; T < 4; ++T)
#pragma unroll
            for (int r = 0; r < 16; ++r) S[T][r] = 0.f;
        LAS float* ngL = (LAS float*)(L + FM_NG);
        if (tid0 < 256) { ngL[tid0] = (type == 0) ? a.gng[tid0] : a.rng[head * 256 + tid0]; ngL[256 + tid0] = (type == 0) ? 0.f : a.rnb[head * 256 + tid0]; }
        float bad = 0.f;
        LAS float* waL = (LAS float*)(L + FM_WA);
        if (type == 0) { bad = a.ba[head * 128 + gd];
            if (tid0 < 128) {
#pragma unroll
                for (int r = 0; r < 16; ++r) waL[r * 128 + gd] = a.wa2[r * 512 + head * 128 + gd]; } }
        unsigned qraw[16], kraw[16];
        { const unsigned qoff = (unsigned)(qcol + gd) * 2u, koff = (unsigned)(kcol + gd) * 2u;
#pragma unroll
        for (int ii = 0; ii < 16; ++ii) { qraw[ii] = 0u; kraw[ii] = 0u; }
        if (gi == 3) {
#pragma unroll
            for (int ii = 0; ii < 16; ++ii) { const char* rb = (const char*)a.mQK + (size_t)ii * 4096; qraw[ii] = *(const bf16*)(rb + qoff); kraw[ii] = *(const bf16*)(rb + koff); }
        } }
        {
            unsigned z0 = 0u; asm volatile("" : "+v"(z0));
            const u32x4 z = (u32x4){z0, z0, z0, z0};
#pragma unroll
            for (int j = 0; j < 3; ++j) *(LAS u32x4*)(slab + j * 1024 + lane * 16) = z;
            __builtin_amdgcn_global_load_lds((const unsigned*)(a.mV + (size_t)(lane >> 2) * 2048 + vcol + 32 * wave + 8 * (lane & 3)), (LAS unsigned*)(slab + 3 * 1024), 16, 0, 0);
        }
        if (type == 0 && gi == 3) __builtin_amdgcn_global_load_lds((const unsigned*)(a.mGA + lane * 4), (LAS unsigned*)(L + FM_GA + wave * 1024), 16, 0, 0);
        MIX_BAR();
#pragma unroll 1
        for (int ch = -1; ch < 32; ++ch) {
            const bool meta = ch < 0;
            bf16* vb = meta ? a.mV : a.V + (size_t)(b * SEQ + ch * 64) * 2048;
            const int roff = meta ? 48 : 0;
            int gio = gi; asm volatile("" : "+s"(gio));
            tid = tid0; asm volatile("" : "+v"(tid));
            lane = tid & 63; gd = tid & 127; l32 = lane & 31; hh = lane >> 5; l16 = lane & 15; quad = lane >> 4;
            const unsigned qoff = (unsigned)(qcol + gd) * 2u, koff = (unsigned)(kcol + gd) * 2u;
            asm volatile("s_waitcnt vmcnt(0)" ::: "memory");
            float bcs[16]; float run = 0.f;
            if (type == 0) {
                const LAS f32x4* gr = (const LAS f32x4*)(L + FM_GA + wave * 1024);
                float wa[16];
#pragma unroll
                for (int r = 0; r < 16; ++r) wa[r] = waL[r * 128 + gd];
#pragma unroll
                for (int ii = 0; ii < 16; ++ii) { const int c = gio * 16 + ii;
                    const f32x4 g0 = gr[ii * 4], g1 = gr[ii * 4 + 1], g2 = gr[ii * 4 + 2], g3 = gr[ii * 4 + 3];
                    float pre = bad + ((g0[0] * wa[0] + g0[1] * wa[1]) + (g0[2] * wa[2] + g0[3] * wa[3])) + ((g1[0] * wa[4] + g1[1] * wa[5]) + (g1[2] * wa[6] + g1[3] * wa[7]))
                                    + ((g2[0] * wa[8] + g2[1] * wa[9]) + (g2[2] * wa[10] + g2[3] * wa[11])) + ((g3[0] * wa[12] + g3[1] * wa[13]) + (g3[2] * wa[14] + g3[3] * wa[15]));
                    float ls = (fminf(pre, 0.f) - __logf(1.0f + __expf(-fabsf(pre)))) * (1.0f / 16.0f);
                    ls = (c >= roff) ? ls : 0.f;
                    run += ls; bcs[ii] = run; }
                seg[gio * 128 + gd] = run;
            } else {
#pragma unroll
                for (int ii = 0; ii < 16; ++ii) bcs[ii] = (float)(gio * 16 + ii + 1) * lng;
            }
            MIX_BAR();
            float off = 0.f;
            if (type == 0) {
#pragma unroll
                for (int g = 0; g < 4; ++g) off += (g < gio) ? seg[g * 128 + gd] : 0.f;
                if (gio == 3) dec[gd] = __expf(off + run);
            } else if (gio == 3) dec[gd] = __expf(64.0f * lng);
            {
                unsigned kt[8];
#pragma unroll
                for (int ii = 0; ii < 16; ++ii) { const int c = gio * 16 + ii; const float bb = bcs[ii] + off; const float eb = __expf(bb), en = __expf(-bb);
                    const unsigned qkv = pk2(bf2f(qraw[ii]) * eb, bf2f(kraw[ii]) * en); const unsigned qv = qkv & 0xffffu, kv = qkv >> 16;
                    *(LAS bf16*)(L + FM_QIN + c * QROW + gd * 2) = (bf16)qv; *(LAS bf16*)(L + FM_KIN + c * QROW + gd * 2) = (bf16)kv;
                    if (ii & 1) kt[ii >> 1] |= kv << 16; else kt[ii >> 1] = kv; }
                *(LAS u32x4*)(L + FM_KT + gd * KTROW + gio * 32) = (u32x4){kt[0], kt[1], kt[2], kt[3]};
                *(LAS u32x4*)(L + FM_KT + gd * KTROW + gio * 32 + 16) = (u32x4){kt[4], kt[5], kt[6], kt[7]};
            }
            MIX_BAR();
#pragma unroll 1
            for (int tt = wave; tt < 10; tt += 8) {
                const int ti = (tt >= 6) ? 3 : (tt >= 3) ? 2 : (tt >= 1) ? 1 : 0, tj = tt - ti * (ti + 1) / 2;
                f32x4 pacc = (f32x4){0.f, 0.f, 0.f, 0.f};
#pragma unroll
                for (int ks = 0; ks < 4; ++ks) {
                    const bf16x8 A = *(const LAS bf16x8*)(L + FM_QIN + (16 * ti + l16) * QROW + (32 * ks + 8 * quad) * 2);
                    const bf16x8 B = *(const LAS bf16x8*)(L + FM_KIN + (16 * tj + l16) * QROW + (32 * ks + 8 * quad) * 2);
                    pacc = __builtin_amdgcn_mfma_f32_16x16x32_bf16(A, B, pacc, 0, 0, 0);
                }
#pragma unroll
                for (int jj = 0; jj < 4; jj += 2) { const int row = 16 * ti + 4 * quad + jj, col = 16 * tj + l16;
                    const unsigned pp = pk2((col > row) ? 0.f : pacc[jj], (col > row + 1) ? 0.f : pacc[jj + 1]);
                    *(LAS bf16*)(L + FM_PT + row * PROW + col * 2) = (bf16)(pp & 0xffffu); *(LAS bf16*)(L + FM_PT + (row + 1) * PROW + col * 2) = (bf16)(pp >> 16); }
            }
            if (wave == 2 || wave == 3) {
                const int ti = (wave == 2) ? 0 : 2, tj = ti + 1;
#pragma unroll
                for (int jj = 0; jj < 4; ++jj) *(LAS bf16*)(L + FM_PT + (16 * ti + 4 * quad + jj) * PROW + (16 * tj + l16) * 2) = (bf16)0;
            }
            MIX_BAR();
            bf16x8 vf[4];
            {
                const unsigned base = (unsigned)(size_t)(slab + (8 * hh + (l16 >> 2)) * 64 + 32 * (quad & 1) + 8 * (l16 & 3));
                s16x4 t0, t1, t2, t3, t4, t5, t6, t7;
                asm volatile("ds_read_b64_tr_b16 %0, %8\n\tds_read_b64_tr_b16 %1, %8 offset:256\n\tds_read_b64_tr_b16 %2, %8 offset:1024\n\tds_read_b64_tr_b16 %3, %8 offset:1280\n\t"
                             "ds_read_b64_tr_b16 %4, %8 offset:2048\n\tds_read_b64_tr_b16 %5, %8 offset:2304\n\tds_read_b64_tr_b16 %6, %8 offset:3072\n\tds_read_b64_tr_b16 %7, %8 offset:3328\n\ts_waitcnt lgkmcnt(0)"
                             : "=&v"(t0), "=&v"(t1), "=&v"(t2), "=&v"(t3), "=&v"(t4), "=&v"(t5), "=&v"(t6), "=&v"(t7) : "v"(base) : "memory");
                vf[0] = (bf16x8){t0[0], t0[1], t0[2], t0[3], t1[0], t1[1], t1[2], t1[3]}; vf[1] = (bf16x8){t2[0], t2[1], t2[2], t2[3], t3[0], t3[1], t3[2], t3[3]};
                vf[2] = (bf16x8){t4[0], t4[1], t4[2], t4[3], t5[0], t5[1], t5[2], t5[3]}; vf[3] = (bf16x8){t6[0], t6[1], t6[2], t6[3], t7[0], t7[1], t7[2], t7[3]};
            }
            if (ch < 31) { const bf16* nq = a.QK + (size_t)(b * SEQ + (ch + 1) * 64 + gi * 16) * 2048;
#pragma unroll
                for (int ii = 0; ii < 16; ++ii) { const char* rb = (const char*)nq + (size_t)ii * 4096; qraw[ii] = *(const bf16*)(rb + qoff); kraw[ii] = *(const bf16*)(rb + koff); } }
            __builtin_amdgcn_sched_barrier(0);
            f32x16 O[2];
#pragma unroll
            for (int mt = 0; mt < 2; ++mt)
#pragma unroll
                for (int r = 0; r < 16; ++r) O[mt][r] = 0.f;
#pragma unroll
            for (int mt = 0; mt < 2; ++mt)
#pragma unroll
                for (int ks = 0; ks < 2 * mt + 2; ++ks) {
                    const bf16x8 A = *(const LAS bf16x8*)(L + FM_PT + (32 * mt + l32) * PROW + (16 * ks + 8 * hh) * 2);
                    O[mt] = __builtin_amdgcn_mfma_f32_32x32x16_bf16(A, vf[ks], O[mt], 0, 0, 0);
                }
#pragma unroll
            for (int T = 0; T < 4; ++T) {
                bf16x8 Aq[2][2];
#pragma unroll
                for (int s2 = 0; s2 < 2; ++s2)
#pragma unroll
                    for (int mt = 0; mt < 2; ++mt) {
                        const LAS unsigned char* qp = L + FM_QIN + (32 * mt + l32) * QROW + (32 * T + 16 * s2 + 4 * hh) * 2;
                        const u32x2 lo = *(const LAS u32x2*)qp, hi = *(const LAS u32x2*)(qp + 16);
                        Aq[s2][mt] = __builtin_bit_cast(bf16x8, (u32x4){lo.x, lo.y, hi.x, hi.y});
                    }
#pragma unroll
                for (int s2 = 0; s2 < 2; ++s2) {
                    const bf16x8 Bs = pack8(S[T][8 * s2], S[T][8 * s2 + 1], S[T][8 * s2 + 2], S[T][8 * s2 + 3], S[T][8 * s2 + 4], S[T][8 * s2 + 5], S[T][8 * s2 + 6], S[T][8 * s2 + 7]);
                    O[0] = __builtin_amdgcn_mfma_f32_32x32x16_bf16(Aq[s2][0], Bs, O[0], 0, 0, 0);
                    O[1] = __builtin_amdgcn_mfma_f32_32x32x16_bf16(Aq[s2][1], Bs, O[1], 0, 0, 0);
                }
                __builtin_amdgcn_sched_barrier(0);
            }
#pragma unroll
            for (int T = 0; T < 4; ++T) {
                bf16x8 Ak[4]; f32x4 dc[4];
#pragma unroll
                for (int ks = 0; ks < 4; ++ks) Ak[ks] = *(const LAS bf16x8*)(L + FM_KT + (32 * T + l32) * KTROW + (16 * ks + 8 * hh) * 2);
#pragma unroll
                for (int q4 = 0; q4 < 4; ++q4) dc[q4] = *(const LAS f32x4*)(dec + 32 * T + 8 * q4 + 4 * hh);
#pragma unroll
                for (int ks = 0; ks < 4; ++ks) S[T] = __builtin_amdgcn_mfma_f32_32x32x16_bf16(Ak[ks], vf[ks], S[T], 0, 0, 0);
#pragma unroll
                for (int q4 = 0; q4 < 4; ++q4) { S[T][4 * q4] *= dc[q4][0]; S[T][4 * q4 + 1] *= dc[q4][1]; S[T][4 * q4 + 2] *= dc[q4][2]; S[T][4 * q4 + 3] *= dc[q4][3]; }
                __builtin_amdgcn_sched_barrier(0);
            }
            if (ch < 31) { const bf16* nv = a.V + (size_t)(b * SEQ + (ch + 1) * 64) * 2048 + vcol + 32 * wave + 8 * (lane & 3);
                asm volatile("s_waitcnt lgkmcnt(0)" ::: "memory");
#pragma unroll
                for (int j = 0; j < 4; ++j) __builtin_amdgcn_global_load_lds((const unsigned*)(nv + (size_t)(16 * j + (lane >> 2)) * 2048), (LAS unsigned*)(slab + j * 1024), 16, 0, 0);
                if (type == 0) __builtin_amdgcn_global_load_lds((const unsigned*)(a.GA + (size_t)(b * SEQ + (ch + 1) * 64 + gi * 16) * 16 + lane * 4), (LAS unsigned*)(L + FM_GA + wave * 1024), 16, 0, 0); }
            MIX_BAR();
#pragma unroll
            for (int mt = 0; mt < 2; ++mt)
#pragma unroll
                for (int r = 0; r < 16; ++r) ot[(32 * mt + (r & 3) + 8 * (r >> 2) + 4 * hh) * OROWF + 32 * wave + l32] = O[mt][r];
            MIX_BAR();
            const f32x4 ng = *(const LAS f32x4*)(ngL + lane * 4), nb = *(const LAS f32x4*)(ngL + 256 + lane * 4);
#pragma unroll 2
            for (int rr = 0; rr < 8; ++rr) {
                const int i = wave * 8 + rr;
                const f32x4 o = *(const LAS f32x4*)(ot + i * OROWF + lane * 4);
                f32x4 y;
                if (type == 0) {
                    const float ss = wave_sum((o[0] * o[0] + o[1] * o[1]) + (o[2] * o[2] + o[3] * o[3]));
                    const float rs = __builtin_amdgcn_rsqf(ss * (1.0f / 256.0f) + LN_EPS);
                    y = o * rs * ng;
                } else {
                    const float mu = wave_sum((o[0] + o[1]) + (o[2] + o[3])) * (1.0f / 256.0f); const f32x4 dd = o - mu;
                    const float var = wave_sum((dd[0] * dd[0] + dd[1] * dd[1]) + (dd[2] * dd[2] + dd[3] * dd[3])) * (1.0f / 256.0f);
                    const float rs = __builtin_amdgcn_rsqf(var + GN_EPS);
                    y = dd * rs * ng + nb;
                }
                if (i >= roff && (!meta || b == 0) && !a.dry) store_bf4((meta ? a.mO : vb) + (size_t)(i - roff) * 2048 + vcol + lane * 4, y);
            }
        }
        MIX_BAR();
    }
}

typedef const __attribute__((address_space(4))) Args* KArgs;
__device__ __forceinline__ KArgs kargs() { KArgs p = (KArgs)__builtin_amdgcn_kernarg_segment_ptr(); asm volatile("" : "+s"(p)); return p; }
#define ENV() \
    KArgs A_ = kargs(); \
    Frame F; { int t_ = threadIdx.x; asm volatile("" : "+v"(t_)); int b_ = blockIdx.x; asm volatile("" : "+s"(b_)); \
        { LAS unsigned char* l_ = (LAS unsigned char*)lds_raw; asm volatile("" : "+s"(l_)); F.lds = l_; } F.MISC = (volatile LAS unsigned*)(F.lds + MISC_OFF); F.tid = t_; F.lane = t_ & 63; F.wave = __builtin_amdgcn_readfirstlane(t_ >> 6); \
        F.G = gridDim.x; F.bid = b_; F.gtid = b_ * NTHR + t_; F.gthreads = F.G * NTHR; F.gwave = b_ * NWAVES + F.wave; F.gwaves = F.G * NWAVES; F.ws = A_->ws; F.ctl = (unsigned*)(A_->ws + WS_CTL); } \
    unsigned char* ws = A_->ws; typedef const float* cfp_; const __attribute__((address_space(4))) cfp_* in = A_->in; \
    float* XA = (float*)(ws + WS_XA); float* XB = A_->out; bf16* XBF = (bf16*)(ws + WS_XBF); \
    bf16* QK = (bf16*)(ws + WS_QK); bf16* V = (bf16*)(ws + WS_V); float* GA = (float*)(ws + WS_GA); \
    bf16* MRG = QK; bf16* U = QK; const f32x2* rope = (const f32x2*)(ws + WS_ROPE); \
    unsigned char* mt = ws + WS_META; \
    float* mHA = (float*)(mt + MT_HA); float* mHB = (float*)(mt + MT_HB); bf16* mXB = (bf16*)(mt + MT_XB); bf16* mQK = (bf16*)(mt + MT_QK); bf16* mV = (bf16*)(mt + MT_V); \
    bf16* mSIG = (bf16*)(mt + MT_SIG); float* mGA = (float*)(mt + MT_GA); bf16* mMRG = (bf16*)(mt + MT_MRG); bf16* mU = (bf16*)(mt + MT_U); float* mY = (float*)(mt + MT_Y); \
    bf16* mUall = (bf16*)(ws + WS_META2); float* mYall = (float*)(ws + WS_META2 + 512 * 1024); (void)mUall; (void)mYall; \
    bf16* mO = (bf16*)(mt + MT_O); int* mTokE = (int*)(mt + MT_TOK); float* mTokW = (float*)(mt + MT_TOK + 128); \
    int* perm = (int*)(ws + WS_MOE); int* tok_slot = (int*)(ws + WS_MOE + 2 * MiB); float* tok_w = (float*)(ws + WS_MOE + 2 * MiB + 512 * 1024); \
    const bf16* B1t = (const bf16*)(ws + WS_W + W_B1); const bf16* B2t = (const bf16*)(ws + WS_W + W_B2); const bf16* PAt = (const bf16*)(ws + WS_W + W_PA); \
    const bf16* PBt = (const bf16*)(ws + WS_W + W_PB); const bf16* Ot = (const bf16*)(ws + WS_W + W_O); const bf16* FGU = (const bf16*)(ws + WS_W + W_F); \
    const bf16* FDd = (const bf16*)(ws + WS_W + W_FD_DENSE); const bf16* FDm = (const bf16*)(ws + WS_W + W_FD_MOE); \
    const float* hin = (l == 0) ? in[I_X] : (l == 1 ? XB : XA); float* x1buf = (l < 2) ? XA : XB; float* x2buf = (l == 0) ? XB : XA; \
    bf16* SIG = (bf16*)x1buf; bf16* Y = (bf16*)((l == 1) ? XB : XA); \
    const float* mhin = (l == 0) ? in[I_META] : (l == 1 ? mHB : mHA); float* mx1 = (l < 2) ? mHA : mHB; float* mx2 = (l == 0) ? mHB : mHA; \
    (void)XA; (void)XB; (void)XBF; (void)QK; (void)V; (void)GA; (void)MRG; (void)U; (void)rope; (void)mHA; (void)mHB; (void)mXB; (void)mQK; (void)mV; (void)mSIG; (void)mGA; (void)mMRG; (void)mU; (void)mY; \
    (void)mO; (void)mTokE; (void)mTokW; (void)perm; (void)tok_slot; (void)tok_w; (void)B1t; (void)B2t; (void)PAt; (void)PBt; (void)Ot; (void)FGU; (void)FDd; (void)FDm; (void)hin; (void)x1buf; (void)x2buf; \
    (void)SIG; (void)Y; (void)mhin; (void)mx1; (void)mx2; (void)in

__global__ void __launch_bounds__(NTHR, 2) fwd_kernel(Args args) {
    extern __shared__ __attribute__((aligned(16))) unsigned char lds_raw[];
    const int lo = args.ph_lo, hi = args.ph_hi;
    const bool multi = (hi - lo) > 1;
    {
        volatile LAS unsigned* MISC0 = (volatile LAS unsigned*)((LAS unsigned char*)lds_raw + MISC_OFF);
        for (int u = threadIdx.x; u < 256; u += NTHR) MISC0[u] = 0u;
        __syncthreads();
        if (multi) (void)xcd_barrier_post((unsigned*)(args.ws + WS_CTL) + CW_BAR + args.li * XCD_BAR_WORDS, MISC0);
    }
#ifndef PH_MASK
#define PH_MASK 0xFFF
#endif
#define INS(slot, k) ((((PH_MASK) >> (slot)) & 1) && lo <= (k) && (k) < hi)
#define IN(k) (lo <= (k) && (k) < hi)
#define SEAM(k) do { if (IN(k) && IN((k) + 1)) { KArgs B_ = kargs(); XcdBarrier bar; bar.bar = (unsigned*)(B_->ws + WS_CTL) + CW_BAR + B_->li * XCD_BAR_WORDS; bar.x = xb_xcc_id(); \
        bar.st = (volatile LAS unsigned*)((LAS unsigned char*)lds_raw + MISC_OFF); xcd_barrier(bar); } } while (0)

    for (int l = 0; l < DEPTH; ++l) {
        const int pb = l * NPH;
        if (hi <= pb || lo >= pb + NPH) continue;
        const bool moe = (l & 1) != 0; const int l2 = l >> 1;
        if (INS(0, pb + 0)) { ENV();
            int rot = 0;
            const float* win = in[I_WIN] + (size_t)l * D * NIN;
            cvt_job(F, rot, win, nullptr, 1, 0, NIN, 0, D, N1, (bf16*)B1t);
            cvt_job(F, rot, win, nullptr, 2, 0, NIN, 0, D, 2048, (bf16*)B2t);
            cvt_job(F, rot, in[I_WPA] + (size_t)l * D * D, nullptr, 0, 0, D, 0, D, D, (bf16*)PAt);
            cvt_job(F, rot, in[I_WPB] + (size_t)l * D * D, nullptr, 0, 0, D, 0, D, D, (bf16*)PBt);
            cvt_job(F, rot, in[I_WO] + (size_t)l * D * D, nullptr, 0, 0, D, 0, D, D, (bf16*)Ot);
            if (!moe) {
                cvt_job(F, rot, in[I_FG] + (size_t)l2 * D * DFF, in[I_FU] + (size_t)l2 * D * DFF, 3, 0, DFF, 0, D, 2 * DFF, (bf16*)FGU);
                cvt_job(F, rot, in[I_FD] + (size_t)l2 * DFF * D, nullptr, 0, 0, D, 0, DFF, D, (bf16*)FDd);
            } else {
                for (int e = 0; e < NEXP; ++e)
                    for (int hf = 0; hf < 2; ++hf) {
                        const float* wg = in[I_MG] + ((size_t)l2 * NEXP + e) * D * DFFE; const float* wu = in[I_MU] + ((size_t)l2 * NEXP + e) * D * DFFE;
                        cvt_job(F, rot, wg, wu, 3, hf * HFF, DFFE, 0, D, DFFE, (bf16*)FGU + (size_t)(e * 2 + hf) * DFFE * D);
                        cvt_job(F, rot, in[I_MD] + ((size_t)l2 * NEXP + e) * DFFE * D, nullptr, 0, 0, D, hf * HFF, HFF, D, (bf16*)FDm + (size_t)(e * 2 + hf) * D * HFF);
                    }
                if (F.gtid < NEXP) F.ctl[CW_CNT + 64 * F.gtid] = 0u;
            }
            if (l == 0) {
                for (int i = F.gtid; i < 2064 * 64; i += F.gthreads) { const int pos = i >> 6, k = i & 63; const float inv = powf(10000.0f, -(float)k / 64.0f); const float ang = (float)pos * inv;
                    float sn, cs; sincosf(ang, &sn, &cs); ((f32x2*)rope)[i] = (f32x2){cs, sn}; }
                const float* x = in[I_X];
                for (size_t i = (size_t)F.gtid * 4; i < (size_t)M * D; i += (size_t)F.gthreads * 4) store_bf4(XBF + i, *(const f32x4*)(x + i));
                for (int i = F.gtid * 4; i < NMETA * D; i += F.gthreads * 4) store_bf4(mXB + i, *(const f32x4*)(in[I_META] + i));
            }
        }
        SEAM(pb + 0);

        if (INS(1, pb + 1)) { ENV();
            const float* bg = in[I_BGATE] + (size_t)l * 2 * D;
            { F1 f{mQK, mV, mSIG, mGA, rope, bg, 15, 0};
              meta_gemm(F, 1, N1, D, [=](int, int r) { return mXB + (size_t)r * D; }, [=](int, int c) { return B1t + (size_t)c * D; }, [=](int) { return f; }); }
            pg8::SchedDense S; S.init(M, N1, F.G, F.bid, XBF, D * 2, B1t, D * 2);
            pg8::EpiRow<F1> E{F1{QK, V, SIG, GA, rope, bg, 2047, 16}};
            pg8::gemm_phase<pg8::EpiRow<F1>, pg8::SchedDense>(F.lds, F.tid, S, E, D, D * 2, D * 2);
        }
        SEAM(pb + 1);

        if (INS(2, pb + 2)) { ENV();
            MixArgs ma{QK, V, GA, mQK, mV, mGA, mO, in[I_WA2] + (size_t)l * 16 * 512, in[I_BA] + (size_t)l * 512, in[I_GNG] + (size_t)l * 256,
                       in[I_RNG] + (size_t)l * 1024, in[I_RNB] + (size_t)l * 1024, 0};
#if MIXER_FAST
            if (PROBE_DUP & 2) { ma.dry = 1; mixer_fast(F, ma); ma.dry = 0; }
            mixer_fast(F, ma);
#else
            if (PROBE_DUP & 2) { ma.dry = 1; mixer_phase(F, ma); ma.dry = 0; }
            mixer_phase(F, ma);
#endif
        }
        SEAM(pb + 2);

        if (INS(3, pb + 3)) { ENV();
            { F2 f{mO, mV}; meta_gemm(F, 1, 2048, D, [=](int, int r) { return mXB + (size_t)r * D; }, [=](int, int c) { return B2t + (size_t)c * D; }, [=](int) { return f; }); }
            pg8::SchedDense S; S.init(M, 2048, F.G, F.bid, XBF, D * 2, B2t, D * 2);
            pg8::EpiRow<F2> E{F2{V, V}};
            pg8::gemm_phase<pg8::EpiRow<F2>, pg8::SchedDense>(F.lds, F.tid, S, E, D, D * 2, D * 2);
        }
        SEAM(pb + 3);

        if (INS(4, pb + 4)) { ENV();
#pragma unroll 1
            for (int pass = 0; pass < 2; ++pass) {
                const bf16* Wt = pass ? PBt : PAt;
                { F3 f{mMRG, mSIG, pass}; const bf16* mA = mV + pass * 1024; meta_gemm(F, 1, D, D, [=](int, int r) { return mA + (size_t)r * 2048; }, [=](int, int c) { return Wt + (size_t)c * D; }, [=](int) { return f; }); }
                pg8::SchedDense S; S.init(M, D, F.G, F.bid, V + pass * 1024, 2048 * 2, Wt, D * 2);
                pg8::EpiRow<F3> E{F3{MRG, SIG, pass}};
                pg8::gemm_phase<pg8::EpiRow<F3>, pg8::SchedDense>(F.lds, F.tid, S, E, D, 2048 * 2, D * 2);
            }
        }
        SEAM(pb + 4);

        if (INS(5, pb + 5)) { ENV();
            { F4 f{mhin, mx1}; meta_gemm(F, 1, D, D, [=](int, int r) { return mMRG + (size_t)r * D; }, [=](int, int c) { return Ot + (size_t)c * D; }, [=](int) { return f; }); }
            pg8::SchedDense S; S.init(M, D, F.G, F.bid, MRG, D * 2, Ot, D * 2);
            pg8::EpiEl<F4> E{F4{hin, x1buf}};
            pg8::gemm_phase<pg8::EpiEl<F4>, pg8::SchedDense>(F.lds, F.tid, S, E, D, D * 2, D * 2);
        }
        SEAM(pb + 5);

        if (INS(6, pb + 6)) { ENV();
            const float* g = in[I_LN1G] + (size_t)l * D; const float* bb = in[I_LN1B] + (size_t)l * D;
            const float* wrt = in[I_RT] + (size_t)l2 * D * NEXP;
#pragma unroll 1
            for (int rep = (PROBE_DUP & 4) ? 0 : 1; rep < 2; ++rep)
            for (int r = F.gwave; r < M + NMETA; r += F.gwaves) { const int dry = (rep == 0);
                const bool ism = r >= M; const int rr = ism ? r - M : r;
                float* p = ism ? mx1 + (size_t)rr * D : x1buf + (size_t)rr * D; bf16* pbf = ism ? mXB + (size_t)rr * D : XBF + (size_t)rr * D;
                f32x4 v[4]; row_load(v, p, F.lane); ln_vals(v, g, bb, F.lane); row_store(v, p, pbf, F.lane, dry);
                if (moe) {
                    int e1, e2; float w1, w2; route_row(v, wrt, F.lane, e1, e2, w1, w2);
                    if (F.lane == 0 && !dry) {
                        if (ism) { mTokE[rr * 2] = e1; mTokE[rr * 2 + 1] = e2; mTokW[rr * 2] = w1; mTokW[rr * 2 + 1] = w2; }
                        else {
                            const unsigned r1 = atomicAdd(F.ctl + CW_CNT + 64 * e1, 1u), r2 = atomicAdd(F.ctl + CW_CNT + 64 * e2, 1u);
                            perm[e1 * M + (int)r1] = rr; perm[e2 * M + (int)r2] = rr;
                            tok_slot[rr * 2] = (e1 << 16) | (int)r1; tok_slot[rr * 2 + 1] = (e2 << 16) | (int)r2; tok_w[rr * 2] = w1; tok_w[rr * 2 + 1] = w2;
                        }
                    }
                }
            }
        }
        SEAM(pb + 6);

        if (!moe) {
            if (INS(7, pb + 7)) { ENV();
                { F5 f{mU, DFF}; meta_gemm_pair(F, 1, DFF, D, [=](int, int r) { return mXB + (size_t)r * D; }, [=](int, int c) { return FGU + (size_t)c * D; }, [=](int) { return f; }); }
                pg8::SchedDense S; S.init(M, 2 * DFF, F.G, F.bid, XBF, D * 2, FGU, D * 2);
                pg8::EpiRow<F5> E{F5{U, DFF}};
                pg8::gemm_phase<pg8::EpiRow<F5>, pg8::SchedDense>(F.lds, F.tid, S, E, D, D * 2, D * 2);
            }
            SEAM(pb + 7);
            if (INS(8, pb + 8)) { ENV();
                { F4 f{mx1, mx2}; meta_gemm(F, 1, D, DFF, [=](int, int r) { return mU + (size_t)r * DFF; }, [=](int, int c) { return FDd + (size_t)c * DFF; }, [=](int) { return f; }); }
                pg8::SchedDense S; S.init(M, D, F.G, F.bid, U, DFF * 2, FDd, DFF * 2);
                pg8::EpiEl<F4> E{F4{x1buf, x2buf}};
                pg8::gemm_phase<pg8::EpiEl<F4>, pg8::SchedDense>(F.lds, F.tid, S, E, DFF, DFF * 2, DFF * 2);
            }
            SEAM(pb + 8);
            if (INS(11, pb + 11)) { ENV();
                const float* g = in[I_LN2G] + (size_t)l * D; const float* bb = in[I_LN2B] + (size_t)l * D;
    #pragma unroll 1
            for (int rep = (PROBE_DUP & 4) ? 0 : 1; rep < 2; ++rep)
            for (int r = F.gwave; r < M + NMETA; r += F.gwaves) { const int dry = (rep == 0);
                    const bool ism = r >= M; const int rr = ism ? r - M : r;
                    float* p = ism ? mx2 + (size_t)rr * D : x2buf + (size_t)rr * D; bf16* pbf = ism ? mXB + (size_t)rr * D : XBF + (size_t)rr * D;
                    f32x4 v[4]; row_load(v, p, F.lane); ln_vals(v, g, bb, F.lane); row_store(v, p, pbf, F.lane, dry);
                }
            }
            SEAM(pb + 11);
        } else {
            if (lo <= pb + 11 && hi > pb + 7) { ENV();
                if (F.tid == 0) {
                    unsigned ts = 0, cb = 0;
                    for (int e = 0; e < NEXP; ++e) { const unsigned c = __hip_atomic_load(F.ctl + CW_CNT + 64 * e, __ATOMIC_RELAXED, __HIP_MEMORY_SCOPE_AGENT);
                        F.MISC[16 + e] = c; F.MISC[24 + e] = ts; F.MISC[40 + e] = cb; ts += (c + 255u) >> 8; cb += c; }
                    F.MISC[32] = ts;
                }
                __syncthreads();
            }
#pragma unroll 1
            for (int hf = 0; hf < 2; ++hf) {
                if (INS(9, pb + 7 + 2 * hf)) { ENV();
                    meta_gemm_pair(F, NEXP, HFF, D, [=](int, int r) { return mXB + (size_t)r * D; }, [=](int e, int c) { return FGU + ((size_t)(e * 2 + hf) * DFFE + c) * D; },
                              [=](int e) { return F5{mUall + (size_t)e * NMETA * HFF, HFF}; });
                    SchedMoeUp S{F.MISC, perm, (const char*)XBF, (const char*)FGU, F.G, F.bid, hf};
                    pg8::EpiRow<F5> E{F5{U, HFF}};
                    pg8::gemm_phase<pg8::EpiRow<F5>, SchedMoeUp>(F.lds, F.tid, S, E, D, D * 2, D * 2);
                }
                SEAM(pb + 7 + 2 * hf);
                if (INS(10, pb + 8 + 2 * hf)) { ENV();
                    meta_gemm(F, NEXP, D, HFF, [=](int e, int r) { return mUall + ((size_t)e * NMETA + r) * HFF; }, [=](int e, int c) { return FDm + ((size_t)(e * 2 + hf) * D + c) * HFF; },
                              [=](int e) { return F6Mm{mYall + (size_t)e * NMETA * D, hf}; });
                    SchedMoeDown S{F.MISC, (const char*)U, (const char*)FDm, F.G, F.bid, hf};
                    pg8::EpiRow<F6M> E{F6M{Y, hf}};
                    pg8::gemm_phase<pg8::EpiRow<F6M>, SchedMoeDown>(F.lds, F.tid, S, E, HFF, HFF * 2, HFF * 2);
                }
                SEAM(pb + 8 + 2 * hf);
            }
            if (INS(11, pb + 11)) { ENV();
                const float* g = in[I_LN2G] + (size_t)l * D; const float* bb = in[I_LN2B] + (size_t)l * D;
    #pragma unroll 1
            for (int rep = (PROBE_DUP & 4) ? 0 : 1; rep < 2; ++rep)
            for (int r = F.gwave; r < M + NMETA; r += F.gwaves) { const int dry = (rep == 0);
                    const bool ism = r >= M; const int rr = ism ? r - M : r;
                    float* p = ism ? mx1 + (size_t)rr * D : x1buf + (size_t)rr * D; bf16* pbf = ism ? mXB + (size_t)rr * D : XBF + (size_t)rr * D;
                    f32x4 v[4]; row_load(v, p, F.lane);
                    if (ism) {
                        const float w1 = mTokW[rr * 2], w2 = mTokW[rr * 2 + 1];
                        const int me1 = mTokE[rr * 2], me2 = mTokE[rr * 2 + 1];
#pragma unroll
                        for (int j = 0; j < 4; ++j) { const f32x4 y1 = *(const f32x4*)(mYall + ((size_t)me1 * NMETA + rr) * D + 4 * F.lane + 256 * j), y2 = *(const f32x4*)(mYall + ((size_t)me2 * NMETA + rr) * D + 4 * F.lane + 256 * j);
                            v[j] = v[j] * ALPHA + y1 * w1 + y2 * w2; }
                    } else {
                        const int s1 = tok_slot[rr * 2], s2 = tok_slot[rr * 2 + 1]; const float w1 = tok_w[rr * 2], w2 = tok_w[rr * 2 + 1];
                        const size_t y1r = (size_t)F.MISC[40 + (s1 >> 16)] + (size_t)(s1 & 0xffff), y2r = (size_t)F.MISC[40 + (s2 >> 16)] + (size_t)(s2 & 0xffff);
#pragma unroll
                        for (int j = 0; j < 4; ++j) { const f32x4 y1 = load_bf4(Y + y1r * D + 4 * F.lane + 256 * j), y2 = load_bf4(Y + y2r * D + 4 * F.lane + 256 * j);
                            v[j] = v[j] * ALPHA + y1 * w1 + y2 * w2; }
                    }
                    ln_vals(v, g, bb, F.lane); row_store(v, p, pbf, F.lane, dry);
                }
            }
            SEAM(pb + 11);
        }
    }
#undef IN
#undef SEAM
}

extern "C" void kernel_launch(void* const* d_in, const int* in_sizes, int n_in, void* d_out, int out_size, void* d_ws, size_t ws_size, hipStream_t stream) {
    static int grid = 0;
    if (grid == 0) {
        if (n_in != 23 || in_sizes[0] != M * D || out_size != M * D || ws_size < WS_END) { fprintf(stderr, "kernel_launch: unexpected shapes / workspace (%d inputs, ws %zu)\n", n_in, ws_size); grid = -1; return; }
        int dev = 0, cus = 0, per_cu = 0;
        if (hipGetDevice(&dev) != hipSuccess || hipDeviceGetAttribute(&cus, hipDeviceAttributeMultiprocessorCount, dev) != hipSuccess) { grid = -1; return; }
        if (hipFuncSetAttribute((const void*)fwd_kernel, hipFuncAttributeMaxDynamicSharedMemorySize, LDS_BYTES) != hipSuccess) { fprintf(stderr, "kernel_launch: hipFuncSetAttribute failed\n"); grid = -1; return; }
        if (hipOccupancyMaxActiveBlocksPerMultiprocessor(&per_cu, (const void*)fwd_kernel, NTHR, LDS_BYTES) != hipSuccess || per_cu < 1) fprintf(stderr, "kernel_launch: occupancy query says %d\n", per_cu);
        (void)hipGetLastError();
        grid = cus;
    }
    if (grid < 0) return;
    if (hipMemsetAsync((char*)d_ws + WS_CTL, 0, CTL_ZERO_BYTES, stream) != hipSuccess) return;
    Args a{};
    for (int i = 0; i < 23; ++i) a.in[i] = (const float*)d_in[i];
    a.out = (float*)d_out; a.ws = (unsigned char*)d_ws;
#if defined(PROBE_PHASE)
    a.ph_lo = 0; a.ph_hi = PROBE_PHASE + 1; a.li = 0; hipLaunchKernelGGL(fwd_kernel, dim3(grid), dim3(NTHR), LDS_BYTES, stream, a);
    a.ph_lo = PROBE_PHASE; a.ph_hi = PROBE_PHASE + 1; a.li = 1; hipLaunchKernelGGL(fwd_kernel, dim3(grid), dim3(NTHR), LDS_BYTES, stream, a);
    a.ph_lo = PROBE_PHASE + 1; a.ph_hi = NPHASES; a.li = 2; hipLaunchKernelGGL(fwd_kernel, dim3(grid), dim3(NTHR), LDS_BYTES, stream, a);
#elif N_LAUNCH_MODE == 1
    a.ph_lo = 0; a.ph_hi = NPHASES; a.li = 0;
    hipLaunchKernelGGL(fwd_kernel, dim3(grid), dim3(NTHR), LDS_BYTES, stream, a);
#else
    for (int p = 0; p < NPHASES; ++p) {
        const int l = p / NPH, s = p % NPH;
        if ((l & 1) == 0 && (s == 9 || s == 10)) continue;
        a.ph_lo = p; a.ph_hi = p + 1;
        hipLaunchKernelGGL(fwd_kernel, dim3(grid), dim3(NTHR), LDS_BYTES, stream, a);
    }
#endif
}
```

```cpp
#include <hip/hip_runtime.h>
#include <cstdio>
#include <cstdint>

#ifndef N_LAUNCH_MODE
#define N_LAUNCH_MODE 1
#endif

#ifndef MIXER_FAST
#define MIXER_FAST 1
#endif
#ifndef PROBE_DUP
#define PROBE_DUP 0
#endif
#define LAS __attribute__((address_space(3)))
typedef unsigned short bf16;
typedef short bf16x8 __attribute__((ext_vector_type(8)));
typedef float f32x4 __attribute__((ext_vector_type(4)));
typedef float f32x2 __attribute__((ext_vector_type(2)));
typedef unsigned u32x4 __attribute__((ext_vector_type(4)));
typedef unsigned u32x2 __attribute__((ext_vector_type(2)));

constexpr int D = 1024, NB = 32, SEQ = 2048, DEPTH = 4, NMETA = 16;
constexpr int M = NB * SEQ;
constexpr int NIN = 8208;
constexpr int N1 = 6400;
constexpr int DFF = 2816, DFFE = 3584, NEXP = 8, HFF = 1792;
constexpr float ALPHA = 1.681792830507429f;
constexpr float QSCALE = 0.08838834764831845f;
constexpr float LN_EPS = 1e-5f, GN_EPS = 1e-6f;
constexpr int NPH = 12;
constexpr int NPHASES = DEPTH * NPH;

constexpr size_t MiB = 1u << 20;
constexpr size_t WS_CTL = 0, CTL_ZERO_BYTES = 1 * MiB;
constexpr size_t WS_ROPE = 1 * MiB;
constexpr size_t WS_META = 3 * MiB;
constexpr size_t WS_MOE = 4 * MiB;
constexpr size_t WS_GA = 8 * MiB;
constexpr size_t WS_W = 12 * MiB;
constexpr size_t WS_HB = 204 * MiB;
constexpr size_t WS_Y3 = 332 * MiB;
constexpr size_t WS_HA = 460 * MiB;
constexpr size_t WS_QK = 588 * MiB;
constexpr size_t WS_V = 844 * MiB;
constexpr size_t WS_META2 = 1100 * MiB;
constexpr size_t WS_END = 1102 * MiB;
constexpr size_t W_B1 = 0;
constexpr size_t W_B2 = W_B1 + (size_t)N1 * D * 2;
constexpr size_t W_PA = W_B2 + (size_t)2048 * D * 2;
constexpr size_t W_PB = W_PA + (size_t)D * D * 2;
constexpr size_t W_O = W_PB + (size_t)D * D * 2;
constexpr size_t W_F = W_O + (size_t)D * D * 2;
constexpr size_t W_FD_DENSE = W_F + (size_t)2 * DFF * D * 2;
constexpr size_t W_FD_MOE = W_F + (size_t)NEXP * 2 * DFFE * D * 2;
static_assert(W_FD_MOE + (size_t)NEXP * 2 * D * HFF * 2 <= 192 * MiB, "weights fit");
constexpr size_t MT_HA = 0, MT_HB = 65536, MT_XB = 131072, MT_QK = 163840, MT_V = 229376, MT_SIG = 294912, MT_GA = 360448, MT_MRG = 364544,
                 MT_U = 397312  , MT_Y = 512000  , MT_TOK = 643072  , MT_O = 644096  ;
static_assert(MT_O + 65536 <= MiB, "meta map");
constexpr int CW_CNT = 1024;
constexpr int CW_BAR = 4096;

constexpr int RING_BYTES = 131072;
constexpr int LDS_BYTES = 147456;
constexpr int MISC_OFF = LDS_BYTES - 1024;
constexpr int NWAVES = 8, NTHR = 512;

__device__ __forceinline__ unsigned f2bf(float f) { unsigned u = __builtin_bit_cast(unsigned, f); return (u + 0x7fffu + ((u >> 16) & 1u)) >> 16; }
__device__ __forceinline__ float bf2f(unsigned h) { return __builtin_bit_cast(float, (h & 0xffffu) << 16); }
typedef __bf16 bf16x2_t __attribute__((ext_vector_type(2)));
__device__ __forceinline__ unsigned pk2(float lo, float hi) { const f32x2 v = {lo, hi}; return __builtin_bit_cast(unsigned, __builtin_convertvector(v, bf16x2_t)); }
__device__ __forceinline__ unsigned pk2_sw(float lo, float hi) { return pk2(lo, hi); }
__device__ __forceinline__ void store_bf4(bf16* p, f32x4 v) { u32x2 w; w.x = pk2(v[0], v[1]); w.y = pk2(v[2], v[3]); *(u32x2*)p = w; }
__device__ __forceinline__ f32x4 load_bf4(const bf16* p) { const u32x2 w = *(const u32x2*)p; return (f32x4){bf2f(w.x), bf2f(w.x >> 16), bf2f(w.y), bf2f(w.y >> 16)}; }
__device__ __forceinline__ void store_bf8(bf16* p, f32x4 lo, f32x4 hi) { u32x4 w; w.x = pk2(lo[0], lo[1]); w.y = pk2(lo[2], lo[3]); w.z = pk2(hi[0], hi[1]); w.w = pk2(hi[2], hi[3]); *(u32x4*)p = w; }
__device__ __forceinline__ void load_bf8(const bf16* p, f32x4& lo, f32x4& hi) { const u32x4 w = *(const u32x4*)p; lo = (f32x4){bf2f(w.x), bf2f(w.x >> 16), bf2f(w.y), bf2f(w.y >> 16)}; hi = (f32x4){bf2f(w.z), bf2f(w.z >> 16), bf2f(w.w), bf2f(w.w >> 16)}; }
__device__ __forceinline__ float sigmoidf_(float x) { return __builtin_amdgcn_rcpf(1.0f + __expf(-x)); }
__device__ __forceinline__ float siluf_(float x) { return x * __builtin_amdgcn_rcpf(1.0f + __expf(-x)); }
template <int CTRL> __device__ __forceinline__ float dpp_f(float v) { return __builtin_bit_cast(float, __builtin_amdgcn_update_dpp(0, __builtin_bit_cast(int, v), CTRL, 0xF, 0xF, true)); }
__device__ __forceinline__ float wave_sum(float v) {
    v += dpp_f<0xB1>(v);
    v += dpp_f<0x4E>(v);
    v += dpp_f<0x141>(v);
    v += dpp_f<0x140>(v);
    const int iv = __builtin_bit_cast(int, v);
    const float r0 = __builtin_bit_cast(float, __builtin_amdgcn_readlane(iv, 0)), r1 = __builtin_bit_cast(float, __builtin_amdgcn_readlane(iv, 16)),
                r2 = __builtin_bit_cast(float, __builtin_amdgcn_readlane(iv, 32)), r3 = __builtin_bit_cast(float, __builtin_amdgcn_readlane(iv, 48));
    return (r0 + r1) + (r2 + r3);
}
#define LDS_WAIT() asm volatile("s_waitcnt lgkmcnt(0)" ::: "memory")
#define VM_WAIT() asm volatile("s_waitcnt vmcnt(0)" ::: "memory")

namespace pg8 {
constexpr int BM = 256, BK = 64, HALF = 128, HTB = HALF * BK * 2, STAGE_BYTES = 8 * HTB, NXCD = 8, WGM = 8, IDX_OFF = STAGE_BYTES  ;
__host__ __device__ __forceinline__ int lds_byte(int r, int c) { const int st = (r >> 4) * 2 + (c >> 5), rr = r & 15, cc = c & 31, ob = rr * 64 + cc * 2; return st * 1024 + (ob ^ (((ob >> 9) & 1) << 5)); }
__host__ __device__ __forceinline__ void stage_rc(int b, int& R, int& C) { const int st = b / 1024, sb = b % 1024, swz = sb ^ (((sb >> 9) & 1) << 5); R = (st >> 1) * 16 + swz / 64; C = (st & 1) * 32 + (swz % 64) / 2; }

__host__ __device__ __forceinline__ int perm32(int rho) { const int n = rho >> 4, i = rho & 15; return 8 * (i >> 2) + 4 * n + (i & 3); }
struct Unit { const char* A; const char* B; int row0, col0, e, nvalid; };

struct SchedDense {
    static constexpr bool GATHER = false;
    int nM, nN, nwg, G, c; const char* A; const char* Bt; unsigned lda, ldb;
    __device__ void init(int Mr, int Nc, int G_, int c_, const void* A_, unsigned lda_, const void* Bt_, unsigned ldb_) { nM = Mr / BM; nN = Nc / BM; nwg = nM * nN; G = G_; c = c_; A = (const char*)A_; Bt = (const char*)Bt_; lda = lda_; ldb = ldb_; }
    __device__ bool next(int i, Unit& u) const {
        const long L = (long)i * G + c; if (L >= nwg) return false;
        int wgid = (int)L; { const int q = nwg / NXCD, r = nwg % NXCD, xcd = wgid % NXCD, off = wgid / NXCD; wgid = (xcd < r ? xcd * (q + 1) : r * (q + 1) + (xcd - r) * q) + off; }
        const int nig = WGM * nN, gid = wgid / nig, fm = gid * WGM, gsz = (nM - fm) < WGM ? (nM - fm) : WGM;
        const int pm = fm + ((wgid % nig) % gsz), pn = (wgid % nig) / gsz;
        u.A = A + (size_t)pm * BM * lda; u.B = Bt + (size_t)pn * BM * ldb; u.row0 = pm * BM; u.col0 = pn * BM; u.e = 0; u.nvalid = BM; return true;
    }
    __device__ __forceinline__ unsigned a_off(const Unit&, int R, int h) const { return (unsigned)(h * HALF + R) * lda; }
};

template <class F> struct EpiEl {
    static constexpr bool PERM = false;
    F f;
    template <int MODE> __device__ __forceinline__ void loop(const f32x4 (&acc)[2][2][4][2], const Unit& u, int wr, int wc, int fr, int fq) const {
#pragma unroll
        for (int ai = 0; ai < 2; ++ai)
#pragma unroll
            for (int m = 0; m < 4; ++m) { const int r = ai * HALF + wr * 64 + m * 16 + fr;
#pragma unroll
                for (int bj = 0; bj < 2; ++bj)
#pragma unroll
                    for (int n = 0; n < 2; ++n) f.template at<MODE>(u, r, bj * HALF + wc * 32 + n * 16 + 4 * fq, acc[ai][bj][m][n]);
                if (m == 3) asm volatile("" ::: "memory"); }
    }
    __device__ __forceinline__ void operator()(const f32x4 (&acc)[2][2][4][2], const Unit& u, int wr, int wc, int fr, int fq) const {
        if constexpr (F::NMODES == 1) loop<0>(acc, u, wr, wc, fr, fq);
        else {
            const int mode = __builtin_amdgcn_readfirstlane(f.mode(u));
            if (mode == 0) loop<0>(acc, u, wr, wc, fr, fq);
            else if (mode == 1) loop<1>(acc, u, wr, wc, fr, fq);
            else if (mode == 2) loop<2>(acc, u, wr, wc, fr, fq);
            else if (mode == 3) loop<3>(acc, u, wr, wc, fr, fq);
            else loop<4>(acc, u, wr, wc, fr, fq);
        }
    }
};

template <class F> struct EpiRow {
    static constexpr bool PERM = true;
    F f;
    template <int MODE> __device__ __forceinline__ void loop(const f32x4 (&acc)[2][2][4][2], const Unit& u, int wr, int wc, int fr, int fq) const {
#pragma unroll
        for (int ai = 0; ai < 2; ++ai)
#pragma unroll
            for (int m = 0; m < 4; ++m) { f.template row<MODE>(u, ai * HALF + wr * 64 + m * 16 + fr, wc * 32 + 8 * fq, acc[ai][0][m][0], acc[ai][0][m][1], acc[ai][1][m][0], acc[ai][1][m][1]);
                if (m == 3) asm volatile("" ::: "memory"); }
    }
    __device__ __forceinline__ void operator()(const f32x4 (&acc)[2][2][4][2], const Unit& u, int wr, int wc, int fr, int fq) const {
        if constexpr (F::NMODES == 1) loop<0>(acc, u, wr, wc, fr, fq);
        else {
            const int mode = __builtin_amdgcn_readfirstlane(f.mode(u));
            if (mode == 0) loop<0>(acc, u, wr, wc, fr, fq);
            else if (mode == 1) loop<1>(acc, u, wr, wc, fr, fq);
            else if (mode == 2) loop<2>(acc, u, wr, wc, fr, fq);
            else if (mode == 3) loop<3>(acc, u, wr, wc, fr, fq);
            else loop<4>(acc, u, wr, wc, fr, fq);
        }
    }
};

template <class Epi, class Sched, bool ALIGN_EPI = true>
__device__ __forceinline__ void gemm_phase(LAS unsigned char* lds, const int tid, const Sched& S, const Epi& E, const int K, const unsigned lda, const unsigned ldb) {
    const int wid = __builtin_amdgcn_readfirstlane(tid >> 6), lane = tid & 63, wr = wid >> 2, wc = wid & 3, fr = lane & 15, fq = lane >> 4;
    const int nt = K / BK;
    int Rr[2], Cc[2]; unsigned voffA[2], voffB[2];
#pragma unroll
    for (int i = 0; i < 2; ++i) { int R, C; stage_rc(tid * 16 + i * 8192, R, C); Rr[i] = R; Cc[i] = C; const int Rb = Epi::PERM ? ((R & ~31) + perm32(R & 31)) : R; voffA[i] = (unsigned)R * lda + (unsigned)C * 2u; voffB[i] = (unsigned)Rb * ldb + (unsigned)C * 2u; }
    const size_t kstep = (size_t)(BK * 2);
    const size_t hstepA = (size_t)HALF * lda, hstepB = (size_t)HALF * ldb;
    const unsigned ldsw = (unsigned)wid * 1024u;
    const int aoff = lds_byte(wr * 64 + fr, fq * 8), boff = lds_byte(wc * 32 + fr, fq * 8);
#define PG8_SA(b, h) (((b) * 2 + (h)) * HTB)
#define PG8_SB(b, h) ((4 + (b) * 2 + (h)) * HTB)
#define PG8_STAGE_B(bufoff, gbase) do { _Pragma("unroll") for (int _i = 0; _i < 2; ++_i) \
        __builtin_amdgcn_global_load_lds((const unsigned*)((const char*)(gbase) + voffB[_i]), (LAS unsigned*)(lds + (bufoff) + ldsw + _i * 8192), 16, 0, 0); } while (0)
#define PG8_STAGE_A(bufoff, gbase, h, ox) do { _Pragma("unroll") for (int _i = 0; _i < 2; ++_i) { \
        const char* _p = Sched::GATHER ? ((const char*)(gbase) + (ox)[h][_i]) : ((const char*)(gbase) + (h) * hstepA + voffA[_i]); \
        __builtin_amdgcn_global_load_lds((const unsigned*)_p, (LAS unsigned*)(lds + (bufoff) + ldsw + _i * 8192), 16, 0, 0); } } while (0)
#define PG8_LDA(dst, b, h) do { _Pragma("unroll") for (int m = 0; m < 4; ++m) _Pragma("unroll") for (int k = 0; k < 2; ++k) dst[m][k] = *(const LAS bf16x8*)(lds + PG8_SA(b, h) + aoff + m * 2048 + k * 1024); } while (0)
#define PG8_LDB(dst, b, h) do { _Pragma("unroll") for (int n = 0; n < 2; ++n) _Pragma("unroll") for (int k = 0; k < 2; ++k) dst[n][k] = *(const LAS bf16x8*)(lds + PG8_SB(b, h) + boff + n * 2048 + k * 1024); } while (0)
#define PG8_MMA(ai, bj, At, Bt) do { __builtin_amdgcn_s_setprio(1); _Pragma("unroll") for (int m = 0; m < 4; ++m) _Pragma("unroll") for (int n = 0; n < 2; ++n) _Pragma("unroll") for (int k = 0; k < 2; ++k) \
        acc[ai][bj][m][n] = __builtin_amdgcn_mfma_f32_16x16x32_bf16(Bt[n][k], At[m][k], acc[ai][bj][m][n], 0, 0, 0); __builtin_amdgcn_s_setprio(0); } while (0)
#define PG8_WAIT_V(n) asm volatile("s_waitcnt vmcnt(" #n ")" ::: "memory")
#define PG8_WAIT_L(n) asm volatile("s_waitcnt lgkmcnt(" #n ")" ::: "memory")
#define PG8_BAR __builtin_amdgcn_s_barrier()
#define PG8_SCHED __builtin_amdgcn_sched_barrier(0)
    Unit cur, nxt; int ui = 0;
    if (!S.next(0, cur)) return;
    f32x4 acc[2][2][4][2];
#pragma unroll
    for (int a = 0; a < 2; ++a)
#pragma unroll
        for (int b = 0; b < 2; ++b)
#pragma unroll
            for (int m = 0; m < 4; ++m)
#pragma unroll
                for (int n = 0; n < 2; ++n) acc[a][b][m][n] = (f32x4){0.f, 0.f, 0.f, 0.f};
    bf16x8 At[4][2], B0[2][2], B1[2][2];
    unsigned oc[2][2];
#pragma unroll
    for (int h = 0; h < 2; ++h)
#pragma unroll
        for (int i = 0; i < 2; ++i) oc[h][i] = Sched::GATHER ? (S.a_off(cur, Rr[i], h) + (unsigned)Cc[i] * 2u) : 0u;
    const char* cA = cur.A; const char* cB = cur.B;
    PG8_STAGE_B(PG8_SB(0, 0), cB); PG8_STAGE_B(PG8_SB(0, 1), cB + hstepB); PG8_STAGE_A(PG8_SA(0, 0), cA, 0, oc); PG8_STAGE_A(PG8_SA(0, 1), cA, 1, oc);
    if (wr == 1) PG8_BAR;
    PG8_WAIT_V(2); PG8_BAR;
    PG8_STAGE_B(PG8_SB(1, 0), cB + kstep); PG8_STAGE_A(PG8_SA(1, 0), cA + kstep, 0, oc); PG8_STAGE_B(PG8_SB(1, 1), cB + hstepB + kstep);
    PG8_WAIT_V(6); PG8_BAR;
    for (;;) {
        const bool has_next = S.next(ui + 1, nxt);
        const char* nA = has_next ? nxt.A : cA; const char* nB = has_next ? nxt.B : cB;
        if constexpr (Sched::GATHER) {
            if (has_next && wid == 0)
                __builtin_amdgcn_global_load_lds((const unsigned*)(S.idx_base(nxt) + lane * 4), (LAS unsigned*)(lds + IDX_OFF), 16, 0, 0);
        }
        for (int t = 0; t < nt; t += 2) {
            const bool last = (t == nt - 2);
            const char* a1 = cA + (size_t)(t + 1) * kstep;
            const char* a2 = last ? nA : cA + (size_t)(t + 2) * kstep; const char* b2 = last ? nB : cB + (size_t)(t + 2) * kstep;
            const char* a3 = a2 + kstep; const char* b3 = b2 + kstep;
            PG8_LDB(B0, 0, 0); PG8_LDB(B1, 0, 1); PG8_SCHED; PG8_LDA(At, 0, 0); PG8_STAGE_A(PG8_SA(1, 1), a1, 1, oc);
            if constexpr (Sched::GATHER) { if (last && has_next) {
#pragma unroll
                for (int h = 0; h < 2; ++h)
#pragma unroll
                    for (int i = 0; i < 2; ++i) { const int rt = h * HALF + Rr[i]; const unsigned tok = *(const LAS unsigned*)(lds + IDX_OFF + (S.row_ok(nxt, rt) ? rt : 0) * 4);
                        oc[h][i] = tok * lda + (unsigned)Cc[i] * 2u; } } }
            PG8_WAIT_V(8); PG8_WAIT_L(0); PG8_BAR; PG8_MMA(0, 0, At, B0); PG8_MMA(0, 1, At, B1); PG8_BAR; PG8_SCHED;
            PG8_LDA(At, 0, 1); PG8_STAGE_B(PG8_SB(0, 0), b2); PG8_STAGE_B(PG8_SB(0, 1), b2 + hstepB); PG8_STAGE_A(PG8_SA(0, 0), a2, 0, oc);
            PG8_WAIT_V(8); PG8_WAIT_L(0); PG8_BAR; PG8_MMA(1, 0, At, B0); PG8_MMA(1, 1, At, B1); PG8_BAR; PG8_SCHED;
            PG8_LDB(B0, 1, 0); PG8_LDB(B1, 1, 1); PG8_SCHED; PG8_LDA(At, 1, 0); PG8_STAGE_A(PG8_SA(0, 1), a2, 1, oc);
            PG8_WAIT_V(8); PG8_WAIT_L(0); PG8_BAR; PG8_MMA(0, 0, At, B0); PG8_MMA(0, 1, At, B1); PG8_BAR; PG8_SCHED;
            PG8_LDA(At, 1, 1); PG8_STAGE_B(PG8_SB(1, 0), b3); PG8_STAGE_B(PG8_SB(1, 1), b3 + hstepB); PG8_STAGE_A(PG8_SA(1, 0), a3, 0, oc);
            PG8_WAIT_V(8); PG8_WAIT_L(0); PG8_BAR; PG8_MMA(1, 0, At, B0); PG8_MMA(1, 1, At, B1); PG8_BAR; PG8_SCHED;
        }
        if constexpr (ALIGN_EPI) { if (wr == 0) PG8_BAR; }
        E(acc, cur, wr, wc, fr, fq);
        if (!has_next) break;
#pragma unroll
        for (int a = 0; a < 2; ++a)
#pragma unroll
            for (int b = 0; b < 2; ++b)
#pragma unroll
                for (int m = 0; m < 4; ++m)
#pragma unroll
                    for (int n = 0; n < 2; ++n) acc[a][b][m][n] = (f32x4){0.f, 0.f, 0.f, 0.f};
        cur = nxt; cA = nA; cB = nB; ++ui;
        if constexpr (ALIGN_EPI) { if (wr == 1) PG8_BAR; }
    }
    PG8_WAIT_V(0);
    if constexpr (!ALIGN_EPI) { if (wr == 0) PG8_BAR; }
    PG8_BAR;
#undef PG8_SA
#undef PG8_SB
#undef PG8_STAGE_A
#undef PG8_STAGE_B
#undef PG8_LDA
#undef PG8_LDB
#undef PG8_MMA
#undef PG8_WAIT_V
#undef PG8_WAIT_L
#undef PG8_BAR
#undef PG8_SCHED
}
}

#define XB_TMO      128
#define XB_XCNT(j)  (256  + 64 * (j))
#define XB_XSUB(j)  (1280 + 64 * (j))
#define XB_XGEN(j)  (2304 + 64 * (j))
#define XB_TOP      3328
#define XB_TOPGEN   3392
#define XCD_BAR_WORDS 3456
#define XB_SPIN_CAP (1u << 18)
__device__ __forceinline__ unsigned xb_ld(unsigned* p)              { return __hip_atomic_load(p, __ATOMIC_RELAXED, __HIP_MEMORY_SCOPE_AGENT); }
__device__ __forceinline__ unsigned xb_add(unsigned* p, unsigned v) { return __hip_atomic_fetch_add(p, v, __ATOMIC_RELAXED, __HIP_MEMORY_SCOPE_AGENT); }
__device__ __forceinline__ unsigned xb_xcc_id() { return (unsigned)__builtin_amdgcn_s_getreg((3 << 11) | 20) & 0xFu; }
#define XB_SPIN(cond, bar) do { unsigned _sp = 0; while (cond) { __builtin_amdgcn_s_sleep(1); \
    if ((++_sp & 255u) == 0u) { if (xb_ld(&(bar)[XB_TMO])) break; if (_sp > XB_SPIN_CAP) { atomicAdd(&(bar)[XB_TMO], 1u); break; } } } } while (0)
struct XcdBarrier { unsigned* bar; unsigned x; volatile LAS unsigned* st; };
__device__ __forceinline__ XcdBarrier xcd_barrier_post(unsigned* bar, volatile LAS unsigned* st) {
    XcdBarrier b; b.bar = bar; b.x = xb_xcc_id(); b.st = st;
    if (threadIdx.x == 0) (void)xb_add(&bar[XB_XCNT(b.x)], 1u);
    return b;
}
__device__ __forceinline__ void xcd_barrier_complete(unsigned* bar, unsigned x, unsigned& nloc, unsigned& nx) {
    const unsigned G = gridDim.x * gridDim.y * gridDim.z;
    unsigned sum, cnt, mine, sp = 0u;
    for (;;) {
        sum = 0u; cnt = 0u; mine = 0u;
#pragma unroll
        for (unsigned j = 0; j < 16; ++j) { const unsigned c = xb_ld(&bar[XB_XCNT(j)]); sum += c; cnt += (c > 0u) ? 1u : 0u; mine = (j == x) ? c : mine; }
        if (sum == G) break;
        __builtin_amdgcn_s_sleep(1);
        if ((++sp & 255u) == 0u) { if (xb_ld(&bar[XB_TMO])) break; if (sp > XB_SPIN_CAP) { atomicAdd(&bar[XB_TMO], 1u); break; } }
    }
    nloc = mine > 0u ? mine : 1u; nx = cnt > 0u ? cnt : 1u;
}
__device__ __forceinline__ void xcd_barrier(const XcdBarrier& b) {
    asm volatile("s_waitcnt vmcnt(0)" ::: "memory");
    __syncthreads();
    if (threadIdx.x == 0) {
        unsigned* bar = b.bar;
        __builtin_amdgcn_s_waitcnt(0);
        unsigned nloc = b.st[0], nx = b.st[1];
        if (nloc == 0u) { xcd_barrier_complete(bar, b.x, nloc, nx); b.st[0] = nloc; b.st[1] = nx; }
        const unsigned old = xb_add(&bar[XB_XSUB(b.x)], 1u);
        const unsigned gen = old / nloc;
        if (old + 1u == (gen + 1u) * nloc) {
            __builtin_amdgcn_fence(__ATOMIC_RELEASE, "agent");
            asm volatile("s_waitcnt vmcnt(0)" ::: "memory");
            const unsigned og = xb_add(&bar[XB_TOP], 1u);
            const unsigned tg = og / nx;
            if (og + 1u == (tg + 1u) * nx) xb_add(&bar[XB_TOPGEN], 1u);
            else XB_SPIN(xb_ld(&bar[XB_TOPGEN]) == tg, bar);
            __builtin_amdgcn_fence(__ATOMIC_ACQUIRE, "agent");
            xb_add(&bar[XB_XGEN(b.x)], 1u);
            asm volatile("s_waitcnt vmcnt(0)" ::: "memory");
        } else {
            XB_SPIN(xb_ld(&bar[XB_XGEN(b.x)]) == gen, bar);
            __builtin_amdgcn_fence(__ATOMIC_ACQUIRE, "agent");
            asm volatile("s_waitcnt vmcnt(0)" ::: "memory");
        }
    }
    __syncthreads();
}

struct Args { const float* in[23]; float* out; unsigned char* ws; int ph_lo, ph_hi, li, pad; };
enum { I_X = 0, I_META, I_WIN, I_BGATE, I_WA2, I_BA, I_GNG, I_RNG, I_RNB, I_WPA, I_WPB, I_WO, I_LN1G, I_LN1B, I_FG, I_FU, I_FD, I_RT, I_MG, I_MU, I_MD, I_LN2G, I_LN2B };

struct Frame {
    LAS unsigned char* lds; volatile LAS unsigned* MISC; unsigned* ctl;
    int tid, lane, wave, G, bid, gtid, gthreads, gwave, gwaves;
    unsigned char* ws;
};

template <class AR, class BR, class F>
__device__ __forceinline__ void naive_gemm(const Frame& Fr, int nrows, int ncols, int K, AR arow, BR brow, F f) {
    const int nc4 = ncols >> 2;
#pragma unroll 1
    for (int rep = (PROBE_DUP & 1) ? 0 : 1; rep < 2; ++rep)
    for (int idx = Fr.gtid; idx < nrows * nc4; idx += Fr.gthreads) {
        const int row = idx / nc4, c0 = (idx % nc4) * 4;
        const bf16* a = arow(row);
        f32x4 acc = (f32x4){0.f, 0.f, 0.f, 0.f};
#pragma unroll
        for (int j = 0; j < 4; ++j) {
            const bf16* b = brow(row, c0 + j);
            float s = 0.f;
            for (int k = 0; k < K; k += 8) {
                const u32x4 av = *(const u32x4*)(a + k), bv = *(const u32x4*)(b + k);
                s += bf2f(av.x) * bf2f(bv.x) + bf2f(av.x >> 16) * bf2f(bv.x >> 16) + bf2f(av.y) * bf2f(bv.y) + bf2f(av.y >> 16) * bf2f(bv.y >> 16)
                   + bf2f(av.z) * bf2f(bv.z) + bf2f(av.z >> 16) * bf2f(bv.z >> 16) + bf2f(av.w) * bf2f(bv.w) + bf2f(av.w >> 16) * bf2f(bv.w >> 16);
            }
            acc[j] = s;
        }
        if (rep == 0) { if (acc[0] + acc[1] + acc[2] + acc[3] == 1.2345678e30f) *(f32x4*)(Fr.ws + WS_META + MT_Y) = acc; continue; }
        pg8::Unit u; u.A = nullptr; u.B = nullptr; u.row0 = 0; u.col0 = c0 & ~255; u.e = 0; u.nvalid = nrows;
        const int cc = c0 & 255;
        if constexpr (F::NMODES == 1) f.template at<0>(u, row, cc, acc);
        else { const int mode = f.mode(u);
            if (mode == 0) f.template at<0>(u, row, cc, acc); else if (mode == 1) f.template at<1>(u, row, cc, acc); else if (mode == 2) f.template at<2>(u, row, cc, acc);
            else if (mode == 3) f.template at<3>(u, row, cc, acc); else f.template at<4>(u, row, cc, acc); }
    }
}

template <class AR, class BC, class FM>
__device__ __forceinline__ void meta_gemm(const Frame& Fr, int nouter, int ncols, int K, AR arow, BC bcol, FM fmk) {
    const int ntile = ncols >> 4, ntask = nouter * ntile, kw = K >> 3;
    const int lane = Fr.lane, l16 = lane & 15, quad = lane >> 4;
    LAS f32x4* part = (LAS f32x4*)Fr.lds;
#pragma unroll 1
    for (int rep = (PROBE_DUP & 1) ? 0 : 1; rep < 2; ++rep)
#pragma unroll 1
    for (int task = Fr.bid; task < ntask; task += Fr.G) {
        const int o = task / ntile, c0 = (task - o * ntile) * 16;
        const bf16* ap = arow(o, l16) + Fr.wave * kw + 8 * quad; const bf16* bp = bcol(o, c0 + l16) + Fr.wave * kw + 8 * quad;
        f32x4 acc = (f32x4){0.f, 0.f, 0.f, 0.f};
        for (int k = 0; k < kw; k += 32) { const bf16x8 av = *(const bf16x8*)(ap + k), bv = *(const bf16x8*)(bp + k); acc = __builtin_amdgcn_mfma_f32_16x16x32_bf16(bv, av, acc, 0, 0, 0); }
        part[Fr.wave * 64 + lane] = acc;
        __syncthreads();
        if (Fr.wave == 0) {
            f32x4 t = part[lane];
#pragma unroll
            for (int w = 1; w < 8; ++w) t = t + part[w * 64 + lane];
            if (rep == 1) {
                auto f = fmk(o);
                pg8::Unit u; u.A = nullptr; u.B = nullptr; u.row0 = 0; u.col0 = c0 & ~255; u.e = 0; u.nvalid = 16;
                const int cc = (c0 & 255) + 4 * quad;
                if constexpr (decltype(f)::NMODES == 1) f.template at<0>(u, l16, cc, t);
                else { const int mode = f.mode(u);
                    if (mode == 0) f.template at<0>(u, l16, cc, t); else if (mode == 1) f.template at<1>(u, l16, cc, t); else if (mode == 2) f.template at<2>(u, l16, cc, t);
                    else if (mode == 3) f.template at<3>(u, l16, cc, t); else f.template at<4>(u, l16, cc, t); }
            }
        }
        __syncthreads();
    }
}

template <class AR, class BC, class FM>
__device__ __forceinline__ void meta_gemm_pair(const Frame& Fr, int nouter, int nff, int K, AR arow, BC bcol, FM fmk) {
    const int ntile = nff >> 4, ntask = nouter * ntile, kw = K >> 3;
    const int lane = Fr.lane, l16 = lane & 15, quad = lane >> 4;
    LAS f32x4* part = (LAS f32x4*)Fr.lds;
#pragma unroll 1
    for (int rep = (PROBE_DUP & 1) ? 0 : 1; rep < 2; ++rep)
#pragma unroll 1
    for (int task = Fr.bid; task < ntask; task += Fr.G) {
        const int o = task / ntile, f0 = (task - o * ntile) * 16, wrow = 256 * (f0 >> 7) + (f0 & 127);
        const bf16* ap = arow(o, l16) + Fr.wave * kw + 8 * quad; const bf16* bp = bcol(o, wrow + l16) + Fr.wave * kw + 8 * quad; const bf16* bp2 = bp + (size_t)128 * K;
        f32x4 ag = (f32x4){0.f, 0.f, 0.f, 0.f}, au = ag;
        for (int k = 0; k < kw; k += 32) { const bf16x8 av = *(const bf16x8*)(ap + k), bg = *(const bf16x8*)(bp + k), bu = *(const bf16x8*)(bp2 + k);
            ag = __builtin_amdgcn_mfma_f32_16x16x32_bf16(bg, av, ag, 0, 0, 0); au = __builtin_amdgcn_mfma_f32_16x16x32_bf16(bu, av, au, 0, 0, 0); }
        part[Fr.wave * 64 + lane] = ag; part[512 + Fr.wave * 64 + lane] = au;
        __syncthreads();
        if (Fr.wave == 0) {
            f32x4 tg = part[lane], tu = part[512 + lane];
#pragma unroll
            for (int w = 1; w < 8; ++w) { tg = tg + part[w * 64 + lane]; tu = tu + part[512 + w * 64 + lane]; }
            if (rep == 1) { auto f = fmk(o); f.pair(l16, f0 + 4 * quad, tg, tu); }
        }
        __syncthreads();
    }
}

struct F1 {
    static constexpr int NMODES = 5;
    bf16* QK; bf16* V; bf16* SIG; float* GA; const f32x2* rope; const float* bg; int posmask, posbase;
    __device__ __forceinline__ int mode(const pg8::Unit& u) const { const int c = u.col0; return c < 1024 ? 0 : (c < 2048 ? 1 : (c < 4096 ? 2 : (c < 6144 ? 3 : 4))); }
    template <int MODE> __device__ __forceinline__ void at(const pg8::Unit& u, int r, int c, f32x4 v) const {
        const int row = u.row0 + r, col = u.col0 + c;
        if (MODE == 0) { const float s = col < 512 ? QSCALE : 1.f; store_bf4(QK + (size_t)row * 2048 + col, v * s); }
        else if (MODE == 1) {
            const int j = (col - 1024) & 127, pos = (row & posmask) + posbase; const f32x2 c0 = rope[pos * 64 + (j >> 1)], c1 = rope[pos * 64 + (j >> 1) + 1];
            const float s = col >= 1536 ? QSCALE : 1.f;
            f32x4 o; o[0] = (v[0] * c0.x - v[1] * c0.y) * s; o[1] = (v[0] * c0.y + v[1] * c0.x) * s; o[2] = (v[2] * c1.x - v[3] * c1.y) * s; o[3] = (v[2] * c1.y + v[3] * c1.x) * s;
            store_bf4(QK + (size_t)row * 2048 + col, o);
        }
        else if (MODE == 2) store_bf4(V + (size_t)row * 2048 + (col - 2048), v);
        else if (MODE == 3) { const int cc = col - 4096; const f32x4 b = *(const f32x4*)(bg + cc);
            f32x4 o; o[0] = sigmoidf_(v[0] + b[0]); o[1] = sigmoidf_(v[1] + b[1]); o[2] = sigmoidf_(v[2] + b[2]); o[3] = sigmoidf_(v[3] + b[3]);
            store_bf4(SIG + (size_t)row * 2048 + cc, o); }
        else { if (col < 6160) *(f32x4*)(GA + (size_t)row * 16 + (col - 6144)) = v; }
    }
    template <int MODE> __device__ __forceinline__ void half8(int row, int col, f32x4 lo, f32x4 hi) const {
        if (MODE == 0) { const float s = col < 512 ? QSCALE : 1.f; store_bf8(QK + (size_t)row * 2048 + col, lo * s, hi * s); }
        else if (MODE == 1) {
            const int j = (col - 1024) & 127, pos = (row & posmask) + posbase; const f32x4* rp = (const f32x4*)(rope + pos * 64 + (j >> 1)); const f32x4 t0 = rp[0], t1 = rp[1];
            const float s = col >= 1536 ? QSCALE : 1.f;
            f32x4 o0, o1;
            o0[0] = (lo[0] * t0[0] - lo[1] * t0[1]) * s; o0[1] = (lo[0] * t0[1] + lo[1] * t0[0]) * s; o0[2] = (lo[2] * t0[2] - lo[3] * t0[3]) * s; o0[3] = (lo[2] * t0[3] + lo[3] * t0[2]) * s;
            o1[0] = (hi[0] * t1[0] - hi[1] * t1[1]) * s; o1[1] = (hi[0] * t1[1] + hi[1] * t1[0]) * s; o1[2] = (hi[2] * t1[2] - hi[3] * t1[3]) * s; o1[3] = (hi[2] * t1[3] + hi[3] * t1[2]) * s;
            store_bf8(QK + (size_t)row * 2048 + col, o0, o1);
        }
        else if (MODE == 2) store_bf8(V + (size_t)row * 2048 + (col - 2048), lo, hi);
        else if (MODE == 3) { const int cc = col - 4096; const f32x4 b0 = *(const f32x4*)(bg + cc), b1 = *(const f32x4*)(bg + cc + 4);
            f32x4 o0, o1;
#pragma unroll
            for (int i = 0; i < 4; ++i) { o0[i] = sigmoidf_(lo[i] + b0[i]); o1[i] = sigmoidf_(hi[i] + b1[i]); }
            store_bf8(SIG + (size_t)row * 2048 + cc, o0, o1); }
        else { if (col < 6160) { *(f32x4*)(GA + (size_t)row * 16 + (col - 6144)) = lo; *(f32x4*)(GA + (size_t)row * 16 + (col - 6144) + 4) = hi; } }
    }
    template <int MODE> __device__ __forceinline__ void row(const pg8::Unit& u, int r, int c8, f32x4 a0, f32x4 a1, f32x4 b0, f32x4 b1) const {
        half8<MODE>(u.row0 + r, u.col0 + c8, a0, a1); half8<MODE>(u.row0 + r, u.col0 + 128 + c8, b0, b1);
    }
};
struct F2 {
    static constexpr int NMODES = 1;
    const bf16* O; bf16* V;
    template <int MODE> __device__ __forceinline__ void at(const pg8::Unit& u, int r, int c, f32x4 v) const {
        const size_t off = (size_t)(u.row0 + r) * 2048 + u.col0 + c; bf16* p = V + off; const f32x4 o = load_bf4(O + off);
        f32x4 w; w[0] = siluf_(v[0]) * o[0]; w[1] = siluf_(v[1]) * o[1]; w[2] = siluf_(v[2]) * o[2]; w[3] = siluf_(v[3]) * o[3];
        store_bf4(p, w);
    }
    __device__ __forceinline__ void half8(size_t off, f32x4 lo, f32x4 hi) const {
        f32x4 o0, o1; load_bf8(O + off, o0, o1);
#pragma unroll
        for (int i = 0; i < 4; ++i) { o0[i] *= siluf_(lo[i]); o1[i] *= siluf_(hi[i]); }
        store_bf8(V + off, o0, o1);
    }
    template <int MODE> __device__ __forceinline__ void row(const pg8::Unit& u, int r, int c8, f32x4 a0, f32x4 a1, f32x4 b0, f32x4 b1) const {
        const size_t off = (size_t)(u.row0 + r) * 2048 + u.col0 + c8; half8(off, a0, a1); half8(off + 128, b0, b1);
    }
};
struct F3 {
    static constexpr int NMODES = 1;
    bf16* MRG; const bf16* SIG; int second;
    template <int MODE> __device__ __forceinline__ void at(const pg8::Unit& u, int r, int c, f32x4 v) const {
        const int row = u.row0 + r, col = u.col0 + c; bf16* p = MRG + (size_t)row * 1024 + col;
        const f32x4 g = load_bf4(SIG + (size_t)row * 2048 + second * 1024 + col); f32x4 o = g * v;
        if (second) o = o + load_bf4(p);
        store_bf4(p, o);
    }
    __device__ __forceinline__ void half8(int row, int col, f32x4 lo, f32x4 hi) const {
        bf16* p = MRG + (size_t)row * 1024 + col; f32x4 g0, g1; load_bf8(SIG + (size_t)row * 2048 + second * 1024 + col, g0, g1);
        f32x4 o0 = g0 * lo, o1 = g1 * hi;
        if (second) { f32x4 m0, m1; load_bf8(p, m0, m1); o0 = o0 + m0; o1 = o1 + m1; }
        store_bf8(p, o0, o1);
    }
    template <int MODE> __device__ __forceinline__ void row(const pg8::Unit& u, int r, int c8, f32x4 a0, f32x4 a1, f32x4 b0, f32x4 b1) const {
        half8(u.row0 + r, u.col0 + c8, a0, a1); half8(u.row0 + r, u.col0 + 128 + c8, b0, b1);
    }
};
struct F4 {
    static constexpr int NMODES = 1;
    const bf16* RES; bf16* OUT;
    template <int MODE> __device__ __forceinline__ void at(const pg8::Unit& u, int r, int c, f32x4 v) const {
        const size_t o = (size_t)(u.row0 + r) * 1024 + u.col0 + c; store_bf4(OUT + o, load_bf4(RES + o) * ALPHA + v);
    }
    __device__ __forceinline__ void half8(size_t o, f32x4 lo, f32x4 hi) const { f32x4 r0, r1; load_bf8(RES + o, r0, r1); store_bf8(OUT + o, r0 * ALPHA + lo, r1 * ALPHA + hi); }
    template <int MODE> __device__ __forceinline__ void row(const pg8::Unit& u, int r, int c8, f32x4 a0, f32x4 a1, f32x4 b0, f32x4 b1) const {
        const size_t o = (size_t)(u.row0 + r) * 1024 + u.col0 + c8; half8(o, a0, a1); half8(o + 128, b0, b1);
    }
};
struct F5 {
    static constexpr int NMODES = 1;
    bf16* U; int ldu;
    template <int MODE> __device__ __forceinline__ void row(const pg8::Unit& u, int r, int c8, f32x4 a0, f32x4 a1, f32x4 b0, f32x4 b1) const {
        f32x4 o0, o1;
#pragma unroll
        for (int i = 0; i < 4; ++i) { o0[i] = siluf_(a0[i]) * b0[i]; o1[i] = siluf_(a1[i]) * b1[i]; }
        store_bf8(U + (size_t)(u.row0 + r) * ldu + (u.col0 >> 1) + c8, o0, o1);
    }
    __device__ __forceinline__ void pair(int r, int f, f32x4 g, f32x4 uu) const {
        f32x4 o; o[0] = siluf_(g[0]) * uu[0]; o[1] = siluf_(g[1]) * uu[1]; o[2] = siluf_(g[2]) * uu[2]; o[3] = siluf_(g[3]) * uu[3];
        store_bf4(U + (size_t)r * ldu + f, o);
    }
};
struct F6M {
    static constexpr int NMODES = 1;
    bf16* Y; int second;
    template <int MODE> __device__ __forceinline__ void at(const pg8::Unit& u, int r, int c, f32x4 v) const {
        if (r >= u.nvalid) return;
        bf16* p = Y + (size_t)(u.row0 + r) * 1024 + u.col0 + c;
        if (second) v = v + load_bf4(p);
        store_bf4(p, v);
    }
    template <int MODE> __device__ __forceinline__ void row(const pg8::Unit& u, int r, int c8, f32x4 a0, f32x4 a1, f32x4 b0, f32x4 b1) const {
        if (r >= u.nvalid) return;
        bf16* p = Y + (size_t)(u.row0 + r) * 1024 + u.col0 + c8;
        if (second) { f32x4 m0, m1; load_bf8(p, m0, m1); a0 = a0 + m0; a1 = a1 + m1; load_bf8(p + 128, m0, m1); b0 = b0 + m0; b1 = b1 + m1; }
        store_bf8(p, a0, a1); store_bf8(p + 128, b0, b1);
    }
};
struct F6Mm {
    static constexpr int NMODES = 1;
    float* Y; int second;
    template <int MODE> __device__ __forceinline__ void at(const pg8::Unit& u, int r, int c, f32x4 v) const {
        float* p = Y + (size_t)r * 1024 + u.col0 + c;
        if (second) v = v + *(const f32x4*)p;
        *(f32x4*)p = v;
    }
};

struct SchedMoeUp {
    static constexpr bool GATHER = true;
    volatile LAS unsigned* T; const int* perm; const char* A; const char* W; int G, c, hf;
    __device__ bool next(int i, pg8::Unit& u) const {
        const int TT = (int)T[32]; const long L = (long)i * G + c; if (L >= (long)TT * 14) return false;
        const int gt = (int)(L / 14), pn = (int)(L % 14); int e = 0;
#pragma unroll
        for (int j = 1; j < 8; ++j) e += (gt >= (int)T[24 + j]) ? 1 : 0;
        u.A = A; u.B = W + ((size_t)(e * 2 + hf) * DFFE + (size_t)pn * 256) * (D * 2); u.row0 = gt * 256; u.col0 = pn * 256; u.e = e; u.nvalid = gt - (int)T[24 + e];
        return true;
    }
    __device__ __forceinline__ const int* idx_ptr(const pg8::Unit& u, int R, int h) const {
        const int rank = u.nvalid * 256 + h * 128 + R, cnt = (int)T[16 + u.e];
        return perm + u.e * M + (rank < cnt ? rank : 0);
    }
    __device__ __forceinline__ unsigned a_off(const pg8::Unit& u, int R, int h) const { return (unsigned)(*idx_ptr(u, R, h)) * (unsigned)(D * 2); }
    __device__ __forceinline__ const int* idx_base(const pg8::Unit& u) const { return perm + u.e * M + u.nvalid * 256; }
    __device__ __forceinline__ bool row_ok(const pg8::Unit& u, int rt) const { return u.nvalid * 256 + rt < (int)T[16 + u.e]; }
};
struct SchedMoeDown {
    static constexpr bool GATHER = false;
    volatile LAS unsigned* T; const char* A; const char* W; int G, c, hf;
    __device__ bool next(int i, pg8::Unit& u) const {
        const int TT = (int)T[32]; const long L = (long)i * G + c; if (L >= (long)TT * 4) return false;
        const int gt = (int)(L / 4), pn = (int)(L % 4); int e = 0;
#pragma unroll
        for (int j = 1; j < 8; ++j) e += (gt >= (int)T[24 + j]) ? 1 : 0;
        const int ti = gt - (int)T[24 + e], cnt = (int)T[16 + e];
        u.A = A + (size_t)gt * 256 * (HFF * 2); u.B = W + ((size_t)(e * 2 + hf) * D + (size_t)pn * 256) * (HFF * 2);
        u.row0 = (int)T[40 + e] + ti * 256; u.col0 = pn * 256; u.e = e; u.nvalid = (cnt - ti * 256) < 256 ? (cnt - ti * 256) : 256;
        return true;
    }
    __device__ __forceinline__ unsigned a_off(const pg8::Unit&, int R, int h) const { return (unsigned)(h * 128 + R) * (unsigned)(HFF * 2); }
};

__device__ __forceinline__ int map_b1(int n) {
    if (n < 1024) return n;
    if (n < 2048) { const int t = n - 1024, blk = t >> 9, hh = (t >> 7) & 3, j = t & 127; return (blk ? 3600 : 3088) + hh * 128 + (j >> 1) + 64 * (j & 1); }
    if (n < 3072) return 1024 + (n - 2048);
    if (n < 4096) return 4112 + (n - 3072);
    if (n < 5120) return 6160 + (n - 4096);
    if (n < 6144) return 7184 + (n - 5120);
    if (n < 6160) return 3072 + (n - 6144);
    return -1;
}
__device__ __forceinline__ int map_b2(int n) { return n < 1024 ? 2048 + n : 5136 + (n - 1024); }
__device__ __forceinline__ void cvt_item(const float* W, const float* W2, int kind, int foff, int ldsrc, int koff, int K, bf16* WT, LAS float* scr, int item, int lane) {
    const int nkb = K / 64, nb = item / nkb, kb = item % nkb, k0 = 64 * kb, n0 = 32 * nb;
    const int n = n0 + (lane & 31);
    int col; const float* src = W;
    if (kind == 0) col = n; else if (kind == 1) col = map_b1(n); else if (kind == 2) col = map_b2(n);
    else { col = foff + 128 * (n >> 8) + (n & 127); if (n & 128) src = W2; }
#pragma unroll 8
    for (int i = 0; i < 32; ++i) { const int kk = 2 * i + (lane >> 5); scr[kk * 33 + (lane & 31)] = (col >= 0) ? src[(size_t)(koff + k0 + kk) * ldsrc + col] : 0.f; }
    LDS_WAIT(); asm volatile("" ::: "memory");
    const int c = lane & 7;
#pragma unroll
    for (int j = 0; j < 4; ++j) { const int nn = (lane >> 3) + 8 * j; const LAS float* s = scr + (8 * c) * 33 + nn;
        u32x4 o; o.x = pk2(s[0 * 33], s[1 * 33]); o.y = pk2(s[2 * 33], s[3 * 33]); o.z = pk2(s[4 * 33], s[5 * 33]); o.w = pk2(s[6 * 33], s[7 * 33]);
        *(u32x4*)(WT + (size_t)(n0 + nn) * K + k0 + 8 * c) = o; }
    LDS_WAIT(); asm volatile("" ::: "memory");
}
__device__ __forceinline__ void cvt_job(const Frame& F, int& rot, const float* W, const float* W2, int kind, int foff, int ldsrc, int koff, int K, int Nnew, bf16* WT) {
    LAS float* scr = (LAS float*)(F.lds + F.wave * 16384);
    const int items = (K / 64) * (Nnew / 32);
    int start = F.gwave - rot; if (start < 0) start += F.gwaves;
    for (int it = start; it < items; it += F.gwaves) cvt_item(W, W2, kind, foff, ldsrc, koff, K, WT, scr, it, F.lane);
    rot = (rot + items) % F.gwaves;
}

__device__ __forceinline__ int rcol(int lane, int k) { return 8 * lane + 512 * (k >> 1) + 4 * (k & 1); }
__device__ __forceinline__ void ln_vals(f32x4 (&v)[4], const float* g, const float* b, int lane) {
    float s = 0.f;
#pragma unroll
    for (int j = 0; j < 4; ++j) s += (v[j][0] + v[j][1]) + (v[j][2] + v[j][3]);
    const float mean = wave_sum(s) * (1.f / D); float s2 = 0.f;
#pragma unroll
    for (int j = 0; j < 4; ++j) { v[j] = v[j] - mean; s2 += (v[j][0] * v[j][0] + v[j][1] * v[j][1]) + (v[j][2] * v[j][2] + v[j][3] * v[j][3]); }
    const float rstd = 1.f / sqrtf(wave_sum(s2) * (1.f / D) + LN_EPS);
#pragma unroll
    for (int j = 0; j < 4; ++j) { const f32x4 gg = *(const f32x4*)(g + rcol(lane, j)), bb = *(const f32x4*)(b + rcol(lane, j)); v[j] = v[j] * rstd * gg + bb; }
}
__device__ __forceinline__ void rowb_load(f32x4 (&v)[4], const bf16* p, int lane) { load_bf8(p + 8 * lane, v[0], v[1]); load_bf8(p + 512 + 8 * lane, v[2], v[3]); }
__device__ __forceinline__ void rowb_store(const f32x4 (&v)[4], bf16* p, int lane, int dry = 0) { if (dry) return; store_bf8(p + 8 * lane, v[0], v[1]); store_bf8(p + 512 + 8 * lane, v[2], v[3]); }
__device__ __forceinline__ void rowf_store(const f32x4 (&v)[4], float* p, int lane, int dry = 0) {
    if (dry) return;
#pragma unroll
    for (int j = 0; j < 4; ++j) *(f32x4*)(p + rcol(lane, j)) = v[j];
}
__device__ __forceinline__ void route_row(const f32x4 (&v)[4], const float* wr, int lane, int& e1, int& e2, float& w1, float& w2) {
    float lg[8];
#pragma unroll
    for (int e = 0; e < 8; ++e) lg[e] = 0.f;
#pragma unroll
    for (int j = 0; j < 4; ++j)
#pragma unroll
        for (int q = 0; q < 4; ++q) { const float* w = wr + (size_t)(rcol(lane, j) + q) * 8; const f32x4 wa = *(const f32x4*)w, wb = *(const f32x4*)(w + 4); const float x = v[j][q];
            lg[0] += x * wa[0]; lg[1] += x * wa[1]; lg[2] += x * wa[2]; lg[3] += x * wa[3]; lg[4] += x * wb[0]; lg[5] += x * wb[1]; lg[6] += x * wb[2]; lg[7] += x * wb[3]; }
#pragma unroll
    for (int e = 0; e < 8; ++e) lg[e] = wave_sum(lg[e]);
    int a = 0; float la = lg[0];
#pragma unroll
    for (int e = 1; e < 8; ++e) if (lg[e] > la) { la = lg[e]; a = e; }
    int b = -1; float lb = -3.0e38f;
#pragma unroll
    for (int e = 0; e < 8; ++e) if (e != a && lg[e] > lb) { lb = lg[e]; b = e; }
    const float t = __expf(lb - la);
    e1 = a; e2 = b; w1 = 1.f / (1.f + t); w2 = t / (1.f + t);
}

constexpr int MX_QIN = 0, MX_KIN = 33792, MX_P = 67584, MX_OB = 84224, MX_VT = 100608  ;
constexpr int MX_GA = 133376, MX_SEG = 137472  , MX_DEC = 139520  , MX_END = 140032;
static_assert(MX_END <= MISC_OFF, "mixer LDS below the MISC words");
struct MixArgs {
    bf16* QK; bf16* V; const float* GA;
    bf16* mQK; bf16* mV; const float* mGA; bf16* mO;
    const float* wa2; const float* ba; const float* gng; const float* rng; const float* rnb;
    int dry;
};
__device__ __forceinline__ void mixer_phase(const Frame& F, const MixArgs& a) {
    LAS float* qin = (LAS float*)(F.lds + MX_QIN); LAS float* kin = (LAS float*)(F.lds + MX_KIN); LAS float* P = (LAS float*)(F.lds + MX_P);
    LAS float* ob = (LAS float*)(F.lds + MX_OB); LAS bf16* vt = (LAS bf16*)(F.lds + MX_VT); LAS float* bc = (LAS float*)(F.lds + MX_P);
    LAS float* gab = (LAS float*)(F.lds + MX_GA); LAS float* seg = (LAS float*)(F.lds + MX_SEG); LAS float* dec = (LAS float*)(F.lds + MX_DEC);
    const int tid = F.tid, lane = F.lane, wave = F.wave, vv = tid & 255, dh = tid >> 8;
    for (int it = F.bid; it < NB * 8; it += F.G) {
        const int b = it >> 3, type = (it >> 2) & 1, head = it & 3;
        const int qcol = (type ? 1024 : 0) + head * 128, kcol = qcol + 512, vcol = type * 1024 + head * 256;
        const float lng = __logf(1.0f - exp2f(-5.0f - (float)head));
        float S[64];
#pragma unroll
        for (int i = 0; i < 64; ++i) S[i] = 0.f;
        const int gd = tid & 127, gi = tid >> 7;
        float wa[16]; float bad = 0.f;
        if (type == 0) {
#pragma unroll
            for (int r = 0; r < 16; ++r) wa[r] = a.wa2[r * 512 + head * 128 + gd];
            bad = a.ba[head * 128 + gd];
        } else {
#pragma unroll
            for (int r = 0; r < 16; ++r) wa[r] = 0.f;
        }
#pragma unroll 1
        for (int ch = -1; ch < 32; ++ch) {
            const bool meta = ch < 0;
            const bf16* qkb = meta ? a.mQK : a.QK + (size_t)(b * SEQ + ch * 64) * 2048;
            bf16* vb = meta ? a.mV : a.V + (size_t)(b * SEQ + ch * 64) * 2048;
            const float* gb = meta ? a.mGA : a.GA + (size_t)(b * SEQ + ch * 64) * 16;
            const int roff = meta ? 48 : 0;
            __syncthreads();
            for (int e = tid; e < 64 * 32; e += NTHR) {
                const int i = e >> 5, c4 = (e & 31) * 4; f32x4 q = (f32x4){0.f, 0.f, 0.f, 0.f}, k = q;
                if (i >= roff) { q = load_bf4(qkb + (size_t)(i - roff) * 2048 + qcol + c4); k = load_bf4(qkb + (size_t)(i - roff) * 2048 + kcol + c4); }
                *(LAS f32x4*)(qin + i * 132 + c4) = q; *(LAS f32x4*)(kin + i * 132 + c4) = k;
            }
            for (int e = tid; e < 64 * 64; e += NTHR) {
                const int i = e >> 6, c4 = (e & 63) * 4; u32x2 w; w.x = 0u; w.y = 0u;
                if (i >= roff) w = *(const u32x2*)(vb + (size_t)(i - roff) * 2048 + vcol + c4);
                *(LAS u32x2*)(vt + i * 256 + c4) = w;
            }
            if (type == 0) for (int e = tid; e < 64 * 16; e += NTHR) { const int i = e >> 4; gab[e] = (i >= roff) ? gb[(size_t)(i - roff) * 16 + (e & 15)] : 0.f; }
            __syncthreads();
            if (type == 0) {
                float run = 0.f;
#pragma unroll 4
                for (int ii = 0; ii < 16; ++ii) { const int i = gi * 16 + ii; float pre = bad;
#pragma unroll
                    for (int r = 0; r < 16; ++r) pre += gab[i * 16 + r] * wa[r];
                    const float ls = fminf(pre, 0.f) - log1pf(__expf(-fabsf(pre)));
                    run += (i >= roff) ? ls * (1.0f / 16.0f) : 0.f; bc[i * 128 + gd] = run; }
                seg[gi * 128 + gd] = run;
                __syncthreads();
                float off = 0.f;
#pragma unroll
                for (int g = 0; g < 4; ++g) off += (g < gi) ? seg[g * 128 + gd] : 0.f;
                if (gi == 3) dec[gd] = __expf(off + run);
#pragma unroll 4
                for (int ii = 0; ii < 16; ++ii) { const int i = gi * 16 + ii; const float bb = bc[i * 128 + gd] + off;
                    qin[i * 132 + gd] *= __expf(bb); kin[i * 132 + gd] *= __expf(-bb); }
            } else {
#pragma unroll 4
                for (int ii = 0; ii < 16; ++ii) { const int i = gi * 16 + ii; const float bb = (float)(i + 1) * lng;
                    qin[i * 132 + gd] *= __expf(bb); kin[i * 132 + gd] *= __expf(-bb); }
                if (gi == 3) dec[gd] = __expf(64.0f * lng);
            }
            __syncthreads();
            {
                const int i = tid >> 3, j0 = (tid & 7) * 8; float sc[8];
#pragma unroll
                for (int jj = 0; jj < 8; ++jj) sc[jj] = 0.f;
                for (int d4 = 0; d4 < 128; d4 += 4) { const f32x4 q = *(const LAS f32x4*)(qin + i * 132 + d4);
#pragma unroll
                    for (int jj = 0; jj < 8; ++jj) { const f32x4 k = *(const LAS f32x4*)(kin + (j0 + jj) * 132 + d4); sc[jj] += (q[0] * k[0] + q[1] * k[1]) + (q[2] * k[2] + q[3] * k[3]); } }
                __syncthreads();
#pragma unroll
                for (int jj = 0; jj < 8; ++jj) P[i * 65 + j0 + jj] = (j0 + jj <= i) ? sc[jj] : 0.f;
            }
            __syncthreads();
#pragma unroll 1
            for (int p = 0; p < 8; ++p) {
#pragma unroll 1
                for (int ii = 0; ii < 8; ++ii) { const int i = p * 8 + ii; float s = 0.f;
#pragma unroll
                    for (int d4 = 0; d4 < 64; d4 += 4) { const f32x4 q = *(const LAS f32x4*)(qin + i * 132 + dh * 64 + d4); s += (q[0] * S[d4] + q[1] * S[d4 + 1]) + (q[2] * S[d4 + 2] + q[3] * S[d4 + 3]); }
                    const int jlo = dh ? (i >> 1) + 1 : 0, jhi = dh ? i : (i >> 1);
                    for (int j = jlo; j <= jhi; ++j) s += P[i * 65 + j] * bf2f(vt[j * 256 + vv]);
                    ob[(dh * 8 + ii) * 256 + vv] = s; }
                __syncthreads();
                {
                    const int ii = wave, i = p * 8 + ii;
                    const f32x4 o = *(const LAS f32x4*)(ob + ii * 256 + lane * 4) + *(const LAS f32x4*)(ob + (8 + ii) * 256 + lane * 4);
                    f32x4 y;
                    if (type == 0) {
                        const float ss = wave_sum((o[0] * o[0] + o[1] * o[1]) + (o[2] * o[2] + o[3] * o[3]));
                        const float rs = 1.0f / sqrtf(ss * (1.0f / 256.0f) + LN_EPS);
                        const f32x4 g = *(const f32x4*)(a.gng + lane * 4); y = o * rs * g;
                    } else {
                        const float mu = wave_sum((o[0] + o[1]) + (o[2] + o[3])) * (1.0f / 256.0f); const f32x4 dd = o - mu;
                        const float var = wave_sum((dd[0] * dd[0] + dd[1] * dd[1]) + (dd[2] * dd[2] + dd[3] * dd[3])) * (1.0f / 256.0f);
                        const float rs = 1.0f / sqrtf(var + GN_EPS);
                        const f32x4 g = *(const f32x4*)(a.rng + head * 256 + lane * 4), bb = *(const f32x4*)(a.rnb + head * 256 + lane * 4); y = dd * rs * g + bb;
                    }
                    if (i >= roff && (!meta || b == 0) && !a.dry) store_bf4((meta ? a.mO : vb) + (size_t)(i - roff) * 2048 + vcol + lane * 4, y);
                }
                __syncthreads();
            }
#pragma unroll 1
            for (int j = 0; j < 64; ++j) { const float vj = bf2f(vt[j * 256 + vv]);
#pragma unroll
                for (int d4 = 0; d4 < 64; d4 += 4) { const f32x4 k = *(const LAS f32x4*)(kin + j * 132 + dh * 64 + d4); S[d4] += k[0] * vj; S[d4 + 1] += k[1] * vj; S[d4 + 2] += k[2] * vj; S[d4 + 3] += k[3] * vj; } }
#pragma unroll
            for (int d4 = 0; d4 < 64; d4 += 4) { const f32x4 dc = *(const LAS f32x4*)(dec + dh * 64 + d4); S[d4] *= dc[0]; S[d4 + 1] *= dc[1]; S[d4 + 2] *= dc[2]; S[d4 + 3] *= dc[3]; }
        }
    }
    __syncthreads();
}

typedef float f32x16 __attribute__((ext_vector_type(16)));
typedef short s16x4 __attribute__((ext_vector_type(4)));
constexpr int QROW = 272, PROW = 144, KTROW = 144, OROWF = 260;
constexpr int FM_QIN = 0, FM_KIN = 17408, FM_PT = 34816, FM_KT = 44032  , FM_OT = 0  ,
              FM_VS = 66560  , FM_SEG = 99328, FM_DEC = 101376, FM_GA = 101888  , FM_WA = 110080  , FM_NG = 118272  , FM_END = 120320;
static_assert(FM_KT + 128 * KTROW <= FM_VS && FM_END <= MISC_OFF, "fast mixer LDS map");
__device__ __forceinline__ bf16x8 pack8(float a0, float a1, float a2, float a3, float a4, float a5, float a6, float a7) {
    u32x4 p; p.x = pk2_sw(a0, a1); p.y = pk2_sw(a2, a3); p.z = pk2_sw(a4, a5); p.w = pk2_sw(a6, a7); return __builtin_bit_cast(bf16x8, p);
}
#define MIX_BAR() do { asm volatile("s_waitcnt lgkmcnt(0)" ::: "memory"); __builtin_amdgcn_s_barrier(); asm volatile("" ::: "memory"); } while (0)
__device__ __forceinline__ void mixer_fast(const Frame& F, const MixArgs& a) {
    LAS unsigned char* L = F.lds;
    LAS float* seg = (LAS float*)(L + FM_SEG); LAS float* dec = (LAS float*)(L + FM_DEC); LAS float* ot = (LAS float*)(L + FM_OT);
    const int tid0 = F.tid, wave = F.wave;
    const int gi = __builtin_amdgcn_readfirstlane(tid0 >> 7);
    LAS unsigned char* slab = L + FM_VS + wave * 4096;
    for (int it = F.bid; it < NB * 8; it += F.G) {
        int tid = tid0; asm volatile("" : "+v"(tid));
        int lane = tid & 63, gd = tid & 127, l32 = lane & 31, hh = lane >> 5, l16 = lane & 15, quad = lane >> 4;
        const int b = it >> 3, type = (it >> 2) & 1, head = it & 3;
        const int qcol = (type ? 1024 : 0) + head * 128, kcol = qcol + 512, vcol = type * 1024 + head * 256;
        const float lng = __logf(1.0f - exp2f(-5.0f - (float)head));
        f32x16 S[4];
#pragma unroll
        for (int T = 0; T < 4; ++T)
#pragma unroll
            for (int r = 0; r < 16; ++r) S[T][r] = 0.f;
        LAS float* ngL = (LAS float*)(L + FM_NG);
        if (tid0 < 256) { ngL[tid0] = (type == 0) ? a.gng[tid0] : a.rng[head * 256 + tid0]; ngL[256 + tid0] = (type == 0) ? 0.f : a.rnb[head * 256 + tid0]; }
        float bad = 0.f;
        LAS float* waL = (LAS float*)(L + FM_WA);
        if (type == 0) { bad = a.ba[head * 128 + gd];
            if (tid0 < 128) {
#pragma unroll
                for (int r = 0; r < 16; ++r) waL[r * 128 + gd] = a.wa2[r * 512 + head * 128 + gd]; } }
        unsigned qraw[16], kraw[16];
        { const unsigned qoff = (unsigned)(qcol + gd) * 2u, koff = (unsigned)(kcol + gd) * 2u;
#pragma unroll
        for (int ii = 0; ii < 16; ++ii) { qraw[ii] = 0u; kraw[ii] = 0u; }
        if (gi == 3) {
#pragma unroll
            for (int ii = 0; ii < 16; ++ii) { const char* rb = (const char*)a.mQK + (size_t)ii * 4096; qraw[ii] = *(const bf16*)(rb + qoff); kraw[ii] = *(const bf16*)(rb + koff); }
        } }
        {
            unsigned z0 = 0u; asm volatile("" : "+v"(z0));
            const u32x4 z = (u32x4){z0, z0, z0, z0};
#pragma unroll
            for (int j = 0; j < 3; ++j) *(LAS u32x4*)(slab + j * 1024 + lane * 16) = z;
            __builtin_amdgcn_global_load_lds((const unsigned*)(a.mV + (size_t)(lane >> 2) * 2048 + vcol + 32 * wave + 8 * (lane & 3)), (LAS unsigned*)(slab + 3 * 1024), 16, 0, 0);
        }
        if (type == 0 && gi == 3) __builtin_amdgcn_global_load_lds((const unsigned*)(a.mGA + lane * 4), (LAS unsigned*)(L + FM_GA + wave * 1024), 16, 0, 0);
        MIX_BAR();
#pragma unroll 1
        for (int ch = -1; ch < 32; ++ch) {
            const bool meta = ch < 0;
            bf16* vb = meta ? a.mV : a.V + (size_t)(b * SEQ + ch * 64) * 2048;
            const int roff = meta ? 48 : 0;
            int gio = gi; asm volatile("" : "+s"(gio));
            tid = tid0; asm volatile("" : "+v"(tid));
            lane = tid & 63; gd = tid & 127; l32 = lane & 31; hh = lane >> 5; l16 = lane & 15; quad = lane >> 4;
            const unsigned qoff = (unsigned)(qcol + gd) * 2u, koff = (unsigned)(kcol + gd) * 2u;
            asm volatile("s_waitcnt vmcnt(0)" ::: "memory");
            float bcs[16]; float run = 0.f;
            if (type == 0) {
                const LAS f32x4* gr = (const LAS f32x4*)(L + FM_GA + wave * 1024);
                float wa[16];
#pragma unroll
                for (int r = 0; r < 16; ++r) wa[r] = waL[r * 128 + gd];
#pragma unroll
                for (int ii = 0; ii < 16; ++ii) { const int c = gio * 16 + ii;
                    const f32x4 g0 = gr[ii * 4], g1 = gr[ii * 4 + 1], g2 = gr[ii * 4 + 2], g3 = gr[ii * 4 + 3];
                    float pre = bad + ((g0[0] * wa[0] + g0[1] * wa[1]) + (g0[2] * wa[2] + g0[3] * wa[3])) + ((g1[0] * wa[4] + g1[1] * wa[5]) + (g1[2] * wa[6] + g1[3] * wa[7]))
                                    + ((g2[0] * wa[8] + g2[1] * wa[9]) + (g2[2] * wa[10] + g2[3] * wa[11])) + ((g3[0] * wa[12] + g3[1] * wa[13]) + (g3[2] * wa[14] + g3[3] * wa[15]));
                    float ls = (fminf(pre, 0.f) - __logf(1.0f + __expf(-fabsf(pre)))) * (1.0f / 16.0f);
                    ls = (c >= roff) ? ls : 0.f;
                    run += ls; bcs[ii] = run; }
                seg[gio * 128 + gd] = run;
            } else {
#pragma unroll
                for (int ii = 0; ii < 16; ++ii) bcs[ii] = (float)(gio * 16 + ii + 1) * lng;
            }
            MIX_BAR();
            float off = 0.f;
            if (type == 0) {
#pragma unroll
                for (int g = 0; g < 4; ++g) off += (g < gio) ? seg[g * 128 + gd] : 0.f;
                if (gio == 3) dec[gd] = __expf(off + run);
            } else if (gio == 3) dec[gd] = __expf(64.0f * lng);
            {
                unsigned kt[8];
#pragma unroll
                for (int ii = 0; ii < 16; ++ii) { const int c = gio * 16 + ii; const float bb = bcs[ii] + off; const float eb = __expf(bb), en = __expf(-bb);
                    const unsigned qkv = pk2(bf2f(qraw[ii]) * eb, bf2f(kraw[ii]) * en); const unsigned qv = qkv & 0xffffu, kv = qkv >> 16;
                    *(LAS bf16*)(L + FM_QIN + c * QROW + gd * 2) = (bf16)qv; *(LAS bf16*)(L + FM_KIN + c * QROW + gd * 2) = (bf16)kv;
                    if (ii & 1) kt[ii >> 1] |= kv << 16; else kt[ii >> 1] = kv; }
                *(LAS u32x4*)(L + FM_KT + gd * KTROW + gio * 32) = (u32x4){kt[0], kt[1], kt[2], kt[3]};
                *(LAS u32x4*)(L + FM_KT + gd * KTROW + gio * 32 + 16) = (u32x4){kt[4], kt[5], kt[6], kt[7]};
            }
            MIX_BAR();
#pragma unroll 1
            for (int tt = wave; tt < 10; tt += 8) {
                const int ti = (tt >= 6) ? 3 : (tt >= 3) ? 2 : (tt >= 1) ? 1 : 0, tj = tt - ti * (ti + 1) / 2;
                f32x4 pacc = (f32x4){0.f, 0.f, 0.f, 0.f};
#pragma unroll
                for (int ks = 0; ks < 4; ++ks) {
                    const bf16x8 A = *(const LAS bf16x8*)(L + FM_QIN + (16 * ti + l16) * QROW + (32 * ks + 8 * quad) * 2);
                    const bf16x8 B = *(const LAS bf16x8*)(L + FM_KIN + (16 * tj + l16) * QROW + (32 * ks + 8 * quad) * 2);
                    pacc = __builtin_amdgcn_mfma_f32_16x16x32_bf16(A, B, pacc, 0, 0, 0);
                }
#pragma unroll
                for (int jj = 0; jj < 4; jj += 2) { const int row = 16 * ti + 4 * quad + jj, col = 16 * tj + l16;
                    const unsigned pp = pk2((col > row) ? 0.f : pacc[jj], (col > row + 1) ? 0.f : pacc[jj + 1]);
                    *(LAS bf16*)(L + FM_PT + row * PROW + col * 2) = (bf16)(pp & 0xffffu); *(LAS bf16*)(L + FM_PT + (row + 1) * PROW + col * 2) = (bf16)(pp >> 16); }
            }
            if (wave == 2 || wave == 3) {
                const int ti = (wave == 2) ? 0 : 2, tj = ti + 1;
#pragma unroll
                for (int jj = 0; jj < 4; ++jj) *(LAS bf16*)(L + FM_PT + (16 * ti + 4 * quad + jj) * PROW + (16 * tj + l16) * 2) = (bf16)0;
            }
            MIX_BAR();
            bf16x8 vf[4];
            {
                const unsigned base = (unsigned)(size_t)(slab + (8 * hh + (l16 >> 2)) * 64 + 32 * (quad & 1) + 8 * (l16 & 3));
                s16x4 t0, t1, t2, t3, t4, t5, t6, t7;
                asm volatile("ds_read_b64_tr_b16 %0, %8\n\tds_read_b64_tr_b16 %1, %8 offset:256\n\tds_read_b64_tr_b16 %2, %8 offset:1024\n\tds_read_b64_tr_b16 %3, %8 offset:1280\n\t"
                             "ds_read_b64_tr_b16 %4, %8 offset:2048\n\tds_read_b64_tr_b16 %5, %8 offset:2304\n\tds_read_b64_tr_b16 %6, %8 offset:3072\n\tds_read_b64_tr_b16 %7, %8 offset:3328\n\ts_waitcnt lgkmcnt(0)"
                             : "=&v"(t0), "=&v"(t1), "=&v"(t2), "=&v"(t3), "=&v"(t4), "=&v"(t5), "=&v"(t6), "=&v"(t7) : "v"(base) : "memory");
                vf[0] = (bf16x8){t0[0], t0[1], t0[2], t0[3], t1[0], t1[1], t1[2], t1[3]}; vf[1] = (bf16x8){t2[0], t2[1], t2[2], t2[3], t3[0], t3[1], t3[2], t3[3]};
                vf[2] = (bf16x8){t4[0], t4[1], t4[2], t4[3], t5[0], t5[1], t5[2], t5[3]}; vf[3] = (bf16x8){t6[0], t6[1], t6[2], t6[3], t7[0], t7[1], t7[2], t7[3]};
            }
            if (ch < 31) { const bf16* nq = a.QK + (size_t)(b * SEQ + (ch + 1) * 64 + gi * 16) * 2048;
#pragma unroll
                for (int ii = 0; ii < 16; ++ii) { const char* rb = (const char*)nq + (size_t)ii * 4096; qraw[ii] = *(const bf16*)(rb + qoff); kraw[ii] = *(const bf16*)(rb + koff); } }
            __builtin_amdgcn_sched_barrier(0);
            f32x16 O[2];
#pragma unroll
            for (int mt = 0; mt < 2; ++mt)
#pragma unroll
                for (int r = 0; r < 16; ++r) O[mt][r] = 0.f;
#pragma unroll
            for (int mt = 0; mt < 2; ++mt)
#pragma unroll
                for (int ks = 0; ks < 2 * mt + 2; ++ks) {
                    const bf16x8 A = *(const LAS bf16x8*)(L + FM_PT + (32 * mt + l32) * PROW + (16 * ks + 8 * hh) * 2);
                    O[mt] = __builtin_amdgcn_mfma_f32_32x32x16_bf16(A, vf[ks], O[mt], 0, 0, 0);
                }
#pragma unroll
            for (int T = 0; T < 4; ++T) {
                bf16x8 Aq[2][2];
#pragma unroll
                for (int s2 = 0; s2 < 2; ++s2)
#pragma unroll
                    for (int mt = 0; mt < 2; ++mt) {
                        const LAS unsigned char* qp = L + FM_QIN + (32 * mt + l32) * QROW + (32 * T + 16 * s2 + 4 * hh) * 2;
                        const u32x2 lo = *(const LAS u32x2*)qp, hi = *(const LAS u32x2*)(qp + 16);
                        Aq[s2][mt] = __builtin_bit_cast(bf16x8, (u32x4){lo.x, lo.y, hi.x, hi.y});
                    }
#pragma unroll
                for (int s2 = 0; s2 < 2; ++s2) {
                    const bf16x8 Bs = pack8(S[T][8 * s2], S[T][8 * s2 + 1], S[T][8 * s2 + 2], S[T][8 * s2 + 3], S[T][8 * s2 + 4], S[T][8 * s2 + 5], S[T][8 * s2 + 6], S[T][8 * s2 + 7]);
                    O[0] = __builtin_amdgcn_mfma_f32_32x32x16_bf16(Aq[s2][0], Bs, O[0], 0, 0, 0);
                    O[1] = __builtin_amdgcn_mfma_f32_32x32x16_bf16(Aq[s2][1], Bs, O[1], 0, 0, 0);
                }
                __builtin_amdgcn_sched_barrier(0);
            }
#pragma unroll
            for (int T = 0; T < 4; ++T) {
                bf16x8 Ak[4]; f32x4 dc[4];
#pragma unroll
                for (int ks = 0; ks < 4; ++ks) Ak[ks] = *(const LAS bf16x8*)(L + FM_KT + (32 * T + l32) * KTROW + (16 * ks + 8 * hh) * 2);
#pragma unroll
                for (int q4 = 0; q4 < 4; ++q4) dc[q4] = *(const LAS f32x4*)(dec + 32 * T + 8 * q4 + 4 * hh);
#pragma unroll
                for (int ks = 0; ks < 4; ++ks) S[T] = __builtin_amdgcn_mfma_f32_32x32x16_bf16(Ak[ks], vf[ks], S[T], 0, 0, 0);
#pragma unroll
                for (int q4 = 0; q4 < 4; ++q4) { S[T][4 * q4] *= dc[q4][0]; S[T][4 * q4 + 1] *= dc[q4][1]; S[T][4 * q4 + 2] *= dc[q4][2]; S[T][4 * q4 + 3] *= dc[q4][3]; }
                __builtin_amdgcn_sched_barrier(0);
            }
            if (ch < 31) { const bf16* nv = a.V + (size_t)(b * SEQ + (ch + 1) * 64) * 2048 + vcol + 32 * wave + 8 * (lane & 3);
                asm volatile("s_waitcnt lgkmcnt(0)" ::: "memory");
#pragma unroll
                for (int j = 0; j < 4; ++j) __builtin_amdgcn_global_load_lds((const unsigned*)(nv + (size_t)(16 * j + (lane >> 2)) * 2048), (LAS unsigned*)(slab + j * 1024), 16, 0, 0);
                if (type == 0) __builtin_amdgcn_global_load_lds((const unsigned*)(a.GA + (size_t)(b * SEQ + (ch + 1) * 64 + gi * 16) * 16 + lane * 4), (LAS unsigned*)(L + FM_GA + wave * 1024), 16, 0, 0); }
            MIX_BAR();
#pragma unroll
            for (int mt = 0; mt < 2; ++mt)
#pragma unroll
                for (int r = 0; r < 16; ++r) ot[(32 * mt + (r & 3) + 8 * (r >> 2) + 4 * hh) * OROWF + 32 * wave + l32] = O[mt][r];
            MIX_BAR();
            const f32x4 ng = *(const LAS f32x4*)(ngL + lane * 4), nb = *(const LAS f32x4*)(ngL + 256 + lane * 4);
#pragma unroll 2
            for (int rr = 0; rr < 8; ++rr) {
                const int i = wave * 8 + rr;
                const f32x4 o = *(const LAS f32x4*)(ot + i * OROWF + lane * 4);
                f32x4 y;
                if (type == 0) {
                    const float ss = wave_sum((o[0] * o[0] + o[1] * o[1]) + (o[2] * o[2] + o[3] * o[3]));
                    const float rs = __builtin_amdgcn_rsqf(ss * (1.0f / 256.0f) + LN_EPS);
                    y = o * rs * ng;
                } else {
                    const float mu = wave_sum((o[0] + o[1]) + (o[2] + o[3])) * (1.0f / 256.0f); const f32x4 dd = o - mu;
                    const float var = wave_sum((dd[0] * dd[0] + dd[1] * dd[1]) + (dd[2] * dd[2] + dd[3] * dd[3])) * (1.0f / 256.0f);
                    const float rs = __builtin_amdgcn_rsqf(var + GN_EPS);
                    y = dd * rs * ng + nb;
                }
                if (i >= roff && (!meta || b == 0) && !a.dry) store_bf4((meta ? a.mO : vb) + (size_t)(i - roff) * 2048 + vcol + lane * 4, y);
            }
        }
        MIX_BAR();
    }
}

typedef const __attribute__((address_space(4))) Args* KArgs;
__device__ __forceinline__ KArgs kargs() { KArgs p = (KArgs)__builtin_amdgcn_kernarg_segment_ptr(); asm volatile("" : "+s"(p)); return p; }
#define ENV() \
    KArgs A_ = kargs(); \
    Frame F; { int t_ = threadIdx.x; asm volatile("" : "+v"(t_)); int b_ = blockIdx.x; asm volatile("" : "+s"(b_)); \
        { LAS unsigned char* l_ = (LAS unsigned char*)lds_raw; asm volatile("" : "+s"(l_)); F.lds = l_; } F.MISC = (volatile LAS unsigned*)(F.lds + MISC_OFF); F.tid = t_; F.lane = t_ & 63; F.wave = __builtin_amdgcn_readfirstlane(t_ >> 6); \
        F.G = gridDim.x; F.bid = b_; F.gtid = b_ * NTHR + t_; F.gthreads = F.G * NTHR; F.gwave = b_ * NWAVES + F.wave; F.gwaves = F.G * NWAVES; F.ws = A_->ws; F.ctl = (unsigned*)(A_->ws + WS_CTL); } \
    unsigned char* ws = A_->ws; typedef const float* cfp_; const __attribute__((address_space(4))) cfp_* in = A_->in; \
    bf16* HA = (bf16*)(ws + WS_HA); bf16* HB = (bf16*)(ws + WS_HB); float* OUTF = A_->out; \
    bf16* QK = (bf16*)(ws + WS_QK); bf16* V = (bf16*)(ws + WS_V); float* GA = (float*)(ws + WS_GA); \
    bf16* MRG = QK; bf16* U = QK; const f32x2* rope = (const f32x2*)(ws + WS_ROPE); \
    unsigned char* mt = ws + WS_META; \
    bf16* mA = (bf16*)(mt + MT_XB); bf16* mB = (bf16*)(mt + MT_HA); bf16* mQK = (bf16*)(mt + MT_QK); bf16* mV = (bf16*)(mt + MT_V); \
    bf16* mSIG = (bf16*)(mt + MT_SIG); float* mGA = (float*)(mt + MT_GA); bf16* mMRG = (bf16*)(mt + MT_MRG); bf16* mU = (bf16*)(mt + MT_U); float* mY = (float*)(mt + MT_Y); \
    bf16* mUall = (bf16*)(ws + WS_META2); float* mYall = (float*)(ws + WS_META2 + 512 * 1024); (void)mUall; (void)mYall; \
    bf16* mO = (bf16*)(mt + MT_O); int* mTokE = (int*)(mt + MT_TOK); float* mTokW = (float*)(mt + MT_TOK + 128); \
    int* perm = (int*)(ws + WS_MOE); int* tok_slot = (int*)(ws + WS_MOE + 2 * MiB); float* tok_w = (float*)(ws + WS_MOE + 2 * MiB + 512 * 1024); \
    const bf16* B1t = (const bf16*)(ws + WS_W + W_B1); const bf16* B2t = (const bf16*)(ws + WS_W + W_B2); const bf16* PAt = (const bf16*)(ws + WS_W + W_PA); \
    const bf16* PBt = (const bf16*)(ws + WS_W + W_PB); const bf16* Ot = (const bf16*)(ws + WS_W + W_O); const bf16* FGU = (const bf16*)(ws + WS_W + W_F); \
    const bf16* FDd = (const bf16*)(ws + WS_W + W_FD_DENSE); const bf16* FDm = (const bf16*)(ws + WS_W + W_FD_MOE); \
    bf16* SIG = (bf16*)A_->out; bf16* Y = (l == DEPTH - 1) ? (bf16*)(ws + WS_Y3) : (bf16*)A_->out;     \
    (void)HA; (void)HB; (void)OUTF; (void)mA; (void)mB; (void)QK; (void)V; (void)GA; (void)MRG; (void)U; (void)rope; (void)mQK; (void)mV; (void)mSIG; (void)mGA; (void)mMRG; (void)mU; (void)mY; \
    (void)mO; (void)mTokE; (void)mTokW; (void)perm; (void)tok_slot; (void)tok_w; (void)B1t; (void)B2t; (void)PAt; (void)PBt; (void)Ot; (void)FGU; (void)FDd; (void)FDm; \
    (void)SIG; (void)Y; (void)in

__global__ void __launch_bounds__(NTHR, 2) fwd_kernel(Args args) {
    extern __shared__ __attribute__((aligned(16))) unsigned char lds_raw[];
    const int lo = args.ph_lo, hi = args.ph_hi;
    const bool multi = (hi - lo) > 1;
    {
        volatile LAS unsigned* MISC0 = (volatile LAS unsigned*)((LAS unsigned char*)lds_raw + MISC_OFF);
        for (int u = threadIdx.x; u < 256; u += NTHR) MISC0[u] = 0u;
        __syncthreads();
        if (multi) (void)xcd_barrier_post((unsigned*)(args.ws + WS_CTL) + CW_BAR + args.li * XCD_BAR_WORDS, MISC0);
    }
#ifndef PH_MASK
#define PH_MASK 0xFFF
#endif
#define INS(slot, k) ((((PH_MASK) >> (slot)) & 1) && lo <= (k) && (k) < hi)
#define IN(k) (lo <= (k) && (k) < hi)
#define SEAM(k) do { if (IN(k) && IN((k) + 1)) { KArgs B_ = kargs(); XcdBarrier bar; bar.bar = (unsigned*)(B_->ws + WS_CTL) + CW_BAR + B_->li * XCD_BAR_WORDS; bar.x = xb_xcc_id(); \
        bar.st = (volatile LAS unsigned*)((LAS unsigned char*)lds_raw + MISC_OFF); xcd_barrier(bar); } } while (0)

    for (int l = 0; l < DEPTH; ++l) {
        const int pb = l * NPH;
        if (hi <= pb || lo >= pb + NPH) continue;
        const bool moe = (l & 1) != 0; const int l2 = l >> 1;
        if (INS(0, pb + 0)) { ENV();
            int rot = 0;
            const float* win = in[I_WIN] + (size_t)l * D * NIN;
            cvt_job(F, rot, win, nullptr, 1, 0, NIN, 0, D, N1, (bf16*)B1t);
            cvt_job(F, rot, win, nullptr, 2, 0, NIN, 0, D, 2048, (bf16*)B2t);
            cvt_job(F, rot, in[I_WPA] + (size_t)l * D * D, nullptr, 0, 0, D, 0, D, D, (bf16*)PAt);
            cvt_job(F, rot, in[I_WPB] + (size_t)l * D * D, nullptr, 0, 0, D, 0, D, D, (bf16*)PBt);
            cvt_job(F, rot, in[I_WO] + (size_t)l * D * D, nullptr, 0, 0, D, 0, D, D, (bf16*)Ot);
            if (!moe) {
                cvt_job(F, rot, in[I_FG] + (size_t)l2 * D * DFF, in[I_FU] + (size_t)l2 * D * DFF, 3, 0, DFF, 0, D, 2 * DFF, (bf16*)FGU);
                cvt_job(F, rot, in[I_FD] + (size_t)l2 * DFF * D, nullptr, 0, 0, D, 0, DFF, D, (bf16*)FDd);
            } else {
                for (int e = 0; e < NEXP; ++e)
                    for (int hf = 0; hf < 2; ++hf) {
                        const float* wg = in[I_MG] + ((size_t)l2 * NEXP + e) * D * DFFE; const float* wu = in[I_MU] + ((size_t)l2 * NEXP + e) * D * DFFE;
                        cvt_job(F, rot, wg, wu, 3, hf * HFF, DFFE, 0, D, DFFE, (bf16*)FGU + (size_t)(e * 2 + hf) * DFFE * D);
                        cvt_job(F, rot, in[I_MD] + ((size_t)l2 * NEXP + e) * DFFE * D, nullptr, 0, 0, D, hf * HFF, HFF, D, (bf16*)FDm + (size_t)(e * 2 + hf) * D * HFF);
                    }
                if (F.gtid < NEXP) F.ctl[CW_CNT + 64 * F.gtid] = 0u;
            }
            if (l == 0) {
                for (int i = F.gtid; i < 2064 * 64; i += F.gthreads) { const int pos = i >> 6, k = i & 63; const float inv = powf(10000.0f, -(float)k / 64.0f); const float ang = (float)pos * inv;
                    float sn, cs; sincosf(ang, &sn, &cs); ((f32x2*)rope)[i] = (f32x2){cs, sn}; }
                const float* x = in[I_X];
                for (size_t i = (size_t)F.gtid * 4; i < (size_t)M * D; i += (size_t)F.gthreads * 4) store_bf4(HA + i, *(const f32x4*)(x + i));
                for (int i = F.gtid * 4; i < NMETA * D; i += F.gthreads * 4) store_bf4(mA + i, *(const f32x4*)(in[I_META] + i));
            }
        }
        SEAM(pb + 0);

        if (INS(1, pb + 1)) { ENV();
            const float* bg = in[I_BGATE] + (size_t)l * 2 * D;
            { F1 f{mQK, mV, mSIG, mGA, rope, bg, 15, 0};
              meta_gemm(F, 1, N1, D, [=](int, int r) { return mA + (size_t)r * D; }, [=](int, int c) { return B1t + (size_t)c * D; }, [=](int) { return f; }); }
            pg8::SchedDense S; S.init(M, N1, F.G, F.bid, HA, D * 2, B1t, D * 2);
            pg8::EpiRow<F1> E{F1{QK, V, SIG, GA, rope, bg, 2047, 16}};
            pg8::gemm_phase<pg8::EpiRow<F1>, pg8::SchedDense>(F.lds, F.tid, S, E, D, D * 2, D * 2);
        }
        SEAM(pb + 1);

        if (INS(2, pb + 2)) { ENV();
            MixArgs ma{QK, V, GA, mQK, mV, mGA, mO, in[I_WA2] + (size_t)l * 16 * 512, in[I_BA] + (size_t)l * 512, in[I_GNG] + (size_t)l * 256,
                       in[I_RNG] + (size_t)l * 1024, in[I_RNB] + (size_t)l * 1024, 0};
#if MIXER_FAST
            if (PROBE_DUP & 2) { ma.dry = 1; mixer_fast(F, ma); ma.dry = 0; }
            mixer_fast(F, ma);
#else
            if (PROBE_DUP & 2) { ma.dry = 1; mixer_phase(F, ma); ma.dry = 0; }
            mixer_phase(F, ma);
#endif
        }
        SEAM(pb + 2);

        if (INS(3, pb + 3)) { ENV();
            { F2 f{mO, mV}; meta_gemm(F, 1, 2048, D, [=](int, int r) { return mA + (size_t)r * D; }, [=](int, int c) { return B2t + (size_t)c * D; }, [=](int) { return f; }); }
            pg8::SchedDense S; S.init(M, 2048, F.G, F.bid, HA, D * 2, B2t, D * 2);
            pg8::EpiRow<F2> E{F2{V, V}};
            pg8::gemm_phase<pg8::EpiRow<F2>, pg8::SchedDense>(F.lds, F.tid, S, E, D, D * 2, D * 2);
        }
        SEAM(pb + 3);

        if (INS(4, pb + 4)) { ENV();
#pragma unroll 1
            for (int pass = 0; pass < 2; ++pass) {
                const bf16* Wt = pass ? PBt : PAt;
                { F3 f{mMRG, mSIG, pass}; const bf16* mA = mV + pass * 1024; meta_gemm(F, 1, D, D, [=](int, int r) { return mA + (size_t)r * 2048; }, [=](int, int c) { return Wt + (size_t)c * D; }, [=](int) { return f; }); }
                pg8::SchedDense S; S.init(M, D, F.G, F.bid, V + pass * 1024, 2048 * 2, Wt, D * 2);
                pg8::EpiRow<F3> E{F3{MRG, SIG, pass}};
                pg8::gemm_phase<pg8::EpiRow<F3>, pg8::SchedDense>(F.lds, F.tid, S, E, D, 2048 * 2, D * 2);
            }
        }
        SEAM(pb + 4);

        if (INS(5, pb + 5)) { ENV();
            { F4 f{mA, mB}; meta_gemm(F, 1, D, D, [=](int, int r) { return mMRG + (size_t)r * D; }, [=](int, int c) { return Ot + (size_t)c * D; }, [=](int) { return f; }); }
            pg8::SchedDense S; S.init(M, D, F.G, F.bid, MRG, D * 2, Ot, D * 2);
            pg8::EpiRow<F4> E{F4{HA, HB}};
            pg8::gemm_phase<pg8::EpiRow<F4>, pg8::SchedDense>(F.lds, F.tid, S, E, D, D * 2, D * 2);
        }
        SEAM(pb + 5);

        if (INS(6, pb + 6)) { ENV();
            const float* g = in[I_LN1G] + (size_t)l * D; const float* bb = in[I_LN1B] + (size_t)l * D;
            const float* wrt = in[I_RT] + (size_t)l2 * D * NEXP;
#pragma unroll 1
            for (int rep = (PROBE_DUP & 4) ? 0 : 1; rep < 2; ++rep)
            for (int r = F.gwave; r < M + NMETA; r += F.gwaves) { const int dry = (rep == 0);
                const bool ism = r >= M; const int rr = ism ? r - M : r;
                bf16* p = ism ? mB + (size_t)rr * D : HB + (size_t)rr * D;
                f32x4 v[4]; rowb_load(v, p, F.lane); ln_vals(v, g, bb, F.lane); rowb_store(v, p, F.lane, dry);
                if (moe) {
                    int e1, e2; float w1, w2; route_row(v, wrt, F.lane, e1, e2, w1, w2);
                    if (F.lane == 0 && !dry) {
                        if (ism) { mTokE[rr * 2] = e1; mTokE[rr * 2 + 1] = e2; mTokW[rr * 2] = w1; mTokW[rr * 2 + 1] = w2; }
                        else {
                            const unsigned r1 = atomicAdd(F.ctl + CW_CNT + 64 * e1, 1u), r2 = atomicAdd(F.ctl + CW_CNT + 64 * e2, 1u);
                            perm[e1 * M + (int)r1] = rr; perm[e2 * M + (int)r2] = rr;
                            tok_slot[rr * 2] = (e1 << 16) | (int)r1; tok_slot[rr * 2 + 1] = (e2 << 16) | (int)r2; tok_w[rr * 2] = w1; tok_w[rr * 2 + 1] = w2;
                        }
                    }
                }
            }
        }
        SEAM(pb + 6);

        if (!moe) {
            if (INS(7, pb + 7)) { ENV();
                { F5 f{mU, DFF}; meta_gemm_pair(F, 1, DFF, D, [=](int, int r) { return mB + (size_t)r * D; }, [=](int, int c) { return FGU + (size_t)c * D; }, [=](int) { return f; }); }
                pg8::SchedDense S; S.init(M, 2 * DFF, F.G, F.bid, HB, D * 2, FGU, D * 2);
                pg8::EpiRow<F5> E{F5{U, DFF}};
                pg8::gemm_phase<pg8::EpiRow<F5>, pg8::SchedDense>(F.lds, F.tid, S, E, D, D * 2, D * 2);
            }
            SEAM(pb + 7);
            if (INS(8, pb + 8)) { ENV();
                { F4 f{mB, mA}; meta_gemm(F, 1, D, DFF, [=](int, int r) { return mU + (size_t)r * DFF; }, [=](int, int c) { return FDd + (size_t)c * DFF; }, [=](int) { return f; }); }
                pg8::SchedDense S; S.init(M, D, F.G, F.bid, U, DFF * 2, FDd, DFF * 2);
                pg8::EpiRow<F4> E{F4{HB, HA}};
                pg8::gemm_phase<pg8::EpiRow<F4>, pg8::SchedDense>(F.lds, F.tid, S, E, DFF, DFF * 2, DFF * 2);
            }
            SEAM(pb + 8);
            if (INS(11, pb + 11)) { ENV();
                const float* g = in[I_LN2G] + (size_t)l * D; const float* bb = in[I_LN2B] + (size_t)l * D;
    #pragma unroll 1
            for (int rep = (PROBE_DUP & 4) ? 0 : 1; rep < 2; ++rep)
            for (int r = F.gwave; r < M + NMETA; r += F.gwaves) { const int dry = (rep == 0);
                    const bool ism = r >= M; const int rr = ism ? r - M : r;
                    bf16* p = ism ? mA + (size_t)rr * D : HA + (size_t)rr * D;
                    f32x4 v[4]; rowb_load(v, p, F.lane); ln_vals(v, g, bb, F.lane); rowb_store(v, p, F.lane, dry);
                }
            }
            SEAM(pb + 11);
        } else {
            if (lo <= pb + 11 && hi > pb + 7) { ENV();
                if (F.tid == 0) {
                    unsigned ts = 0, cb = 0;
                    for (int e = 0; e < NEXP; ++e) { const unsigned c = __hip_atomic_load(F.ctl + CW_CNT + 64 * e, __ATOMIC_RELAXED, __HIP_MEMORY_SCOPE_AGENT);
                        F.MISC[16 + e] = c; F.MISC[24 + e] = ts; F.MISC[40 + e] = cb; ts += (c + 255u) >> 8; cb += c; }
                    F.MISC[32] = ts;
                }
                __syncthreads();
            }
#pragma unroll 1
            for (int hf = 0; hf < 2; ++hf) {
                if (INS(9, pb + 7 + 2 * hf)) { ENV();
                    meta_gemm_pair(F, NEXP, HFF, D, [=](int, int r) { return mB + (size_t)r * D; }, [=](int e, int c) { return FGU + ((size_t)(e * 2 + hf) * DFFE + c) * D; },
                              [=](int e) { return F5{mUall + (size_t)e * NMETA * HFF, HFF}; });
                    SchedMoeUp S{F.MISC, perm, (const char*)HB, (const char*)FGU, F.G, F.bid, hf};
                    pg8::EpiRow<F5> E{F5{U, HFF}};
                    pg8::gemm_phase<pg8::EpiRow<F5>, SchedMoeUp>(F.lds, F.tid, S, E, D, D * 2, D * 2);
                }
                SEAM(pb + 7 + 2 * hf);
                if (INS(10, pb + 8 + 2 * hf)) { ENV();
                    meta_gemm(F, NEXP, D, HFF, [=](int e, int r) { return mUall + ((size_t)e * NMETA + r) * HFF; }, [=](int e, int c) { return FDm + ((size_t)(e * 2 + hf) * D + c) * HFF; },
                              [=](int e) { return F6Mm{mYall + (size_t)e * NMETA * D, hf}; });
                    SchedMoeDown S{F.MISC, (const char*)U, (const char*)FDm, F.G, F.bid, hf};
                    pg8::EpiRow<F6M> E{F6M{Y, hf}};
                    pg8::gemm_phase<pg8::EpiRow<F6M>, SchedMoeDown>(F.lds, F.tid, S, E, HFF, HFF * 2, HFF * 2);
                }
                SEAM(pb + 8 + 2 * hf);
            }
            if (INS(11, pb + 11)) { ENV();
                const float* g = in[I_LN2G] + (size_t)l * D; const float* bb = in[I_LN2B] + (size_t)l * D;
    #pragma unroll 1
            for (int rep = (PROBE_DUP & 4) ? 0 : 1; rep < 2; ++rep)
            for (int r = F.gwave; r < M + NMETA; r += F.gwaves) { const int dry = (rep == 0);
                    const bool ism = r >= M; const int rr = ism ? r - M : r;
                    const bf16* p = ism ? mB + (size_t)rr * D : HB + (size_t)rr * D;
                    f32x4 v[4]; rowb_load(v, p, F.lane);
                    if (ism) {
                        const float w1 = mTokW[rr * 2], w2 = mTokW[rr * 2 + 1];
                        const int me1 = mTokE[rr * 2], me2 = mTokE[rr * 2 + 1];
#pragma unroll
                        for (int j = 0; j < 4; ++j) { const f32x4 y1 = *(const f32x4*)(mYall + ((size_t)me1 * NMETA + rr) * D + rcol(F.lane, j)), y2 = *(const f32x4*)(mYall + ((size_t)me2 * NMETA + rr) * D + rcol(F.lane, j));
                            v[j] = v[j] * ALPHA + y1 * w1 + y2 * w2; }
                    } else {
                        const int s1 = tok_slot[rr * 2], s2 = tok_slot[rr * 2 + 1]; const float w1 = tok_w[rr * 2], w2 = tok_w[rr * 2 + 1];
                        const size_t y1r = (size_t)F.MISC[40 + (s1 >> 16)] + (size_t)(s1 & 0xffff), y2r = (size_t)F.MISC[40 + (s2 >> 16)] + (size_t)(s2 & 0xffff);
                        f32x4 ya[4], yb[4]; rowb_load(ya, Y + y1r * D, F.lane); rowb_load(yb, Y + y2r * D, F.lane);
#pragma unroll
                        for (int j = 0; j < 4; ++j) v[j] = v[j] * ALPHA + ya[j] * w1 + yb[j] * w2;
                    }
                    ln_vals(v, g, bb, F.lane);
                    if (ism) rowb_store(v, mA + (size_t)rr * D, F.lane, dry);
                    else if (l == DEPTH - 1) rowf_store(v, OUTF + (size_t)rr * D, F.lane, dry);
                    else rowb_store(v, HA + (size_t)rr * D, F.lane, dry);
                }
            }
            SEAM(pb + 11);
        }
    }
#undef IN
#undef SEAM
}

extern "C" void kernel_launch(void* const* d_in, const int* in_sizes, int n_in, void* d_out, int out_size, void* d_ws, size_t ws_size, hipStream_t stream) {
    static int grid = 0;
    if (grid == 0) {
        if (n_in != 23 || in_sizes[0] != M * D || out_size != M * D || ws_size < WS_END) { fprintf(stderr, "kernel_launch: unexpected shapes / workspace (%d inputs, ws %zu)\n", n_in, ws_size); grid = -1; return; }
        int dev = 0, cus = 0, per_cu = 0;
        if (hipGetDevice(&dev) != hipSuccess || hipDeviceGetAttribute(&cus, hipDeviceAttributeMultiprocessorCount, dev) != hipSuccess) { grid = -1; return; }
        if (hipFuncSetAttribute((const void*)fwd_kernel, hipFuncAttributeMaxDynamicSharedMemorySize, LDS_BYTES) != hipSuccess) { fprintf(stderr, "kernel_launch: hipFuncSetAttribute failed\n"); grid = -1; return; }
        if (hipOccupancyMaxActiveBlocksPerMultiprocessor(&per_cu, (const void*)fwd_kernel, NTHR, LDS_BYTES) != hipSuccess || per_cu < 1) fprintf(stderr, "kernel_launch: occupancy query says %d\n", per_cu);
        (void)hipGetLastError();
        grid = cus;
    }
    if (grid < 0) return;
    if (hipMemsetAsync((char*)d_ws + WS_CTL, 0, CTL_ZERO_BYTES, stream) != hipSuccess) return;
    Args a{};
    for (int i = 0; i < 23; ++i) a.in[i] = (const float*)d_in[i];
    a.out = (float*)d_out; a.ws = (unsigned char*)d_ws;
#if defined(PROBE_PHASE)
    a.ph_lo = 0; a.ph_hi = PROBE_PHASE + 1; a.li = 0; hipLaunchKernelGGL(fwd_kernel, dim3(grid), dim3(NTHR), LDS_BYTES, stream, a);
    a.ph_lo = PROBE_PHASE; a.ph_hi = PROBE_PHASE + 1; a.li = 1; hipLaunchKernelGGL(fwd_kernel, dim3(grid), dim3(NTHR), LDS_BYTES, stream, a);
    a.ph_lo = PROBE_PHASE + 1; a.ph_hi = NPHASES; a.li = 2; hipLaunchKernelGGL(fwd_kernel, dim3(grid), dim3(NTHR), LDS_BYTES, stream, a);
#elif N_LAUNCH_MODE == 1
    a.ph_lo = 0; a.ph_hi = NPHASES; a.li = 0;
    hipLaunchKernelGGL(fwd_kernel, dim3(grid), dim3(NTHR), LDS_BYTES, stream, a);
#else
    for (int p = 0; p < NPHASES; ++p) {
        const int l = p / NPH, s = p % NPH;
        if ((l & 1) == 0 && (s == 9 || s == 10)) continue;
        a.ph_lo = p; a.ph_hi = p + 1;
        hipLaunchKernelGGL(fwd_kernel, dim3(grid), dim3(NTHR), LDS_BYTES, stream, a);
    }
#endif
}
```

```cpp
#include <hip/hip_runtime.h>
#include <cstdio>
#include <cstdint>

#ifndef N_LAUNCH_MODE
#define N_LAUNCH_MODE 1
#endif

#ifndef PROBE_SPREAD
#define PROBE_SPREAD (-1)
#endif
#ifndef PROBE_STAMP
#define PROBE_STAMP (-1)
#endif
#ifndef PROBE_CLK
#define PROBE_CLK 0
#endif
#ifndef WGM_MOE
#define WGM_MOE 4
#endif
#ifndef WGM_DENSE
#define WGM_DENSE 4
#endif
#ifndef PROBE_DUP
#define PROBE_DUP 0
#endif
#define LAS __attribute__((address_space(3)))
typedef unsigned short bf16;
typedef short bf16x8 __attribute__((ext_vector_type(8)));
typedef float f32x4 __attribute__((ext_vector_type(4)));
typedef float f32x2 __attribute__((ext_vector_type(2)));
typedef unsigned u32x4 __attribute__((ext_vector_type(4)));
typedef unsigned u32x2 __attribute__((ext_vector_type(2)));

constexpr int D = 1024, NB = 32, SEQ = 2048, DEPTH = 4, NMETA = 16;
constexpr int M = NB * SEQ;
constexpr int NIN = 8208;
constexpr int N1 = 6400;
constexpr int DFF = 2816, DFFE = 3584, NEXP = 8, HFF = 1792;
constexpr float ALPHA = 1.681792830507429f;
constexpr float QSCALE = 0.08838834764831845f;
constexpr float LN_EPS = 1e-5f, GN_EPS = 1e-6f;
constexpr int NPH = 12;
constexpr int NPHASES = DEPTH * NPH;

constexpr size_t MiB = 1u << 20;
constexpr size_t WS_CTL = 0, CTL_ZERO_BYTES = 1 * MiB;
constexpr size_t WS_ROPE = 1 * MiB;
constexpr size_t WS_META = 3 * MiB;
constexpr size_t WS_MOE = 4 * MiB;
constexpr size_t WS_GA = 8 * MiB;
constexpr size_t WS_W = 12 * MiB;
constexpr size_t WS_HB = 204 * MiB;
constexpr size_t WS_Y3 = 332 * MiB;
constexpr size_t WS_HA = 460 * MiB;
constexpr size_t WS_QK = 588 * MiB;
constexpr size_t WS_V = 844 * MiB;
constexpr size_t WS_META2 = 1100 * MiB;
constexpr size_t WS_END = 1102 * MiB;
constexpr size_t W_B1 = 0;
constexpr size_t W_B2 = W_B1 + (size_t)N1 * D * 2;
constexpr size_t W_PA = W_B2 + (size_t)2048 * D * 2;
constexpr size_t W_PB = W_PA + (size_t)D * D * 2;
constexpr size_t W_O = W_PB + (size_t)D * D * 2;
constexpr size_t W_F = W_O + (size_t)D * D * 2;
constexpr size_t W_FD_DENSE = W_F + (size_t)2 * DFF * D * 2;
constexpr size_t W_FD_MOE = W_F + (size_t)NEXP * 2 * DFFE * D * 2;
static_assert(W_FD_MOE + (size_t)NEXP * 2 * D * HFF * 2 <= 192 * MiB, "weights fit");
constexpr size_t MT_HA = 0, MT_HB = 65536, MT_XB = 131072, MT_QK = 163840, MT_V = 229376, MT_SIG = 294912, MT_GA = 360448, MT_MRG = 364544,
                 MT_U = 397312  , MT_Y = 512000  , MT_TOK = 643072  , MT_O = 644096  ;
static_assert(MT_O + 65536 <= MiB, "meta map");
constexpr int CW_CNT = 1024;
constexpr int CW_BAR = 4096;

constexpr int RING_BYTES = 131072;
constexpr int LDS_BYTES = 147456;
constexpr int MISC_OFF = LDS_BYTES - 1024;
constexpr int NWAVES = 8, NTHR = 512;

__device__ __forceinline__ f32x4 zero_f4() { float z = 0.f; asm volatile("" : "+v"(z)); return (f32x4){z, z, z, z}; }
__device__ __forceinline__ u32x4 zero_u4() { unsigned z = 0u; asm volatile("" : "+v"(z)); return (u32x4){z, z, z, z}; }
__device__ __forceinline__ unsigned f2bf(float f) { unsigned u = __builtin_bit_cast(unsigned, f); return (u + 0x7fffu + ((u >> 16) & 1u)) >> 16; }
__device__ __forceinline__ float bf2f(unsigned h) { return __builtin_bit_cast(float, (h & 0xffffu) << 16); }
typedef __bf16 bf16x2_t __attribute__((ext_vector_type(2)));
__device__ __forceinline__ unsigned pk2(float lo, float hi) { const f32x2 v = {lo, hi}; return __builtin_bit_cast(unsigned, __builtin_convertvector(v, bf16x2_t)); }
__device__ __forceinline__ unsigned pk2_sw(float lo, float hi) { return pk2(lo, hi); }
__device__ __forceinline__ void store_bf4(bf16* p, f32x4 v) { u32x2 w; w.x = pk2(v[0], v[1]); w.y = pk2(v[2], v[3]); *(u32x2*)p = w; }
__device__ __forceinline__ f32x4 load_bf4(const bf16* p) { const u32x2 w = *(const u32x2*)p; return (f32x4){bf2f(w.x), bf2f(w.x >> 16), bf2f(w.y), bf2f(w.y >> 16)}; }
__device__ __forceinline__ void store_bf8(bf16* p, f32x4 lo, f32x4 hi) { u32x4 w; w.x = pk2(lo[0], lo[1]); w.y = pk2(lo[2], lo[3]); w.z = pk2(hi[0], hi[1]); w.w = pk2(hi[2], hi[3]); *(u32x4*)p = w; }
__device__ __forceinline__ void load_bf8(const bf16* p, f32x4& lo, f32x4& hi) { const u32x4 w = *(const u32x4*)p; lo = (f32x4){bf2f(w.x), bf2f(w.x >> 16), bf2f(w.y), bf2f(w.y >> 16)}; hi = (f32x4){bf2f(w.z), bf2f(w.z >> 16), bf2f(w.w), bf2f(w.w >> 16)}; }
__device__ __forceinline__ void unpack_bf8(const u32x4 w, f32x4& lo, f32x4& hi) { lo = (f32x4){bf2f(w.x), bf2f(w.x >> 16), bf2f(w.y), bf2f(w.y >> 16)}; hi = (f32x4){bf2f(w.z), bf2f(w.z >> 16), bf2f(w.w), bf2f(w.w >> 16)}; }
__device__ __forceinline__ float sigmoidf_(float x) { return __builtin_amdgcn_rcpf(1.0f + __expf(-x)); }
__device__ __forceinline__ float siluf_(float x) { return x * __builtin_amdgcn_rcpf(1.0f + __expf(-x)); }
template <int CTRL> __device__ __forceinline__ float dpp_f(float v) { return __builtin_bit_cast(float, __builtin_amdgcn_update_dpp(0, __builtin_bit_cast(int, v), CTRL, 0xF, 0xF, true)); }
__device__ __forceinline__ float wave_sum(float v) {
    v += dpp_f<0xB1>(v);
    v += dpp_f<0x4E>(v);
    v += dpp_f<0x141>(v);
    v += dpp_f<0x140>(v);
    const int iv = __builtin_bit_cast(int, v);
    const float r0 = __builtin_bit_cast(float, __builtin_amdgcn_readlane(iv, 0)), r1 = __builtin_bit_cast(float, __builtin_amdgcn_readlane(iv, 16)),
                r2 = __builtin_bit_cast(float, __builtin_amdgcn_readlane(iv, 32)), r3 = __builtin_bit_cast(float, __builtin_amdgcn_readlane(iv, 48));
    return (r0 + r1) + (r2 + r3);
}
__device__ __forceinline__ float sum8(float v) { v += dpp_f<0xB1>(v); v += dpp_f<0x4E>(v); v += dpp_f<0x141>(v); return v; }
#define LDS_WAIT() asm volatile("s_waitcnt lgkmcnt(0)" ::: "memory")
#define VM_WAIT() asm volatile("s_waitcnt vmcnt(0)" ::: "memory")

namespace pg8 {
constexpr int BM = 256, BK = 64, HALF = 128, HTB = HALF * BK * 2, STAGE_BYTES = 8 * HTB, NXCD = 8, IDX_OFF = STAGE_BYTES  ;
__host__ __device__ __forceinline__ int lds_byte(int r, int c) { const int st = (r >> 4) * 2 + (c >> 5), rr = r & 15, cc = c & 31, ob = rr * 64 + cc * 2; return st * 1024 + (ob ^ (((ob >> 9) & 1) << 5)); }
__host__ __device__ __forceinline__ void stage_rc(int b, int& R, int& C) { const int st = b / 1024, sb = b % 1024, swz = sb ^ (((sb >> 9) & 1) << 5); R = (st >> 1) * 16 + swz / 64; C = (st & 1) * 32 + (swz % 64) / 2; }

__host__ __device__ __forceinline__ int perm32(int rho) { const int n = rho >> 4, i = rho & 15; return 8 * (i >> 2) + 4 * n + (i & 3); }
struct Unit { const char* A; const char* B; int row0, col0, e, nvalid; };

__device__ __forceinline__ bool unit_order(long L, int nM, int nN, int& pm, int& pn, const int WGM) {
    const int nwg = nM * nN; if (L >= nwg) return false;
    int wgid = (int)L; { const int q = nwg / NXCD, r = nwg % NXCD, xcd = wgid % NXCD, off = wgid / NXCD; wgid = (xcd < r ? xcd * (q + 1) : r * (q + 1) + (xcd - r) * q) + off; }
    const int nig = WGM * nN, gid = wgid / nig, fm = gid * WGM, gsz = (nM - fm) < WGM ? (nM - fm) : WGM;
    pm = fm + ((wgid % nig) % gsz); pn = (wgid % nig) / gsz; return true;
}
struct SchedDense {
    static constexpr bool GATHER = false;
    int nM, nN, nwg, G, c; const char* A; const char* Bt; unsigned lda, ldb;
    __device__ void init(int Mr, int Nc, int G_, int c_, const void* A_, unsigned lda_, const void* Bt_, unsigned ldb_) { nM = Mr / BM; nN = Nc / BM; nwg = nM * nN; G = G_; c = c_; A = (const char*)A_; Bt = (const char*)Bt_; lda = lda_; ldb = ldb_; }
    __device__ bool next(int i, Unit& u) const {
        int pm, pn; if (!unit_order((long)i * G + c, nM, nN, pm, pn, WGM_DENSE)) return false;
        u.A = A + (size_t)pm * BM * lda; u.B = Bt + (size_t)pn * BM * ldb; u.row0 = pm * BM; u.col0 = pn * BM; u.e = 0; u.nvalid = BM; return true;
    }
    __device__ __forceinline__ unsigned a_off(const Unit&, int R, int h) const { return (unsigned)(h * HALF + R) * lda; }
};

template <class F> struct EpiEl {
    static constexpr bool PERM = false;
    F f;
    template <int MODE> __device__ __forceinline__ void loop(const f32x4 (&acc)[2][2][4][2], const Unit& u, int wr, int wc, int fr, int fq) const {
#pragma unroll
        for (int ai = 0; ai < 2; ++ai)
#pragma unroll
            for (int m = 0; m < 4; ++m) { const int r = ai * HALF + wr * 64 + m * 16 + fr;
#pragma unroll
                for (int bj = 0; bj < 2; ++bj)
#pragma unroll
                    for (int n = 0; n < 2; ++n) f.template at<MODE>(u, r, bj * HALF + wc * 32 + n * 16 + 4 * fq, acc[ai][bj][m][n]);
                if (m == 3) asm volatile("" ::: "memory"); }
    }
    __device__ __forceinline__ void operator()(const f32x4 (&acc)[2][2][4][2], const Unit& u, int wr, int wc, int fr, int fq) const {
        if constexpr (F::NMODES == 1) loop<0>(acc, u, wr, wc, fr, fq);
        else {
            const int mode = __builtin_amdgcn_readfirstlane(f.mode(u));
            if (mode == 0) loop<0>(acc, u, wr, wc, fr, fq);
            else if (mode == 1) loop<1>(acc, u, wr, wc, fr, fq);
            else if (mode == 2) loop<2>(acc, u, wr, wc, fr, fq);
            else if (mode == 3) loop<3>(acc, u, wr, wc, fr, fq);
            else loop<4>(acc, u, wr, wc, fr, fq);
        }
    }
};

template <class F> struct EpiRow {
    static constexpr bool PERM = true;
    F f;
    template <int MODE> __device__ __forceinline__ void loop(const f32x4 (&acc)[2][2][4][2], const Unit& u, int wr, int wc, int fr, int fq) const {
#pragma unroll
        for (int ai = 0; ai < 2; ++ai)
#pragma unroll
            for (int m = 0; m < 4; ++m) { f.template row<MODE>(u, ai * HALF + wr * 64 + m * 16 + fr, wc * 32 + 8 * fq, acc[ai][0][m][0], acc[ai][0][m][1], acc[ai][1][m][0], acc[ai][1][m][1]);
                if (m == 3) asm volatile("" ::: "memory"); }
    }
    __device__ __forceinline__ void operator()(const f32x4 (&acc)[2][2][4][2], const Unit& u, int wr, int wc, int fr, int fq) const {
        if constexpr (F::NMODES == 1) loop<0>(acc, u, wr, wc, fr, fq);
        else {
            const int mode = __builtin_amdgcn_readfirstlane(f.mode(u));
            if (mode == 0) loop<0>(acc, u, wr, wc, fr, fq);
            else if (mode == 1) loop<1>(acc, u, wr, wc, fr, fq);
            else if (mode == 2) loop<2>(acc, u, wr, wc, fr, fq);
            else if (mode == 3) loop<3>(acc, u, wr, wc, fr, fq);
            else loop<4>(acc, u, wr, wc, fr, fq);
        }
    }
};

template <class F> struct EpiRowLd {
    static constexpr bool PERM = true;
    F f;
    __device__ __forceinline__ void operator()(const f32x4 (&acc)[2][2][4][2], const Unit& u, int wr, int wc, int fr, int fq) const {
        const int c8 = wc * 32 + 8 * fq;
#pragma unroll
        for (int g0 = 0; g0 < 8; g0 += F::BATCH) {
            u32x4 pre[F::BATCH][F::NPRE];
#pragma unroll
            for (int g = 0; g < F::BATCH; ++g) { const int ai = (g0 + g) >> 2, m = (g0 + g) & 3; f.ld(u, ai * HALF + wr * 64 + m * 16 + fr, c8, pre[g]); }
            asm volatile("" ::: "memory");
#pragma unroll
            for (int g = 0; g < F::BATCH; ++g) { const int ai = (g0 + g) >> 2, m = (g0 + g) & 3;
                f.fin(u, ai * HALF + wr * 64 + m * 16 + fr, c8, pre[g], acc[ai][0][m][0], acc[ai][0][m][1], acc[ai][1][m][0], acc[ai][1][m][1]); }
            asm volatile("" ::: "memory");
        }
    }
};

template <class Epi, class Sched, bool ALIGN_EPI = true>
__device__ __forceinline__ void gemm_phase(LAS unsigned char* lds, const int tid, const Sched& S, const Epi& E, const int K, const unsigned lda, const unsigned ldb) {
    const int wid = __builtin_amdgcn_readfirstlane(tid >> 6), lane = tid & 63, wr = wid >> 2, wc = wid & 3, fr = lane & 15, fq = lane >> 4;
    const int nt = K / BK;
    int Rr[2], Cc[2]; unsigned voffA[2], voffB[2];
#pragma unroll
    for (int i = 0; i < 2; ++i) { int R, C; stage_rc(tid * 16 + i * 8192, R, C); Rr[i] = R; Cc[i] = C; const int Rb = Epi::PERM ? ((R & ~31) + perm32(R & 31)) : R; voffA[i] = (unsigned)R * lda + (unsigned)C * 2u; voffB[i] = (unsigned)Rb * ldb + (unsigned)C * 2u; }
    const size_t kstep = (size_t)(BK * 2);
    const size_t hstepA = (size_t)HALF * lda, hstepB = (size_t)HALF * ldb;
    const unsigned ldsw = (unsigned)wid * 1024u;
    const int aoff = lds_byte(wr * 64 + fr, fq * 8), boff = lds_byte(wc * 32 + fr, fq * 8);
#define PG8_SA(b, h) (((b) * 2 + (h)) * HTB)
#define PG8_SB(b, h) ((4 + (b) * 2 + (h)) * HTB)
#define PG8_STAGE_B(bufoff, gbase) do { _Pragma("unroll") for (int _i = 0; _i < 2; ++_i) \
        __builtin_amdgcn_global_load_lds((const unsigned*)((const char*)(gbase) + voffB[_i]), (LAS unsigned*)(lds + (bufoff) + ldsw + _i * 8192), 16, 0, 0); } while (0)
#define PG8_STAGE_A(bufoff, gbase, h, ox) do { _Pragma("unroll") for (int _i = 0; _i < 2; ++_i) { \
        const char* _p = Sched::GATHER ? ((const char*)(gbase) + (ox)[h][_i]) : ((const char*)(gbase) + (h) * hstepA + voffA[_i]); \
        __builtin_amdgcn_global_load_lds((const unsigned*)_p, (LAS unsigned*)(lds + (bufoff) + ldsw + _i * 8192), 16, 0, 0); } } while (0)
#define PG8_LDA(dst, b, h) do { _Pragma("unroll") for (int m = 0; m < 4; ++m) _Pragma("unroll") for (int k = 0; k < 2; ++k) dst[m][k] = *(const LAS bf16x8*)(lds + PG8_SA(b, h) + aoff + m * 2048 + k * 1024); } while (0)
#define PG8_LDB(dst, b, h) do { _Pragma("unroll") for (int n = 0; n < 2; ++n) _Pragma("unroll") for (int k = 0; k < 2; ++k) dst[n][k] = *(const LAS bf16x8*)(lds + PG8_SB(b, h) + boff + n * 2048 + k * 1024); } while (0)
#define PG8_MMA(ai, bj, At, Bt) do { __builtin_amdgcn_s_setprio(1); _Pragma("unroll") for (int m = 0; m < 4; ++m) _Pragma("unroll") for (int n = 0; n < 2; ++n) _Pragma("unroll") for (int k = 0; k < 2; ++k) \
        acc[ai][bj][m][n] = __builtin_amdgcn_mfma_f32_16x16x32_bf16(Bt[n][k], At[m][k], acc[ai][bj][m][n], 0, 0, 0); __builtin_amdgcn_s_setprio(0); } while (0)
#define PG8_WAIT_V(n) asm volatile("s_waitcnt vmcnt(" #n ")" ::: "memory")
#define PG8_WAIT_L(n) asm volatile("s_waitcnt lgkmcnt(" #n ")" ::: "memory")
#define PG8_BAR __builtin_amdgcn_s_barrier()
#define PG8_SCHED __builtin_amdgcn_sched_barrier(0)
    Unit cur, nxt; int ui = 0;
    if (!S.next(0, cur)) return;
    f32x4 acc[2][2][4][2];
    float zf_ = 0.f; asm volatile("" : "+v"(zf_));
#pragma unroll
    for (int a = 0; a < 2; ++a)
#pragma unroll
        for (int b = 0; b < 2; ++b)
#pragma unroll
            for (int m = 0; m < 4; ++m)
#pragma unroll
                for (int n = 0; n < 2; ++n) acc[a][b][m][n] = (f32x4){zf_, zf_, zf_, zf_};
    bf16x8 At[4][2], B0[2][2], B1[2][2];
    unsigned oc[2][2];
#pragma unroll
    for (int h = 0; h < 2; ++h)
#pragma unroll
        for (int i = 0; i < 2; ++i) oc[h][i] = Sched::GATHER ? (S.a_off(cur, Rr[i], h) + (unsigned)Cc[i] * 2u) : 0u;
    const char* cA = cur.A; const char* cB = cur.B;
    PG8_STAGE_B(PG8_SB(0, 0), cB); PG8_STAGE_B(PG8_SB(0, 1), cB + hstepB); PG8_STAGE_A(PG8_SA(0, 0), cA, 0, oc); PG8_STAGE_A(PG8_SA(0, 1), cA, 1, oc);
    if (wr == 1) PG8_BAR;
    PG8_WAIT_V(2); PG8_BAR;
    PG8_STAGE_B(PG8_SB(1, 0), cB + kstep); PG8_STAGE_A(PG8_SA(1, 0), cA + kstep, 0, oc); PG8_STAGE_B(PG8_SB(1, 1), cB + hstepB + kstep);
    PG8_WAIT_V(6); PG8_BAR;
    for (;;) {
        const bool has_next = S.next(ui + 1, nxt);
        const char* nA = has_next ? nxt.A : cA; const char* nB = has_next ? nxt.B : cB;
        if constexpr (Sched::GATHER) {
            if (has_next && wid == 0)
                __builtin_amdgcn_global_load_lds((const unsigned*)(S.idx_base(nxt) + lane * 4), (LAS unsigned*)(lds + IDX_OFF), 16, 0, 0);
        }
        for (int t = 0; t < nt; t += 2) {
            const bool last = (t == nt - 2);
            const char* a1 = cA + (size_t)(t + 1) * kstep;
            const char* a2 = last ? nA : cA + (size_t)(t + 2) * kstep; const char* b2 = last ? nB : cB + (size_t)(t + 2) * kstep;
            const char* a3 = a2 + kstep; const char* b3 = b2 + kstep;
            PG8_LDB(B0, 0, 0); PG8_LDB(B1, 0, 1); PG8_SCHED; PG8_LDA(At, 0, 0); PG8_STAGE_A(PG8_SA(1, 1), a1, 1, oc);
            if constexpr (Sched::GATHER) { if (last && has_next) {
#pragma unroll
                for (int h = 0; h < 2; ++h)
#pragma unroll
                    for (int i = 0; i < 2; ++i) { const int rt = h * HALF + Rr[i]; const unsigned tok = *(const LAS unsigned*)(lds + IDX_OFF + (S.row_ok(nxt, rt) ? rt : 0) * 4);
                        oc[h][i] = tok * lda + (unsigned)Cc[i] * 2u; } } }
            PG8_WAIT_V(8); PG8_WAIT_L(0); PG8_BAR; PG8_MMA(0, 0, At, B0); PG8_MMA(0, 1, At, B1); PG8_BAR; PG8_SCHED;
            PG8_LDA(At, 0, 1); PG8_STAGE_B(PG8_SB(0, 0), b2); PG8_STAGE_B(PG8_SB(0, 1), b2 + hstepB); PG8_STAGE_A(PG8_SA(0, 0), a2, 0, oc);
            PG8_WAIT_V(8); PG8_WAIT_L(0); PG8_BAR; PG8_MMA(1, 0, At, B0); PG8_MMA(1, 1, At, B1); PG8_BAR; PG8_SCHED;
            PG8_LDB(B0, 1, 0); PG8_LDB(B1, 1, 1); PG8_SCHED; PG8_LDA(At, 1, 0); PG8_STAGE_A(PG8_SA(0, 1), a2, 1, oc);
            PG8_WAIT_V(8); PG8_WAIT_L(0); PG8_BAR; PG8_MMA(0, 0, At, B0); PG8_MMA(0, 1, At, B1); PG8_BAR; PG8_SCHED;
            PG8_LDA(At, 1, 1); PG8_STAGE_B(PG8_SB(1, 0), b3); PG8_STAGE_B(PG8_SB(1, 1), b3 + hstepB); PG8_STAGE_A(PG8_SA(1, 0), a3, 0, oc);
            PG8_WAIT_V(8); PG8_WAIT_L(0); PG8_BAR; PG8_MMA(1, 0, At, B0); PG8_MMA(1, 1, At, B1); PG8_BAR; PG8_SCHED;
        }
        if constexpr (ALIGN_EPI) { if (wr == 0) PG8_BAR; }
        E(acc, cur, wr, wc, fr, fq);
        if (!has_next) break;
#pragma unroll
        for (int a = 0; a < 2; ++a)
#pragma unroll
            for (int b = 0; b < 2; ++b)
#pragma unroll
                for (int m = 0; m < 4; ++m)
#pragma unroll
                    for (int n = 0; n < 2; ++n) acc[a][b][m][n] = (f32x4){zf_, zf_, zf_, zf_};
        cur = nxt; cA = nA; cB = nB; ++ui;
        if constexpr (ALIGN_EPI) { if (wr == 1) PG8_BAR; }
    }
    PG8_WAIT_V(0);
    if constexpr (!ALIGN_EPI) { if (wr == 0) PG8_BAR; }
    PG8_BAR;
#undef PG8_SA
#undef PG8_SB
#undef PG8_STAGE_A
#undef PG8_STAGE_B
#undef PG8_LDA
#undef PG8_LDB
#undef PG8_MMA
#undef PG8_WAIT_V
#undef PG8_WAIT_L
#undef PG8_BAR
#undef PG8_SCHED
}
}

#define XB_TMO      128
#define XB_XCNT(j)  (256  + 64 * (j))
#define XB_XSUB(j)  (1280 + 64 * (j))
#define XB_XGEN(j)  (2304 + 64 * (j))
#define XB_TOP      3328
#define XB_TOPGEN   3392
#define XCD_BAR_WORDS 3456
#define XB_SPIN_CAP (1u << 18)
__device__ __forceinline__ unsigned xb_ld(unsigned* p)              { return __hip_atomic_load(p, __ATOMIC_RELAXED, __HIP_MEMORY_SCOPE_AGENT); }
__device__ __forceinline__ unsigned xb_add(unsigned* p, unsigned v) { return __hip_atomic_fetch_add(p, v, __ATOMIC_RELAXED, __HIP_MEMORY_SCOPE_AGENT); }
__device__ __forceinline__ unsigned xb_xcc_id() { return (unsigned)__builtin_amdgcn_s_getreg((3 << 11) | 20) & 0xFu; }
#define XB_SPIN(cond, bar) do { unsigned _sp = 0; while (cond) { __builtin_amdgcn_s_sleep(1); \
    if ((++_sp & 255u) == 0u) { if (xb_ld(&(bar)[XB_TMO])) break; if (_sp > XB_SPIN_CAP) { atomicAdd(&(bar)[XB_TMO], 1u); break; } } } } while (0)
__device__ __forceinline__ int tid_from_wave(int wv) { int x; asm volatile("v_mbcnt_lo_u32_b32 %0, -1, 0\n\tv_mbcnt_hi_u32_b32 %0, -1, %0" : "=v"(x)); return (wv << 6) | x; }
struct XcdBarrier { unsigned* bar; unsigned x; volatile LAS unsigned* st; int tid; };
__device__ __forceinline__ XcdBarrier xcd_barrier_post(unsigned* bar, volatile LAS unsigned* st, int tid) {
    XcdBarrier b; b.bar = bar; b.x = xb_xcc_id(); b.st = st; b.tid = tid;
    if (tid == 0) (void)xb_add(&bar[XB_XCNT(b.x)], 1u);
    return b;
}
__device__ __forceinline__ void xcd_barrier_complete(unsigned* bar, unsigned x, unsigned& nloc, unsigned& nx) {
    const unsigned G = gridDim.x * gridDim.y * gridDim.z;
    unsigned sum, cnt, mine, sp = 0u;
    for (;;) {
        sum = 0u; cnt = 0u; mine = 0u;
#pragma unroll
        for (unsigned j = 0; j < 16; ++j) { const unsigned c = xb_ld(&bar[XB_XCNT(j)]); sum += c; cnt += (c > 0u) ? 1u : 0u; mine = (j == x) ? c : mine; }
        if (sum == G) break;
        __builtin_amdgcn_s_sleep(1);
        if ((++sp & 255u) == 0u) { if (xb_ld(&bar[XB_TMO])) break; if (sp > XB_SPIN_CAP) { atomicAdd(&bar[XB_TMO], 1u); break; } }
    }
    nloc = mine > 0u ? mine : 1u; nx = cnt > 0u ? cnt : 1u;
}
__device__ __forceinline__ void xcd_barrier(const XcdBarrier& b) {
    asm volatile("s_waitcnt vmcnt(0)" ::: "memory");
    __syncthreads();
    if (b.tid == 0) {
        unsigned* bar = b.bar;
        __builtin_amdgcn_s_waitcnt(0);
        unsigned nloc = b.st[0], nx = b.st[1];
        if (nloc == 0u) { xcd_barrier_complete(bar, b.x, nloc, nx); b.st[0] = nloc; b.st[1] = nx; }
        const unsigned old = xb_add(&bar[XB_XSUB(b.x)], 1u);
        const unsigned gen = old / nloc;
        if (old + 1u == (gen + 1u) * nloc) {
            __builtin_amdgcn_fence(__ATOMIC_RELEASE, "agent");
            asm volatile("s_waitcnt vmcnt(0)" ::: "memory");
            const unsigned og = xb_add(&bar[XB_TOP], 1u);
            const unsigned tg = og / nx;
            if (og + 1u == (tg + 1u) * nx) xb_add(&bar[XB_TOPGEN], 1u);
            else XB_SPIN(xb_ld(&bar[XB_TOPGEN]) == tg, bar);
            __builtin_amdgcn_fence(__ATOMIC_ACQUIRE, "agent");
            xb_add(&bar[XB_XGEN(b.x)], 1u);
            asm volatile("s_waitcnt vmcnt(0)" ::: "memory");
        } else {
            XB_SPIN(xb_ld(&bar[XB_XGEN(b.x)]) == gen, bar);
            __builtin_amdgcn_fence(__ATOMIC_ACQUIRE, "agent");
            asm volatile("s_waitcnt vmcnt(0)" ::: "memory");
        }
    }
    __syncthreads();
}

struct Args { const float* in[23]; float* out; unsigned char* ws; int ph_lo, ph_hi, li, pad; };
enum { I_X = 0, I_META, I_WIN, I_BGATE, I_WA2, I_BA, I_GNG, I_RNG, I_RNB, I_WPA, I_WPB, I_WO, I_LN1G, I_LN1B, I_FG, I_FU, I_FD, I_RT, I_MG, I_MU, I_MD, I_LN2G, I_LN2B };

struct Frame {
    LAS unsigned char* lds; volatile LAS unsigned* MISC; unsigned* ctl;
    int tid, lane, wave, G, bid, gtid, gthreads, gwave, gwaves;
    unsigned char* ws;
};

template <class AR, class BC, class FM>
__device__ __forceinline__ void meta_gemm(const Frame& Fr, int nouter, int ncols, int K, AR arow, BC bcol, FM fmk) {
    const int ntile = ncols >> 4, ntask = nouter * ntile, kw = K >> 3;
    const int lane = Fr.lane, l16 = lane & 15, quad = lane >> 4;
    LAS f32x4* part = (LAS f32x4*)Fr.lds;
#pragma unroll 1
    for (int rep = (PROBE_DUP & 1) ? 0 : 1; rep < 2; ++rep)
#pragma unroll 1
    for (int task = Fr.bid; task < ntask; task += Fr.G) {
        const int o = task / ntile, c0 = (task - o * ntile) * 16;
        const bf16* ap = arow(o, l16) + Fr.wave * kw + 8 * quad; const bf16* bp = bcol(o, c0 + l16) + Fr.wave * kw + 8 * quad;
        f32x4 acc = zero_f4();
        for (int k = 0; k < kw; k += 32) { const bf16x8 av = *(const bf16x8*)(ap + k), bv = *(const bf16x8*)(bp + k); acc = __builtin_amdgcn_mfma_f32_16x16x32_bf16(bv, av, acc, 0, 0, 0); }
        part[Fr.wave * 64 + lane] = acc;
        __syncthreads();
        if (Fr.wave == 0) {
            f32x4 t = part[lane];
#pragma unroll
            for (int w = 1; w < 8; ++w) t = t + part[w * 64 + lane];
            if (rep == 1) {
                auto f = fmk(o);
                pg8::Unit u; u.A = nullptr; u.B = nullptr; u.row0 = 0; u.col0 = c0 & ~255; u.e = 0; u.nvalid = 16;
                const int cc = (c0 & 255) + 4 * quad;
                if constexpr (decltype(f)::NMODES == 1) f.template at<0>(u, l16, cc, t);
                else { const int mode = f.mode(u);
                    if (mode == 0) f.template at<0>(u, l16, cc, t); else if (mode == 1) f.template at<1>(u, l16, cc, t); else if (mode == 2) f.template at<2>(u, l16, cc, t);
                    else if (mode == 3) f.template at<3>(u, l16, cc, t); else f.template at<4>(u, l16, cc, t); }
            }
        }
        __syncthreads();
    }
}

template <class AR, class BC, class FM>
__device__ __forceinline__ void meta_gemm_pair(const Frame& Fr, int nouter, int nff, int K, AR arow, BC bcol, FM fmk) {
    const int ntile = nff >> 4, ntask = nouter * ntile, kw = K >> 3;
    const int lane = Fr.lane, l16 = lane & 15, quad = lane >> 4;
    LAS f32x4* part = (LAS f32x4*)Fr.lds;
#pragma unroll 1
    for (int rep = (PROBE_DUP & 1) ? 0 : 1; rep < 2; ++rep)
#pragma unroll 1
    for (int task = Fr.bid; task < ntask; task += Fr.G) {
        const int o = task / ntile, f0 = (task - o * ntile) * 16, wrow = 256 * (f0 >> 7) + (f0 & 127);
        const bf16* ap = arow(o, l16) + Fr.wave * kw + 8 * quad; const bf16* bp = bcol(o, wrow + l16) + Fr.wave * kw + 8 * quad; const bf16* bp2 = bp + (size_t)128 * K;
        f32x4 ag = zero_f4(), au = ag;
        for (int k = 0; k < kw; k += 32) { const bf16x8 av = *(const bf16x8*)(ap + k), bg = *(const bf16x8*)(bp + k), bu = *(const bf16x8*)(bp2 + k);
            ag = __builtin_amdgcn_mfma_f32_16x16x32_bf16(bg, av, ag, 0, 0, 0); au = __builtin_amdgcn_mfma_f32_16x16x32_bf16(bu, av, au, 0, 0, 0); }
        part[Fr.wave * 64 + lane] = ag; part[512 + Fr.wave * 64 + lane] = au;
        __syncthreads();
        if (Fr.wave == 0) {
            f32x4 tg = part[lane], tu = part[512 + lane];
#pragma unroll
            for (int w = 1; w < 8; ++w) { tg = tg + part[w * 64 + lane]; tu = tu + part[512 + w * 64 + lane]; }
            if (rep == 1) { auto f = fmk(o); f.pair(l16, f0 + 4 * quad, tg, tu); }
        }
        __syncthreads();
    }
}

struct F1 {
    static constexpr int NMODES = 5;
    bf16* QK; bf16* V; bf16* SIG; float* GA; const f32x2* rope; const float* bg; int posmask, posbase;
    __device__ __forceinline__ int mode(const pg8::Unit& u) const { const int c = u.col0; return c < 1024 ? 0 : (c < 2048 ? 1 : (c < 4096 ? 2 : (c < 6144 ? 3 : 4))); }
    template <int MODE> __device__ __forceinline__ void at(const pg8::Unit& u, int r, int c, f32x4 v) const {
        const int row = u.row0 + r, col = u.col0 + c;
        if (MODE == 0) { const float s = col < 512 ? QSCALE : 1.f; store_bf4(QK + (size_t)row * 2048 + col, v * s); }
        else if (MODE == 1) {
            const int j = (col - 1024) & 127, pos = (row & posmask) + posbase; const f32x2 c0 = rope[pos * 64 + (j >> 1)], c1 = rope[pos * 64 + (j >> 1) + 1];
            const float s = col >= 1536 ? QSCALE : 1.f;
            f32x4 o; o[0] = (v[0] * c0.x - v[1] * c0.y) * s; o[1] = (v[0] * c0.y + v[1] * c0.x) * s; o[2] = (v[2] * c1.x - v[3] * c1.y) * s; o[3] = (v[2] * c1.y + v[3] * c1.x) * s;
            store_bf4(QK + (size_t)row * 2048 + col, o);
        }
        else if (MODE == 2) store_bf4(V + (size_t)row * 2048 + (col - 2048), v);
        else if (MODE == 3) { const int cc = col - 4096; const f32x4 b = *(const f32x4*)(bg + cc);
            f32x4 o; o[0] = sigmoidf_(v[0] + b[0]); o[1] = sigmoidf_(v[1] + b[1]); o[2] = sigmoidf_(v[2] + b[2]); o[3] = sigmoidf_(v[3] + b[3]);
            store_bf4(SIG + (size_t)row * 2048 + cc, o); }
        else { if (col < 6160) *(f32x4*)(GA + (size_t)row * 16 + (col - 6144)) = v; }
    }
    template <int MODE> __device__ __forceinline__ void half8(int row, int col, f32x4 lo, f32x4 hi) const {
        if (MODE == 0) { const float s = col < 512 ? QSCALE : 1.f; store_bf8(QK + (size_t)row * 2048 + col, lo * s, hi * s); }
        else if (MODE == 1) {
            const int j = (col - 1024) & 127, pos = (row & posmask) + posbase; const f32x4* rp = (const f32x4*)(rope + pos * 64 + (j >> 1)); const f32x4 t0 = rp[0], t1 = rp[1];
            const float s = col >= 1536 ? QSCALE : 1.f;
            f32x4 o0, o1;
            o0[0] = (lo[0] * t0[0] - lo[1] * t0[1]) * s; o0[1] = (lo[0] * t0[1] + lo[1] * t0[0]) * s; o0[2] = (lo[2] * t0[2] - lo[3] * t0[3]) * s; o0[3] = (lo[2] * t0[3] + lo[3] * t0[2]) * s;
            o1[0] = (hi[0] * t1[0] - hi[1] * t1[1]) * s; o1[1] = (hi[0] * t1[1] + hi[1] * t1[0]) * s; o1[2] = (hi[2] * t1[2] - hi[3] * t1[3]) * s; o1[3] = (hi[2] * t1[3] + hi[3] * t1[2]) * s;
            store_bf8(QK + (size_t)row * 2048 + col, o0, o1);
        }
        else if (MODE == 2) store_bf8(V + (size_t)row * 2048 + (col - 2048), lo, hi);
        else if (MODE == 3) { const int cc = col - 4096; const f32x4 b0 = *(const f32x4*)(bg + cc), b1 = *(const f32x4*)(bg + cc + 4);
            f32x4 o0, o1;
#pragma unroll
            for (int i = 0; i < 4; ++i) { o0[i] = sigmoidf_(lo[i] + b0[i]); o1[i] = sigmoidf_(hi[i] + b1[i]); }
            store_bf8(SIG + (size_t)row * 2048 + cc, o0, o1); }
        else { if (col < 6160) { *(f32x4*)(GA + (size_t)row * 16 + (col - 6144)) = lo; *(f32x4*)(GA + (size_t)row * 16 + (col - 6144) + 4) = hi; } }
    }
    template <int MODE> __device__ __forceinline__ void row(const pg8::Unit& u, int r, int c8, f32x4 a0, f32x4 a1, f32x4 b0, f32x4 b1) const {
        half8<MODE>(u.row0 + r, u.col0 + c8, a0, a1); half8<MODE>(u.row0 + r, u.col0 + 128 + c8, b0, b1);
    }
};
struct F2 {
    static constexpr int NMODES = 1;
    const bf16* O; bf16* V;
    template <int MODE> __device__ __forceinline__ void at(const pg8::Unit& u, int r, int c, f32x4 v) const {
        const size_t off = (size_t)(u.row0 + r) * 2048 + u.col0 + c; bf16* p = V + off; const f32x4 o = load_bf4(O + off);
        f32x4 w; w[0] = siluf_(v[0]) * o[0]; w[1] = siluf_(v[1]) * o[1]; w[2] = siluf_(v[2]) * o[2]; w[3] = siluf_(v[3]) * o[3];
        store_bf4(p, w);
    }
    __device__ __forceinline__ void half8(size_t off, f32x4 lo, f32x4 hi) const {
        f32x4 o0, o1; load_bf8(O + off, o0, o1);
#pragma unroll
        for (int i = 0; i < 4; ++i) { o0[i] *= siluf_(lo[i]); o1[i] *= siluf_(hi[i]); }
        store_bf8(V + off, o0, o1);
    }
    template <int MODE> __device__ __forceinline__ void row(const pg8::Unit& u, int r, int c8, f32x4 a0, f32x4 a1, f32x4 b0, f32x4 b1) const {
        const size_t off = (size_t)(u.row0 + r) * 2048 + u.col0 + c8; half8(off, a0, a1); half8(off + 128, b0, b1);
    }
    static constexpr int NPRE = 2, BATCH = 2;
    __device__ __forceinline__ void ld(const pg8::Unit& u, int r, int c8, u32x4 (&p)[2]) const { const size_t off = (size_t)(u.row0 + r) * 2048 + u.col0 + c8; p[0] = *(const u32x4*)(O + off); p[1] = *(const u32x4*)(O + off + 128); }
    __device__ __forceinline__ void fin(const pg8::Unit& u, int r, int c8, const u32x4 (&p)[2], f32x4 a0, f32x4 a1, f32x4 b0, f32x4 b1) const {
        const size_t off = (size_t)(u.row0 + r) * 2048 + u.col0 + c8; f32x4 o0, o1, o2, o3; unpack_bf8(p[0], o0, o1); unpack_bf8(p[1], o2, o3);
#pragma unroll
        for (int i = 0; i < 4; ++i) { o0[i] *= siluf_(a0[i]); o1[i] *= siluf_(a1[i]); o2[i] *= siluf_(b0[i]); o3[i] *= siluf_(b1[i]); }
        store_bf8(V + off, o0, o1); store_bf8(V + off + 128, o2, o3);
    }
};
struct F3 {
    static constexpr int NMODES = 1;
    bf16* MRG; const bf16* SIG; int second0;
    template <int MODE> __device__ __forceinline__ void at(const pg8::Unit& u, int r, int c, f32x4 v) const {
        const int second = second0 | u.e; const int row = u.row0 + r, col = u.col0 + c; bf16* p = MRG + (size_t)row * 1024 + col;
        const f32x4 g = load_bf4(SIG + (size_t)row * 2048 + second * 1024 + col); f32x4 o = g * v;
        if (second) o = o + load_bf4(p);
        store_bf4(p, o);
    }
    __device__ __forceinline__ void half8(int second, int row, int col, f32x4 lo, f32x4 hi) const {
        bf16* p = MRG + (size_t)row * 1024 + col; f32x4 g0, g1; load_bf8(SIG + (size_t)row * 2048 + second * 1024 + col, g0, g1);
        f32x4 o0 = g0 * lo, o1 = g1 * hi;
        if (second) { f32x4 m0, m1; load_bf8(p, m0, m1); o0 = o0 + m0; o1 = o1 + m1; }
        store_bf8(p, o0, o1);
    }
    template <int MODE> __device__ __forceinline__ void row(const pg8::Unit& u, int r, int c8, f32x4 a0, f32x4 a1, f32x4 b0, f32x4 b1) const {
        const int second = second0 | u.e; half8(second, u.row0 + r, u.col0 + c8, a0, a1); half8(second, u.row0 + r, u.col0 + 128 + c8, b0, b1);
    }
    static constexpr int NPRE = 4, BATCH = 1;
    __device__ __forceinline__ void ld(const pg8::Unit& u, int r, int c8, u32x4 (&p)[4]) const {
        const int second = second0 | u.e; const int row = u.row0 + r, col = u.col0 + c8; const bf16* sg = SIG + (size_t)row * 2048 + second * 1024 + col; const bf16* mp = MRG + (size_t)row * 1024 + col;
        p[0] = *(const u32x4*)sg; p[1] = *(const u32x4*)(sg + 128);
        if (second) { p[2] = *(const u32x4*)mp; p[3] = *(const u32x4*)(mp + 128); } else { p[2] = p[0]; p[3] = p[1]; }
    }
    __device__ __forceinline__ void fin(const pg8::Unit& u, int r, int c8, const u32x4 (&p)[4], f32x4 a0, f32x4 a1, f32x4 b0, f32x4 b1) const {
        const int second = second0 | u.e; const int row = u.row0 + r, col = u.col0 + c8; bf16* mp = MRG + (size_t)row * 1024 + col;
        f32x4 g0, g1, g2, g3, m0, m1, m2, m3; unpack_bf8(p[0], g0, g1); unpack_bf8(p[1], g2, g3); unpack_bf8(p[2], m0, m1); unpack_bf8(p[3], m2, m3);
        f32x4 o0 = g0 * a0, o1 = g1 * a1, o2 = g2 * b0, o3 = g3 * b1;
        if (second) { o0 = o0 + m0; o1 = o1 + m1; o2 = o2 + m2; o3 = o3 + m3; }
        store_bf8(mp, o0, o1); store_bf8(mp + 128, o2, o3);
    }
};
struct F4 {
    static constexpr int NMODES = 1;
    const bf16* RES; bf16* OUT;
    template <int MODE> __device__ __forceinline__ void at(const pg8::Unit& u, int r, int c, f32x4 v) const {
        const size_t o = (size_t)(u.row0 + r) * 1024 + u.col0 + c; store_bf4(OUT + o, load_bf4(RES + o) * ALPHA + v);
    }
    __device__ __forceinline__ void half8(size_t o, f32x4 lo, f32x4 hi) const { f32x4 r0, r1; load_bf8(RES + o, r0, r1); store_bf8(OUT + o, r0 * ALPHA + lo, r1 * ALPHA + hi); }
    template <int MODE> __device__ __forceinline__ void row(const pg8::Unit& u, int r, int c8, f32x4 a0, f32x4 a1, f32x4 b0, f32x4 b1) const {
        const size_t o = (size_t)(u.row0 + r) * 1024 + u.col0 + c8; half8(o, a0, a1); half8(o + 128, b0, b1);
    }
    static constexpr int NPRE = 2, BATCH = 2;
    __device__ __forceinline__ void ld(const pg8::Unit& u, int r, int c8, u32x4 (&p)[2]) const { const size_t o = (size_t)(u.row0 + r) * 1024 + u.col0 + c8; p[0] = *(const u32x4*)(RES + o); p[1] = *(const u32x4*)(RES + o + 128); }
    __device__ __forceinline__ void fin(const pg8::Unit& u, int r, int c8, const u32x4 (&p)[2], f32x4 a0, f32x4 a1, f32x4 b0, f32x4 b1) const {
        const size_t o = (size_t)(u.row0 + r) * 1024 + u.col0 + c8; f32x4 r0, r1, r2, r3; unpack_bf8(p[0], r0, r1); unpack_bf8(p[1], r2, r3);
        store_bf8(OUT + o, r0 * ALPHA + a0, r1 * ALPHA + a1); store_bf8(OUT + o + 128, r2 * ALPHA + b0, r3 * ALPHA + b1);
    }
};
struct F5 {
    static constexpr int NMODES = 1;
    bf16* U; int ldu;
    template <int MODE> __device__ __forceinline__ void row(const pg8::Unit& u, int r, int c8, f32x4 a0, f32x4 a1, f32x4 b0, f32x4 b1) const {
        f32x4 o0, o1;
#pragma unroll
        for (int i = 0; i < 4; ++i) { o0[i] = siluf_(a0[i]) * b0[i]; o1[i] = siluf_(a1[i]) * b1[i]; }
        store_bf8(U + (size_t)(u.row0 + r) * ldu + (u.col0 >> 1) + c8, o0, o1);
    }
    __device__ __forceinline__ void pair(int r, int f, f32x4 g, f32x4 uu) const {
        f32x4 o; o[0] = siluf_(g[0]) * uu[0]; o[1] = siluf_(g[1]) * uu[1]; o[2] = siluf_(g[2]) * uu[2]; o[3] = siluf_(g[3]) * uu[3];
        store_bf4(U + (size_t)r * ldu + f, o);
    }
};
struct F6M {
    static constexpr int NMODES = 1;
    bf16* Y; int second;
    template <int MODE> __device__ __forceinline__ void at(const pg8::Unit& u, int r, int c, f32x4 v) const {
        if (r >= u.nvalid) return;
        bf16* p = Y + (size_t)(u.row0 + r) * 1024 + u.col0 + c;
        if (second) v = v + load_bf4(p);
        store_bf4(p, v);
    }
    template <int MODE> __device__ __forceinline__ void row(const pg8::Unit& u, int r, int c8, f32x4 a0, f32x4 a1, f32x4 b0, f32x4 b1) const {
        if (r >= u.nvalid) return;
        bf16* p = Y + (size_t)(u.row0 + r) * 1024 + u.col0 + c8;
        if (second) { f32x4 m0, m1; load_bf8(p, m0, m1); a0 = a0 + m0; a1 = a1 + m1; load_bf8(p + 128, m0, m1); b0 = b0 + m0; b1 = b1 + m1; }
        store_bf8(p, a0, a1); store_bf8(p + 128, b0, b1);
    }
    static constexpr int NPRE = 2, BATCH = 2;
    __device__ __forceinline__ void ld(const pg8::Unit& u, int r, int c8, u32x4 (&p)[2]) const {
        { unsigned z_ = (unsigned)r; z_ ^= z_; asm volatile("" : "+v"(z_)); p[0] = (u32x4){z_, z_, z_, z_}; p[1] = p[0]; }
        if (second && r < u.nvalid) { const bf16* q = Y + (size_t)(u.row0 + r) * 1024 + u.col0 + c8; p[0] = *(const u32x4*)q; p[1] = *(const u32x4*)(q + 128); }
    }
    __device__ __forceinline__ void fin(const pg8::Unit& u, int r, int c8, const u32x4 (&p)[2], f32x4 a0, f32x4 a1, f32x4 b0, f32x4 b1) const {
        if (r >= u.nvalid) return;
        bf16* q = Y + (size_t)(u.row0 + r) * 1024 + u.col0 + c8; f32x4 m0, m1, m2, m3; unpack_bf8(p[0], m0, m1); unpack_bf8(p[1], m2, m3);
        store_bf8(q, a0 + m0, a1 + m1); store_bf8(q + 128, b0 + m2, b1 + m3);
    }
};
struct F6Mm {
    static constexpr int NMODES = 1;
    float* Y; int second;
    template <int MODE> __device__ __forceinline__ void at(const pg8::Unit& u, int r, int c, f32x4 v) const {
        float* p = Y + (size_t)r * 1024 + u.col0 + c;
        if (second) v = v + *(const f32x4*)p;
        *(f32x4*)p = v;
    }
};

struct SchedP3 {
    static constexpr bool GATHER = false;
    pg8::SchedDense S; const char* Bt2;
    __device__ bool next(int i, pg8::Unit& u) const { if (!S.next(i >> 1, u)) return false; if (i & 1) { u.A += 1024 * 2; u.B = Bt2 + (u.B - S.Bt); u.e = 1; } return true; }
    __device__ __forceinline__ unsigned a_off(const pg8::Unit& u, int R, int h) const { return S.a_off(u, R, h); }
};

struct SchedMoeUp {
    static constexpr bool GATHER = true;
    volatile LAS unsigned* T; const int* perm; const char* A; const char* W; int G, c, hf;
    __device__ bool next(int i, pg8::Unit& u) const {
        const int TT = (int)T[32]; int gt, pn; if (!pg8::unit_order((long)i * G + c, TT, 14, gt, pn, WGM_MOE)) return false;
        int e = 0;
#pragma unroll
        for (int j = 1; j < 8; ++j) e += (gt >= (int)T[24 + j]) ? 1 : 0;
        u.A = A; u.B = W + ((size_t)(e * 2 + hf) * DFFE + (size_t)pn * 256) * (D * 2); u.row0 = gt * 256; u.col0 = pn * 256; u.e = e; u.nvalid = gt - (int)T[24 + e];
        return true;
    }
    __device__ __forceinline__ const int* idx_ptr(const pg8::Unit& u, int R, int h) const {
        const int rank = u.nvalid * 256 + h * 128 + R, cnt = (int)T[16 + u.e];
        return perm + u.e * M + (rank < cnt ? rank : 0);
    }
    __device__ __forceinline__ unsigned a_off(const pg8::Unit& u, int R, int h) const { return (unsigned)(*idx_ptr(u, R, h)) * (unsigned)(D * 2); }
    __device__ __forceinline__ const int* idx_base(const pg8::Unit& u) const { return perm + u.e * M + u.nvalid * 256; }
    __device__ __forceinline__ bool row_ok(const pg8::Unit& u, int rt) const { return u.nvalid * 256 + rt < (int)T[16 + u.e]; }
};
struct SchedMoeDown {
    static constexpr bool GATHER = false;
    volatile LAS unsigned* T; const char* A; const char* W; int G, c, hf;
    __device__ bool next(int i, pg8::Unit& u) const {
        const int TT = (int)T[32]; int gt, pn; if (!pg8::unit_order((long)i * G + c, TT, 4, gt, pn, WGM_MOE)) return false;
        int e = 0;
#pragma unroll
        for (int j = 1; j < 8; ++j) e += (gt >= (int)T[24 + j]) ? 1 : 0;
        const int ti = gt - (int)T[24 + e], cnt = (int)T[16 + e];
        u.A = A + (size_t)gt * 256 * (HFF * 2); u.B = W + ((size_t)(e * 2 + hf) * D + (size_t)pn * 256) * (HFF * 2);
        u.row0 = (int)T[40 + e] + ti * 256; u.col0 = pn * 256; u.e = e; u.nvalid = (cnt - ti * 256) < 256 ? (cnt - ti * 256) : 256;
        return true;
    }
    __device__ __forceinline__ unsigned a_off(const pg8::Unit&, int R, int h) const { return (unsigned)(h * 128 + R) * (unsigned)(HFF * 2); }
};

template <class DST>
__device__ __forceinline__ void cvt_tiles(const Frame& F, int& rot, const float* W, int ldsrc, int koff, int K, int ns, DST dst) {
    LAS unsigned char* T = F.lds + F.wave * 16384;
    const int nsb = (ns + 63) >> 6, items = (K >> 6) * nsb, lane = F.lane;
    int start = F.gwave - rot; if (start < 0) start += F.gwaves;
    for (int it = start; it < items; it += F.gwaves) {
        const int sb = it / (K >> 6), kb = it - sb * (K >> 6), k0 = 64 * kb, s0 = 64 * sb;
        const int sl4 = 4 * (lane & 15), s = s0 + sl4;
#pragma unroll
        for (int j = 0; j < 16; ++j) { const int kk = 4 * j + (lane >> 4);
            f32x4 v = zero_f4();
            if (s < ns) v = *(const f32x4*)(W + (size_t)(koff + k0 + kk) * ldsrc + s);
            u32x2 w; w.x = pk2(v[0], v[1]); w.y = pk2(v[2], v[3]);
            *(LAS u32x2*)(T + kk * 136 + sl4 * 2) = w; }
        LDS_WAIT(); asm volatile("" ::: "memory");
        const int c = lane & 7;
#pragma unroll
        for (int jj = 0; jj < 8; ++jj) { const int sl = (lane >> 3) + 8 * jj; const LAS bf16* t = (const LAS bf16*)(T + (8 * c) * 136 + sl * 2);
            u32x4 o; o.x = (unsigned)t[0] | ((unsigned)t[68] << 16); o.y = (unsigned)t[136] | ((unsigned)t[204] << 16); o.z = (unsigned)t[272] | ((unsigned)t[340] << 16); o.w = (unsigned)t[408] | ((unsigned)t[476] << 16);
            bf16* d = (s0 + sl < ns) ? dst(s0 + sl) : nullptr;
            if (d) *(u32x4*)(d + k0 + 8 * c) = o; }
        LDS_WAIT(); asm volatile("" ::: "memory");
    }
    rot = (rot + items) % F.gwaves;
}
__device__ __forceinline__ bf16* dst_win(int s, bf16* B1, bf16* B2) {
    int n; bf16* base = B1;
    if (s < 1024) n = s;
    else if (s < 2048) n = 2048 + (s - 1024);
    else if (s < 3072) { base = B2; n = s - 2048; }
    else if (s < 3088) n = 6144 + (s - 3072);
    else if (s < 4112) { const int t = s - 3088, blk = t >> 9, hh = (t >> 7) & 3, jp = t & 127; n = 1024 + blk * 512 + hh * 128 + 2 * (jp & 63) + (jp >> 6); }
    else if (s < 5136) n = 3072 + (s - 4112);
    else if (s < 6160) { base = B2; n = 1024 + (s - 5136); }
    else if (s < 7184) n = 4096 + (s - 6160);
    else n = 5120 + (s - 7184);
    return base + (size_t)n * D;
}

__device__ __forceinline__ int rcol(int lane, int k) { return 8 * lane + 512 * (k >> 1) + 4 * (k & 1); }
struct LnPar { f32x4 g[4], b[4]; };
__device__ __forceinline__ LnPar ln_par(const float* g, const float* b, int lane) { LnPar P;
#pragma unroll
    for (int j = 0; j < 4; ++j) { P.g[j] = *(const f32x4*)(g + rcol(lane, j)); P.b[j] = *(const f32x4*)(b + rcol(lane, j)); }
    return P; }
__device__ __forceinline__ void ln_vals(f32x4 (&v)[4], const LnPar& P) {
    float s = 0.f;
#pragma unroll
    for (int j = 0; j < 4; ++j) s += (v[j][0] + v[j][1]) + (v[j][2] + v[j][3]);
    const float mean = wave_sum(s) * (1.f / D); float s2 = 0.f;
#pragma unroll
    for (int j = 0; j < 4; ++j) { v[j] = v[j] - mean; s2 += (v[j][0] * v[j][0] + v[j][1] * v[j][1]) + (v[j][2] * v[j][2] + v[j][3] * v[j][3]); }
    const float rstd = 1.f / sqrtf(wave_sum(s2) * (1.f / D) + LN_EPS);
#pragma unroll
    for (int j = 0; j < 4; ++j) v[j] = v[j] * rstd * P.g[j] + P.b[j];
}
struct RawRow { u32x4 a, b; };
__device__ __forceinline__ RawRow raw_load(const bf16* p, int lane) { RawRow r; r.a = *(const u32x4*)(p + 8 * lane); r.b = *(const u32x4*)(p + 512 + 8 * lane); return r; }
__device__ __forceinline__ void raw_unpack(f32x4 (&v)[4], const RawRow& r) {
    v[0] = (f32x4){bf2f(r.a.x), bf2f(r.a.x >> 16), bf2f(r.a.y), bf2f(r.a.y >> 16)}; v[1] = (f32x4){bf2f(r.a.z), bf2f(r.a.z >> 16), bf2f(r.a.w), bf2f(r.a.w >> 16)};
    v[2] = (f32x4){bf2f(r.b.x), bf2f(r.b.x >> 16), bf2f(r.b.y), bf2f(r.b.y >> 16)}; v[3] = (f32x4){bf2f(r.b.z), bf2f(r.b.z >> 16), bf2f(r.b.w), bf2f(r.b.w >> 16)};
}
__device__ __forceinline__ void rowb_load(f32x4 (&v)[4], const bf16* p, int lane) { load_bf8(p + 8 * lane, v[0], v[1]); load_bf8(p + 512 + 8 * lane, v[2], v[3]); }
__device__ __forceinline__ void rowb_store(const f32x4 (&v)[4], bf16* p, int lane, int dry = 0) { if (dry) return; store_bf8(p + 8 * lane, v[0], v[1]); store_bf8(p + 512 + 8 * lane, v[2], v[3]); }
__device__ __forceinline__ void rowf_store(const f32x4 (&v)[4], float* p, int lane, int dry = 0) {
    if (dry) return;
#pragma unroll
    for (int j = 0; j < 4; ++j) *(f32x4*)(p + rcol(lane, j)) = v[j];
}
__device__ __forceinline__ void route_row(const f32x4 (&v)[4], const LAS float* wr, int lane, int& e1, int& e2, float& w1, float& w2) {
    float lg[8];
#pragma unroll
    for (int e = 0; e < 8; ++e) { f32x2 a2;
#pragma unroll
        for (int k = 0; k < 4; ++k) { const f32x4 w = *(const LAS f32x4*)(wr + ((e * 4 + k) * 64 + lane) * 4);
            if (k == 0) a2 = (f32x2){v[0][0], v[0][1]} * (f32x2){w[0], w[1]}; else a2 += (f32x2){v[k][0], v[k][1]} * (f32x2){w[0], w[1]};
            a2 += (f32x2){v[k][2], v[k][3]} * (f32x2){w[2], w[3]}; }
        lg[e] = a2.x + a2.y; }
    {
        const bool b3 = (lane & 8) != 0, b2 = (lane & 4) != 0, b1 = (lane & 2) != 0;
        float t[4], u[2];
#pragma unroll
        for (int e = 0; e < 4; ++e) { const float keep = b3 ? lg[e + 4] : lg[e], send = b3 ? lg[e] : lg[e + 4]; t[e] = keep + dpp_f<0x140>(send); }
#pragma unroll
        for (int e = 0; e < 2; ++e) { const float keep = b2 ? t[e + 2] : t[e], send = b2 ? t[e] : t[e + 2]; u[e] = keep + dpp_f<0x141>(send); }
        float x = (b1 ? u[1] : u[0]) + dpp_f<0x4E>(b1 ? u[0] : u[1]);
        x += dpp_f<0xB1>(x);
        x += __builtin_bit_cast(float, __builtin_amdgcn_ds_bpermute((lane ^ 16) << 2, __builtin_bit_cast(int, x)));
        x += __builtin_bit_cast(float, __builtin_amdgcn_ds_bpermute((lane ^ 32) << 2, __builtin_bit_cast(int, x)));
        const int xi = __builtin_bit_cast(int, x);
#pragma unroll
        for (int e = 0; e < 8; ++e) lg[e] = __builtin_bit_cast(float, __builtin_amdgcn_readlane(xi, 2 * e));
    }
    int a = 0; float la = lg[0];
#pragma unroll
    for (int e = 1; e < 8; ++e) if (lg[e] > la) { la = lg[e]; a = e; }
    int b = -1; float lb = -3.0e38f;
#pragma unroll
    for (int e = 0; e < 8; ++e) if (e != a && lg[e] > lb) { lb = lg[e]; b = e; }
    const float t = __expf(lb - la);
    e1 = a; e2 = b; w1 = 1.f / (1.f + t); w2 = t / (1.f + t);
}

template <int N> struct IntC { static constexpr int value = N; };
struct MixArgs {
    bf16* QK; bf16* V; const float* GA;
    bf16* mQK; bf16* mV; const float* mGA; bf16* mO;
    const float* wa2; const float* ba; const float* gng; const float* rng; const float* rnb;
    int dry;
};
typedef float f32x16 __attribute__((ext_vector_type(16)));
typedef short s16x4 __attribute__((ext_vector_type(4)));
constexpr int QROW = 272, PROW = 144, KTROW = 144, OROWF = 260;
constexpr int FM_QIN = 0, FM_KIN = 17408, FM_PT = 34816, FM_KT = 44032  , FM_OT = 0  ,
              FM_VS = 66560  , FM_SEG = 99328, FM_DEC = 101376, FM_GA = 101888  , FM_NG = 118272  , FM_WB = 120320  , FM_END = 136704;
static_assert(FM_KT + 128 * KTROW <= FM_VS && FM_END <= MISC_OFF, "fast mixer LDS map");
__device__ __forceinline__ bf16x8 pack8(float a0, float a1, float a2, float a3, float a4, float a5, float a6, float a7) {
    u32x4 p; p.x = pk2_sw(a0, a1); p.y = pk2_sw(a2, a3); p.z = pk2_sw(a4, a5); p.w = pk2_sw(a6, a7); return __builtin_bit_cast(bf16x8, p);
}
#define MIX_BAR() do { asm volatile("s_waitcnt lgkmcnt(0)" ::: "memory"); __builtin_amdgcn_s_barrier(); asm volatile("" ::: "memory"); } while (0)
__device__ __forceinline__ void mixer_fast(const Frame& F, const MixArgs& a) {
    LAS unsigned char* L = F.lds;
    LAS float* seg = (LAS float*)(L + FM_SEG); LAS float* dec = (LAS float*)(L + FM_DEC); LAS float* ot = (LAS float*)(L + FM_OT);
    const int tid0 = F.tid, wave = F.wave;
    LAS unsigned char* slab = L + FM_VS + wave * 4096;
    for (int it = F.bid; it < NB * 8; it += F.G) {
        int tid = tid0; asm volatile("" : "+v"(tid));
        int lane = tid & 63, l32 = lane & 31, hh = lane >> 5, l16 = lane & 15, quad = lane >> 4;
        const int b = it >> 3, type_rt = (a.dry == 2) ? 1 : ((it >> 2) & 1), head = it & 3;
        auto item_body = [&](auto TY_) __attribute__((always_inline)) {
        constexpr int type = decltype(TY_)::value;
        const int qcol = (type ? 1024 : 0) + head * 128, kcol = qcol + 512, vcol = type * 1024 + head * 256;
        const float lng = __log2f(1.0f - exp2f(-5.0f - (float)head));
        f32x16 S[4];
#pragma unroll
        for (int T = 0; T < 4; ++T)
#pragma unroll
            for (int r = 0; r < 16; ++r) S[T][r] = 0.f;
        LAS float* ngL = (LAS float*)(L + FM_NG);
        if (tid0 < 256) { ngL[tid0] = (type == 0) ? a.gng[tid0] : a.rng[head * 256 + tid0]; ngL[256 + tid0] = (type == 0) ? 0.f : a.rnb[head * 256 + tid0]; }
        const int mt = wave >> 2, nt = wave & 3;
        float bad = 0.f;
        if (type == 0) { const int d0 = head * 128 + 32 * nt + l32; bad = a.ba[d0]; float wv[8];
#pragma unroll
            for (int j = 0; j < 8; ++j) wv[j] = a.wa2[(8 * hh + j) * 512 + d0];
            unsigned h_[4], l_[4];
#pragma unroll
            for (int j = 0; j < 4; ++j) { h_[j] = pk2(wv[2 * j], wv[2 * j + 1]); l_[j] = pk2(wv[2 * j] - bf2f(h_[j]), wv[2 * j + 1] - bf2f(h_[j] >> 16)); }
            *(LAS u32x4*)(L + FM_WB + tid * 32) = (u32x4){h_[0], h_[1], h_[2], h_[3]}; *(LAS u32x4*)(L + FM_WB + tid * 32 + 16) = (u32x4){l_[0], l_[1], l_[2], l_[3]}; }
        unsigned qraw[16], kraw[16];
        { const unsigned qoff = (unsigned)(qcol + 32 * nt + l32) * 2u, koff = (unsigned)(kcol + 32 * nt + l32) * 2u;
#pragma unroll
        for (int r = 0; r < 16; ++r) { qraw[r] = 0u; kraw[r] = 0u; }
        if (mt == 1) {
#pragma unroll
            for (int r = 8; r < 16; ++r) { const char* rb = (const char*)a.mQK + (size_t)((r & 3) + 8 * (r >> 2) - 16) * 4096 + (size_t)hh * 4 * 4096; qraw[r] = *(const bf16*)(rb + qoff); kraw[r] = *(const bf16*)(rb + koff); }
        } }
        {
            unsigned z0 = 0u; asm volatile("" : "+v"(z0));
            const u32x4 z = (u32x4){z0, z0, z0, z0};
#pragma unroll
            for (int j = 0; j < 3; ++j) *(LAS u32x4*)(slab + j * 1024 + lane * 16) = z;
            __builtin_amdgcn_global_load_lds((const unsigned*)(a.mV + (size_t)(lane >> 2) * 2048 + vcol + 32 * wave + 8 * (lane & 3)), (LAS unsigned*)(slab + 3 * 1024), 16, 0, 0);
        }
        float bq[16], tot_n = 0.f;
        if (type == 0 && mt == 1) __builtin_amdgcn_global_load_lds((const unsigned*)(a.mGA + lane * 4), (LAS unsigned*)(L + FM_GA + wave * 2048 + 1024), 16, 0, 0);
        auto gates = [&](const bool metaN, const int tid_, const int lane_, const int hh_, const int dch_) __attribute__((always_inline)) {
            const LAS f32x4* gp = (const LAS f32x4*)(L + FM_GA + wave * 2048 + (lane_ & 31) * 64 + hh_ * 32);
            const f32x4 g0 = gp[0], g1 = gp[1];
            unsigned h_[4], l_[4];
            h_[0] = pk2(g0[0], g0[1]); h_[1] = pk2(g0[2], g0[3]); h_[2] = pk2(g1[0], g1[1]); h_[3] = pk2(g1[2], g1[3]);
            l_[0] = pk2(g0[0] - bf2f(h_[0]), g0[1] - bf2f(h_[0] >> 16)); l_[1] = pk2(g0[2] - bf2f(h_[1]), g0[3] - bf2f(h_[1] >> 16));
            l_[2] = pk2(g1[0] - bf2f(h_[2]), g1[1] - bf2f(h_[2] >> 16)); l_[3] = pk2(g1[2] - bf2f(h_[3]), g1[3] - bf2f(h_[3] >> 16));
            const bf16x8 a_hi = __builtin_bit_cast(bf16x8, (u32x4){h_[0], h_[1], h_[2], h_[3]}), a_lo = __builtin_bit_cast(bf16x8, (u32x4){l_[0], l_[1], l_[2], l_[3]});
            const bf16x8 wb_hi = *(const LAS bf16x8*)(L + FM_WB + tid_ * 32), wb_lo = *(const LAS bf16x8*)(L + FM_WB + tid_ * 32 + 16);
            f32x16 pre;
#pragma unroll
            for (int r = 0; r < 16; ++r) pre[r] = 0.f;
            pre = __builtin_amdgcn_mfma_f32_32x32x16_bf16(a_hi, wb_hi, pre, 0, 0, 0);
            pre = __builtin_amdgcn_mfma_f32_32x32x16_bf16(a_lo, wb_hi, pre, 0, 0, 0);
            pre = __builtin_amdgcn_mfma_f32_32x32x16_bf16(a_hi, wb_lo, pre, 0, 0, 0);
#pragma unroll
            for (int r = 0; r < 16; ++r) { const float x = pre[r] + bad;
                bq[r] = fminf(x, 0.f) * (1.44269504f / 16.0f) - __builtin_amdgcn_logf(1.0f + __builtin_amdgcn_exp2f(fabsf(x) * -1.44269504f)) * (1.0f / 16.0f); }
            if (metaN) {
#pragma unroll
                for (int r = 0; r < 16; ++r) { const int c = 32 * mt + (r & 3) + 8 * (r >> 2) + 4 * hh_; bq[r] = (c >= 48) ? bq[r] : 0.f; }
            }
            float T[4];
#pragma unroll
            for (int q = 0; q < 4; ++q) { bq[4 * q + 1] += bq[4 * q]; bq[4 * q + 2] += bq[4 * q + 1]; bq[4 * q + 3] += bq[4 * q + 2]; T[q] = bq[4 * q + 3]; }
            float tot = 0.f;
#pragma unroll
            for (int q = 0; q < 4; ++q) { const float To = __builtin_bit_cast(float, __builtin_amdgcn_ds_bpermute((lane_ ^ 32) << 2, __builtin_bit_cast(int, T[q])));
                const float t0 = hh_ ? To : T[q], t1 = hh_ ? T[q] : To;
                const float mine = tot + (hh_ ? t0 : 0.f);
#pragma unroll
                for (int j = 0; j < 4; ++j) bq[4 * q + j] += mine;
                tot += t0 + t1; }
            if (mt == 0 && hh_ == 0) seg[dch_] = tot;
            tot_n = tot;
        };
        auto finalize = [&](const int hh_, const int dch_) __attribute__((always_inline)) {
            if (mt == 1) { const float base = seg[dch_];
#pragma unroll
                for (int r = 0; r < 16; ++r) bq[r] += base;
                if (hh_ == 0) dec[dch_] = __builtin_amdgcn_exp2f(base + tot_n); }
        };
        MIX_BAR();
        if (type == 0) { asm volatile("s_waitcnt vmcnt(0)" ::: "memory"); gates(true, tid, lane, hh, 32 * nt + l32); MIX_BAR(); finalize(hh, 32 * nt + l32); }
        else {
#pragma unroll
            for (int r = 0; r < 16; ++r) bq[r] = (float)(32 * mt + (r & 3) + 8 * (r >> 2) + 4 * hh + 1) * lng;
            if (mt == 1 && hh == 0) dec[32 * nt + l32] = __builtin_amdgcn_exp2f(64.0f * lng);
        }
#pragma unroll 1
        for (int ch = -1; ch < 32; ++ch) {
            const bool meta = ch < 0;
            bf16* vb = meta ? a.mV : a.V + (size_t)(b * SEQ + ch * 64) * 2048;
            tid = tid0; asm volatile("" : "+v"(tid));
            lane = tid & 63; l32 = lane & 31; hh = lane >> 5; l16 = lane & 15; quad = lane >> 4;
            const int dch = 32 * nt + l32;
            const unsigned qoff = (unsigned)(qcol + dch) * 2u + (unsigned)hh * 16384u, koff = (unsigned)(kcol + dch) * 2u + (unsigned)hh * 16384u;
            asm volatile("s_waitcnt vmcnt(0)" ::: "memory");
            MIX_BAR();
            if (type == 0) { const float* ng_ = a.GA + (size_t)(b * SEQ + (ch < 31 ? ch + 1 : 31) * 64 + 32 * mt) * 16 + lane * 4;
                __builtin_amdgcn_global_load_lds((const unsigned*)ng_, (LAS unsigned*)(L + FM_GA + wave * 2048), 16, 0, 0);
                __builtin_amdgcn_global_load_lds((const unsigned*)(ng_ + 256), (LAS unsigned*)(L + FM_GA + wave * 2048 + 1024), 16, 0, 0); }
            {
                const int dchp = (dch & ~12) | ((dch & 4) << 1) | ((dch & 8) >> 1);
#pragma unroll
                for (int q = 0; q < 4; ++q) { unsigned kt0 = 0u, kt1 = 0u;
#pragma unroll
                    for (int j = 0; j < 4; ++j) { const int r = 4 * q + j; const int c = 32 * mt + j + 8 * q + 4 * hh; const float eb = __builtin_amdgcn_exp2f(bq[r]), en = __builtin_amdgcn_exp2f(-bq[r]);
                        const unsigned qkv = pk2(bf2f(qraw[r]) * eb, bf2f(kraw[r]) * en); const unsigned qv = qkv & 0xffffu, kv = qkv >> 16;
                        *(LAS bf16*)(L + FM_QIN + c * QROW + dchp * 2) = (bf16)qv; *(LAS bf16*)(L + FM_KIN + c * QROW + dchp * 2) = (bf16)kv;
                        if (j == 0) kt0 = kv; else if (j == 1) kt0 |= kv << 16; else if (j == 2) kt1 = kv; else kt1 |= kv << 16; }
                    *(LAS u32x2*)(L + FM_KT + dch * KTROW + (32 * mt + 8 * q + 4 * hh) * 2) = (u32x2){kt0, kt1}; }
            }
            MIX_BAR();
#pragma unroll 1
            for (int tt = wave; tt < 10; tt += 8) {
                const int ti = (tt >= 6) ? 3 : (tt >= 3) ? 2 : (tt >= 1) ? 1 : 0, tj = tt - ti * (ti + 1) / 2;
                f32x4 pacc = zero_f4();
#pragma unroll
                for (int ks = 0; ks < 4; ++ks) {
                    const bf16x8 A = *(const LAS bf16x8*)(L + FM_QIN + (16 * ti + l16) * QROW + (32 * ks + 8 * quad) * 2);
                    const bf16x8 B = *(const LAS bf16x8*)(L + FM_KIN + (16 * tj + l16) * QROW + (32 * ks + 8 * quad) * 2);
                    pacc = __builtin_amdgcn_mfma_f32_16x16x32_bf16(A, B, pacc, 0, 0, 0);
                }
#pragma unroll
                for (int jj = 0; jj < 4; jj += 2) { const int row = 16 * ti + 4 * quad + jj, col = 16 * tj + l16;
                    const unsigned pp = pk2((col > row) ? 0.f : pacc[jj], (col > row + 1) ? 0.f : pacc[jj + 1]);
                    *(LAS bf16*)(L + FM_PT + row * PROW + col * 2) = (bf16)(pp & 0xffffu); *(LAS bf16*)(L + FM_PT + (row + 1) * PROW + col * 2) = (bf16)(pp >> 16); }
            }
            if (wave == 2 || wave == 3) {
                const int ti = (wave == 2) ? 0 : 2, tj = ti + 1;
#pragma unroll
                for (int jj = 0; jj < 4; ++jj) *(LAS bf16*)(L + FM_PT + (16 * ti + 4 * quad + jj) * PROW + (16 * tj + l16) * 2) = (bf16)0;
            }
            MIX_BAR();
            bf16x8 vf[4];
            {
                const unsigned base = (unsigned)(size_t)(slab + (8 * hh + (l16 >> 2)) * 64 + 32 * (quad & 1) + 8 * (l16 & 3));
                s16x4 t0, t1, t2, t3, t4, t5, t6, t7;
                asm volatile("ds_read_b64_tr_b16 %0, %8\n\tds_read_b64_tr_b16 %1, %8 offset:256\n\tds_read_b64_tr_b16 %2, %8 offset:1024\n\tds_read_b64_tr_b16 %3, %8 offset:1280\n\t"
                             "ds_read_b64_tr_b16 %4, %8 offset:2048\n\tds_read_b64_tr_b16 %5, %8 offset:2304\n\tds_read_b64_tr_b16 %6, %8 offset:3072\n\tds_read_b64_tr_b16 %7, %8 offset:3328\n\ts_waitcnt lgkmcnt(0)"
                             : "=&v"(t0), "=&v"(t1), "=&v"(t2), "=&v"(t3), "=&v"(t4), "=&v"(t5), "=&v"(t6), "=&v"(t7) : "v"(base) : "memory");
                vf[0] = (bf16x8){t0[0], t0[1], t0[2], t0[3], t1[0], t1[1], t1[2], t1[3]}; vf[1] = (bf16x8){t2[0], t2[1], t2[2], t2[3], t3[0], t3[1], t3[2], t3[3]};
                vf[2] = (bf16x8){t4[0], t4[1], t4[2], t4[3], t5[0], t5[1], t5[2], t5[3]}; vf[3] = (bf16x8){t6[0], t6[1], t6[2], t6[3], t7[0], t7[1], t7[2], t7[3]};
            }
            { const bf16* nv = a.V + (size_t)(b * SEQ + (ch < 31 ? ch + 1 : 31) * 64) * 2048 + vcol + 32 * wave + 8 * (lane & 3);
#pragma unroll
                for (int j = 0; j < 4; ++j) __builtin_amdgcn_global_load_lds((const unsigned*)(nv + (size_t)(16 * j + (lane >> 2)) * 2048), (LAS unsigned*)(slab + j * 1024), 16, 0, 0);
            }
            __builtin_amdgcn_sched_barrier(0);
            f32x16 O[2];
#pragma unroll
            for (int mt = 0; mt < 2; ++mt)
#pragma unroll
                for (int r = 0; r < 16; ++r) O[mt][r] = 0.f;
            auto mfma_stage = [&]() __attribute__((always_inline)) {
#pragma unroll
            for (int mt = 0; mt < 2; ++mt)
#pragma unroll
                for (int ks = 0; ks < 2 * mt + 2; ++ks) {
                    const bf16x8 A = *(const LAS bf16x8*)(L + FM_PT + (32 * mt + l32) * PROW + (16 * ks + 8 * hh) * 2);
                    O[mt] = __builtin_amdgcn_mfma_f32_32x32x16_bf16(A, vf[ks], O[mt], 0, 0, 0);
                }
#pragma unroll
            for (int T = 0; T < 4; ++T) {
                bf16x8 Aq[2][2];
#pragma unroll
                for (int s2 = 0; s2 < 2; ++s2)
#pragma unroll
                    for (int mt = 0; mt < 2; ++mt) {
                        Aq[s2][mt] = *(const LAS bf16x8*)(L + FM_QIN + (32 * mt + l32) * QROW + (32 * T + 16 * s2 + 8 * hh) * 2);
                    }
#pragma unroll
                for (int s2 = 0; s2 < 2; ++s2) {
                    const bf16x8 Bs = pack8(S[T][8 * s2], S[T][8 * s2 + 1], S[T][8 * s2 + 2], S[T][8 * s2 + 3], S[T][8 * s2 + 4], S[T][8 * s2 + 5], S[T][8 * s2 + 6], S[T][8 * s2 + 7]);
                    O[0] = __builtin_amdgcn_mfma_f32_32x32x16_bf16(Aq[s2][0], Bs, O[0], 0, 0, 0);
                    O[1] = __builtin_amdgcn_mfma_f32_32x32x16_bf16(Aq[s2][1], Bs, O[1], 0, 0, 0);
                }
            }
#pragma unroll
            for (int T = 0; T < 4; ++T) {
                bf16x8 Ak[4]; f32x4 dc[4];
#pragma unroll
                for (int ks = 0; ks < 4; ++ks) Ak[ks] = *(const LAS bf16x8*)(L + FM_KT + (32 * T + l32) * KTROW + (16 * ks + 8 * hh) * 2);
#pragma unroll
                for (int q4 = 0; q4 < 4; ++q4) dc[q4] = *(const LAS f32x4*)(dec + 32 * T + 8 * q4 + 4 * hh);
#pragma unroll
                for (int ks = 0; ks < 4; ++ks) S[T] = __builtin_amdgcn_mfma_f32_32x32x16_bf16(Ak[ks], vf[ks], S[T], 0, 0, 0);
#pragma unroll
                for (int q4 = 0; q4 < 4; ++q4) { S[T][4 * q4] *= dc[q4][0]; S[T][4 * q4 + 1] *= dc[q4][1]; S[T][4 * q4 + 2] *= dc[q4][2]; S[T][4 * q4 + 3] *= dc[q4][3]; }
            }
            };
            const bool gnext = (type == 0);
#pragma unroll 1
            for (int st = 0; st < 2; ++st) {
                if ((st == 0) == (wave < 4)) { if (gnext) { asm volatile("s_waitcnt vmcnt(4)" ::: "memory"); gates(false, tid, lane, hh, dch); } }
                else mfma_stage();
            }
            __builtin_amdgcn_sched_barrier(0);
            { const bf16* nq = a.QK + (size_t)(b * SEQ + (ch < 31 ? ch + 1 : 31) * 64 + 32 * mt) * 2048;
#pragma unroll
                for (int r = 0; r < 16; ++r) { const char* rb = (const char*)nq + (size_t)((r & 3) + 8 * (r >> 2)) * 4096; qraw[r] = *(const bf16*)(rb + qoff); kraw[r] = *(const bf16*)(rb + koff); } }
            MIX_BAR();
#pragma unroll
            for (int mt = 0; mt < 2; ++mt)
#pragma unroll
                for (int r = 0; r < 16; ++r) ot[(32 * mt + (r & 3) + 8 * (r >> 2) + 4 * hh) * OROWF + 32 * wave + l32] = O[mt][r];
            if (gnext) finalize(hh, dch);
            MIX_BAR();
            {
                const int r8 = lane >> 3, s8 = lane & 7, i = wave + 8 * r8;
                const LAS float* orow = ot + i * OROWF + 4 * s8;
                f32x4 o[8];
#pragma unroll
                for (int j = 0; j < 8; ++j) o[j] = *(const LAS f32x4*)(orow + 32 * j);
                float rs;
                if (type == 0) {
                    f32x4 q = o[0] * o[0];
#pragma unroll
                    for (int j = 1; j < 8; ++j) q = q + o[j] * o[j];
                    const float ss = sum8((q[0] + q[1]) + (q[2] + q[3]));
                    rs = __builtin_amdgcn_rsqf(ss * (1.0f / 256.0f) + LN_EPS);
                } else {
                    const f32x4 t = ((o[0] + o[1]) + (o[2] + o[3])) + ((o[4] + o[5]) + (o[6] + o[7]));
                    const float mu = sum8((t[0] + t[1]) + (t[2] + t[3])) * (1.0f / 256.0f);
#pragma unroll
                    for (int j = 0; j < 8; ++j) o[j] = o[j] - mu;
                    f32x4 q = o[0] * o[0];
#pragma unroll
                    for (int j = 1; j < 8; ++j) q = q + o[j] * o[j];
                    const float var = sum8((q[0] + q[1]) + (q[2] + q[3])) * (1.0f / 256.0f);
                    rs = __builtin_amdgcn_rsqf(var + GN_EPS);
                }
                const bool st = !a.dry && (!meta || (b == 0 && i >= 48));
                bf16* dst = (meta ? a.mO + (size_t)(i - 48) * 2048 : vb + (size_t)i * 2048) + vcol + 4 * s8;
                const LAS float* gp = ngL + 4 * s8;
#pragma unroll
                for (int j = 0; j < 8; ++j) { const f32x4 ng = *(const LAS f32x4*)(gp + 32 * j), nb = *(const LAS f32x4*)(gp + 256 + 32 * j);
                    const f32x4 y = o[j] * rs * ng + nb;
                    if (st) store_bf4(dst + 32 * j, y);
                    __builtin_amdgcn_sched_barrier(0); }
            }
        }
        asm volatile("s_waitcnt vmcnt(0)" ::: "memory");
        MIX_BAR();
        };
        if (type_rt == 0) item_body(IntC<0>{}); else item_body(IntC<1>{});
    }
}

typedef const __attribute__((address_space(4))) Args* KArgs;
__device__ __forceinline__ KArgs kargs() { KArgs p = (KArgs)__builtin_amdgcn_kernarg_segment_ptr(); asm volatile("" : "+s"(p)); return p; }
#define ENV() \
    KArgs A_ = kargs(); \
    Frame F; { int t_ = TIDX(); int b_ = blockIdx.x; asm volatile("" : "+s"(b_)); \
        { LAS unsigned char* l_ = (LAS unsigned char*)lds_raw; asm volatile("" : "+s"(l_)); F.lds = l_; } F.MISC = (volatile LAS unsigned*)(F.lds + MISC_OFF); F.tid = t_; F.lane = t_ & 63; F.wave = __builtin_amdgcn_readfirstlane(t_ >> 6); \
        F.G = gridDim.x; F.bid = b_; F.gtid = b_ * NTHR + t_; F.gthreads = F.G * NTHR; F.gwave = b_ * NWAVES + F.wave; F.gwaves = F.G * NWAVES; F.ws = A_->ws; F.ctl = (unsigned*)(A_->ws + WS_CTL); } \
    unsigned char* ws = A_->ws; typedef const float* cfp_; const __attribute__((address_space(4))) cfp_* in = A_->in; \
    bf16* HA = (bf16*)(ws + WS_HA); bf16* HB = (bf16*)(ws + WS_HB); float* OUTF = A_->out; \
    bf16* QK = (bf16*)(ws + WS_QK); bf16* V = (bf16*)(ws + WS_V); float* GA = (float*)(ws + WS_GA); \
    bf16* MRG = QK; bf16* U = QK; const f32x2* rope = (const f32x2*)(ws + WS_ROPE); \
    unsigned char* mt = ws + WS_META; \
    bf16* mA = (bf16*)(mt + MT_XB); bf16* mB = (bf16*)(mt + MT_HA); bf16* mQK = (bf16*)(mt + MT_QK); bf16* mV = (bf16*)(mt + MT_V); \
    bf16* mSIG = (bf16*)(mt + MT_SIG); float* mGA = (float*)(mt + MT_GA); bf16* mMRG = (bf16*)(mt + MT_MRG); bf16* mU = (bf16*)(mt + MT_U); float* mY = (float*)(mt + MT_Y); \
    bf16* mUall = (bf16*)(ws + WS_META2); float* mYall = (float*)(ws + WS_META2 + 512 * 1024); (void)mUall; (void)mYall; \
    bf16* mO = (bf16*)(mt + MT_O); int* mTokE = (int*)(mt + MT_TOK); float* mTokW = (float*)(mt + MT_TOK + 128); \
    int* perm = (int*)(ws + WS_MOE); int* tok_slot = (int*)(ws + WS_MOE + 2 * MiB); float* tok_w = (float*)(ws + WS_MOE + 2 * MiB + 512 * 1024); \
    const bf16* B1t = (const bf16*)(ws + WS_W + W_B1); const bf16* B2t = (const bf16*)(ws + WS_W + W_B2); const bf16* PAt = (const bf16*)(ws + WS_W + W_PA); \
    const bf16* PBt = (const bf16*)(ws + WS_W + W_PB); const bf16* Ot = (const bf16*)(ws + WS_W + W_O); const bf16* FGU = (const bf16*)(ws + WS_W + W_F); \
    const bf16* FDd = (const bf16*)(ws + WS_W + W_FD_DENSE); const bf16* FDm = (const bf16*)(ws + WS_W + W_FD_MOE); \
    bf16* SIG = (bf16*)A_->out; bf16* Y = (l == DEPTH - 1) ? (bf16*)(ws + WS_Y3) : (bf16*)A_->out;     \
    (void)HA; (void)HB; (void)OUTF; (void)mA; (void)mB; (void)QK; (void)V; (void)GA; (void)MRG; (void)U; (void)rope; (void)mQK; (void)mV; (void)mSIG; (void)mGA; (void)mMRG; (void)mU; (void)mY; \
    (void)mO; (void)mTokE; (void)mTokW; (void)perm; (void)tok_slot; (void)tok_w; (void)B1t; (void)B2t; (void)PAt; (void)PBt; (void)Ot; (void)FGU; (void)FDd; (void)FDm; \
    (void)SIG; (void)Y; (void)in

__global__ void __launch_bounds__(NTHR, 2) fwd_kernel(Args args) {
    extern __shared__ __attribute__((aligned(16))) unsigned char lds_raw[];
    const int lo = args.ph_lo, hi = args.ph_hi;
    const int wv0_ = __builtin_amdgcn_readfirstlane((int)(threadIdx.x >> 6));
#define TIDX() tid_from_wave(wv0_)
    const bool multi = (hi - lo) > 1;
    {
        volatile LAS unsigned* MISC0 = (volatile LAS unsigned*)((LAS unsigned char*)lds_raw + MISC_OFF);
        for (int u = TIDX(); u < 256; u += NTHR) MISC0[u] = 0u;
        __syncthreads();
        if (multi) (void)xcd_barrier_post((unsigned*)(args.ws + WS_CTL) + CW_BAR + args.li * XCD_BAR_WORDS, MISC0, TIDX());
    }
#if PROBE_CLK
    if (blockIdx.x == 0 && TIDX() == 0) { volatile LAS unsigned long long* ck = (volatile LAS unsigned long long*)((LAS unsigned char*)lds_raw + MISC_OFF + 512); ck[0] = (unsigned long long)clock64(); ck[1] = __builtin_amdgcn_s_memrealtime(); }
#endif
#ifndef PH_MASK
#define PH_MASK 0xFFF
#endif
#define INS(slot, k) ((((PH_MASK) >> (slot)) & 1) && lo <= (k) && (k) < hi)
#define IN(k) (lo <= (k) && (k) < hi)
#define SEAM(k) do { if (IN(k) && IN((k) + 1)) { KArgs B_ = kargs(); XcdBarrier bar; \
        if (PROBE_SPREAD >= 0 && (k) == PROBE_SPREAD && TIDX() == 0) { asm volatile("s_waitcnt vmcnt(0)" ::: "memory"); ((unsigned long long*)(B_->ws + WS_CTL + 131072))[blockIdx.x] = __builtin_amdgcn_s_memrealtime(); } \
        bar.bar = (unsigned*)(B_->ws + WS_CTL) + CW_BAR + B_->li * XCD_BAR_WORDS; bar.x = xb_xcc_id(); bar.tid = TIDX(); \
        bar.st = (volatile LAS unsigned*)((LAS unsigned char*)lds_raw + MISC_OFF); xcd_barrier(bar); \
        if (PROBE_STAMP >= 0 && blockIdx.x == 0 && TIDX() == 0) { unsigned a_ = MISC_OFF + 512; asm volatile("" : "+v"(a_)); volatile LAS unsigned long long* ck_ = (volatile LAS unsigned long long*)((LAS unsigned char*)lds_raw + a_); \
            if ((k) == PROBE_STAMP - 1) ck_[2] = __builtin_amdgcn_s_memrealtime(); if ((k) == PROBE_STAMP) ck_[3] = __builtin_amdgcn_s_memrealtime(); } \
        if (PROBE_SPREAD >= 0 && (k) == PROBE_SPREAD && blockIdx.x == 0 && TIDX() == 0) { const unsigned long long* ts_ = (const unsigned long long*)(B_->ws + WS_CTL + 131072); unsigned long long mn_ = ~0ull, mx_ = 0ull; \
            for (unsigned i_ = 0; i_ < gridDim.x; ++i_) { const unsigned long long t_ = __hip_atomic_load(ts_ + i_, __ATOMIC_RELAXED, __HIP_MEMORY_SCOPE_AGENT); mn_ = t_ < mn_ ? t_ : mn_; mx_ = t_ > mx_ ? t_ : mx_; } \
            unsigned a_ = MISC_OFF + 512; asm volatile("" : "+v"(a_)); volatile LAS unsigned long long* ck_ = (volatile LAS unsigned long long*)((LAS unsigned char*)lds_raw + a_); ck_[2] = mn_; ck_[3] = mx_; } } } while (0)

    for (int l = 0; l < DEPTH; ++l) {
        const int pb = l * NPH;
        if (hi <= pb || lo >= pb + NPH) continue;
        const bool moe = (l & 1) != 0; const int l2 = l >> 1;
        if (INS(0, pb + 0)) { ENV();
            int rot = 0;
            const float* win = in[I_WIN] + (size_t)l * D * NIN;
            { bf16* b1 = (bf16*)B1t; bf16* b2 = (bf16*)B2t; cvt_tiles(F, rot, win, NIN, 0, D, NIN, [=](int s) { return dst_win(s, b1, b2); }); }
            for (int i = F.gtid * 8; i < (N1 - 6160) * D; i += F.gthreads * 8) *(u32x4*)((bf16*)B1t + (size_t)6160 * D + i) = zero_u4();
            { bf16* d0 = (bf16*)PAt; cvt_tiles(F, rot, in[I_WPA] + (size_t)l * D * D, D, 0, D, D, [=](int s) { return d0 + (size_t)s * D; }); }
            { bf16* d0 = (bf16*)PBt; cvt_tiles(F, rot, in[I_WPB] + (size_t)l * D * D, D, 0, D, D, [=](int s) { return d0 + (size_t)s * D; }); }
            { bf16* d0 = (bf16*)Ot; cvt_tiles(F, rot, in[I_WO] + (size_t)l * D * D, D, 0, D, D, [=](int s) { return d0 + (size_t)s * D; }); }
            if (!moe) {
                { bf16* d0 = (bf16*)FGU; cvt_tiles(F, rot, in[I_FG] + (size_t)l2 * D * DFF, DFF, 0, D, DFF, [=](int s) { return d0 + (size_t)(256 * (s >> 7) + (s & 127)) * D; });
                  cvt_tiles(F, rot, in[I_FU] + (size_t)l2 * D * DFF, DFF, 0, D, DFF, [=](int s) { return d0 + (size_t)(256 * (s >> 7) + 128 + (s & 127)) * D; }); }
                { bf16* d0 = (bf16*)FDd; cvt_tiles(F, rot, in[I_FD] + (size_t)l2 * DFF * D, D, 0, DFF, D, [=](int s) { return d0 + (size_t)s * DFF; }); }
            } else {
                if (F.gtid < NEXP) F.ctl[CW_CNT + 64 * F.gtid] = 0u;
            }
            if (l == 0) {
                for (int i = F.gtid; i < 2064 * 64; i += F.gthreads) { const int pos = i >> 6, k = i & 63; const float inv = powf(10000.0f, -(float)k / 64.0f); const float ang = (float)pos * inv;
                    float sn, cs; sincosf(ang, &sn, &cs); ((f32x2*)rope)[i] = (f32x2){cs, sn}; }
                const float* x = in[I_X];
                for (size_t i = (size_t)F.gtid * 4; i < (size_t)M * D; i += (size_t)F.gthreads * 4) store_bf4(HA + i, *(const f32x4*)(x + i));
                for (int i = F.gtid * 4; i < NMETA * D; i += F.gthreads * 4) store_bf4(mA + i, *(const f32x4*)(in[I_META] + i));
            }
        }
        SEAM(pb + 0);

        if (INS(1, pb + 1)) { ENV();
            const float* bg = in[I_BGATE] + (size_t)l * 2 * D;
            { F1 f{mQK, mV, mSIG, mGA, rope, bg, 15, 0};
              meta_gemm(F, 1, N1, D, [=](int, int r) { return mA + (size_t)r * D; }, [=](int, int c) { return B1t + (size_t)c * D; }, [=](int) { return f; }); }
            pg8::SchedDense S; S.init(M, N1, F.G, F.bid, HA, D * 2, B1t, D * 2);
            pg8::EpiRow<F1> E{F1{QK, V, SIG, GA, rope, bg, 2047, 16}};
            pg8::gemm_phase<pg8::EpiRow<F1>, pg8::SchedDense>(F.lds, F.tid, S, E, D, D * 2, D * 2);
        }
        SEAM(pb + 1);

        if (INS(2, pb + 2)) { ENV();
            MixArgs ma{QK, V, GA, mQK, mV, mGA, mO, in[I_WA2] + (size_t)l * 16 * 512, in[I_BA] + (size_t)l * 512, in[I_GNG] + (size_t)l * 256,
                       in[I_RNG] + (size_t)l * 1024, in[I_RNB] + (size_t)l * 1024, 0};
            if (PROBE_DUP & 2) { ma.dry = (PROBE_DUP & 256) ? 2 : 1; mixer_fast(F, ma); ma.dry = 0; }
            mixer_fast(F, ma);
        }
        SEAM(pb + 2);

        if (INS(3, pb + 3)) { ENV();
            { F2 f{mO, mV}; meta_gemm(F, 1, 2048, D, [=](int, int r) { return mA + (size_t)r * D; }, [=](int, int c) { return B2t + (size_t)c * D; }, [=](int) { return f; }); }
            pg8::SchedDense S; S.init(M, 2048, F.G, F.bid, HA, D * 2, B2t, D * 2);
            pg8::EpiRowLd<F2> E{F2{V, V}};
            pg8::gemm_phase<pg8::EpiRowLd<F2>, pg8::SchedDense>(F.lds, F.tid, S, E, D, D * 2, D * 2);
        }
        SEAM(pb + 3);

        if (INS(4, pb + 4)) { ENV();
#pragma unroll 1
            for (int pass = 0; pass < 2; ++pass) {
                const bf16* Wt = pass ? PBt : PAt;
                { F3 f{mMRG, mSIG, pass}; const bf16* mA = mV + pass * 1024; meta_gemm(F, 1, D, D, [=](int, int r) { return mA + (size_t)r * 2048; }, [=](int, int c) { return Wt + (size_t)c * D; }, [=](int) { return f; }); }
            }
            SchedP3 S; S.S.init(M, D, F.G, F.bid, V, 2048 * 2, PAt, D * 2); S.Bt2 = (const char*)PBt;
            pg8::EpiRowLd<F3> E{F3{MRG, SIG, 0}};
            pg8::gemm_phase<pg8::EpiRowLd<F3>, SchedP3>(F.lds, F.tid, S, E, D, 2048 * 2, D * 2);
        }
        SEAM(pb + 4);

        if (INS(5, pb + 5)) { ENV();
            { F4 f{mA, mB}; meta_gemm(F, 1, D, D, [=](int, int r) { return mMRG + (size_t)r * D; }, [=](int, int c) { return Ot + (size_t)c * D; }, [=](int) { return f; }); }
            pg8::SchedDense S; S.init(M, D, F.G, F.bid, MRG, D * 2, Ot, D * 2);
            pg8::EpiRowLd<F4> E{F4{HA, HB}};
            pg8::gemm_phase<pg8::EpiRowLd<F4>, pg8::SchedDense>(F.lds, F.tid, S, E, D, D * 2, D * 2);
        }
        SEAM(pb + 5);

        if (INS(6, pb + 6)) { ENV();
            const float* g = in[I_LN1G] + (size_t)l * D; const float* bb = in[I_LN1B] + (size_t)l * D; const LnPar LP = ln_par(g, bb, F.lane);
            const LAS float* wrt = (const LAS float*)F.lds;
            if (moe) { int rot = 0;
#pragma unroll 1
                for (int e = 0; e < NEXP; ++e) {
                    const float* wg = in[I_MG] + ((size_t)l2 * NEXP + e) * D * DFFE; const float* wu = in[I_MU] + ((size_t)l2 * NEXP + e) * D * DFFE;
                    bf16* d0 = (bf16*)FGU + (size_t)(e * 2) * DFFE * D;
                    cvt_tiles(F, rot, wg, DFFE, 0, D, DFFE, [=](int s) { const int hf = s >= HFF, sl = s - hf * HFF; return d0 + ((size_t)hf * DFFE + 256 * (sl >> 7) + (sl & 127)) * D; });
                    cvt_tiles(F, rot, wu, DFFE, 0, D, DFFE, [=](int s) { const int hf = s >= HFF, sl = s - hf * HFF; return d0 + ((size_t)hf * DFFE + 256 * (sl >> 7) + 128 + (sl & 127)) * D; });
#pragma unroll 1
                    for (int hf = 0; hf < 2; ++hf) { bf16* d1 = (bf16*)FDm + (size_t)(e * 2 + hf) * D * HFF;
                        cvt_tiles(F, rot, in[I_MD] + ((size_t)l2 * NEXP + e) * DFFE * D, D, hf * HFF, HFF, D, [=](int s) { return d1 + (size_t)s * HFF; }); }
                }
                __syncthreads();
                const float* wg_ = in[I_RT] + (size_t)l2 * D * NEXP;
                for (int c = F.tid; c < D; c += NTHR) { const f32x4 wa_ = *(const f32x4*)(wg_ + c * 8), wb_ = *(const f32x4*)(wg_ + c * 8 + 4);
                    const int ln_ = (c & 511) >> 3, k_ = 2 * (c >> 9) + ((c & 7) >> 2), q_ = c & 3; LAS float* d_ = (LAS float*)F.lds + (k_ * 64 + ln_) * 4 + q_;
                    d_[0 * 1024] = wa_[0]; d_[1 * 1024] = wa_[1]; d_[2 * 1024] = wa_[2]; d_[3 * 1024] = wa_[3]; d_[4 * 1024] = wb_[0]; d_[5 * 1024] = wb_[1]; d_[6 * 1024] = wb_[2]; d_[7 * 1024] = wb_[3]; }
                __syncthreads(); }
            {   const int dry = 0;
                int srow = 0, se1 = 0, se2 = 0, nb = 0; float sw1 = 0.f, sw2 = 0.f;
                RawRow nx = raw_load(F.gwave >= M ? mB + (size_t)(F.gwave - M) * D : HB + (size_t)F.gwave * D, F.lane), n2; n2.a = n2.b = zero_u4();
                { const int rn = F.gwave + F.gwaves; if (rn < M + NMETA) n2 = raw_load(rn >= M ? mB + (size_t)(rn - M) * D : HB + (size_t)rn * D, F.lane); }
                for (int r = F.gwave; r < M + NMETA; r += F.gwaves) {
                    const bool ism = r >= M; const int rr = ism ? r - M : r;
                    bf16* p = ism ? mB + (size_t)rr * D : HB + (size_t)rr * D;
                    const RawRow cu = nx; nx = n2; { const int rn = r + 2 * F.gwaves; if (rn < M + NMETA) n2 = raw_load(rn >= M ? mB + (size_t)(rn - M) * D : HB + (size_t)rn * D, F.lane); }
                    f32x4 v[4]; raw_unpack(v, cu); ln_vals(v, LP); rowb_store(v, p, F.lane, dry);
                    if (moe) {
                        int e1, e2; float w1, w2; route_row(v, wrt, F.lane, e1, e2, w1, w2);
                        if (ism) { if (F.lane == 0) { mTokE[rr * 2] = e1; mTokE[rr * 2 + 1] = e2; mTokW[rr * 2] = w1; mTokW[rr * 2 + 1] = w2; } }
                        else { if (F.lane == nb) { srow = rr; se1 = e1; se2 = e2; sw1 = w1; sw2 = w2; } ++nb; }
                    }
                    if (moe && (nb == 64 || r + F.gwaves >= M + NMETA) && nb > 0) {
                        const bool val = F.lane < nb;
                        unsigned long long m1[8], m2[8]; unsigned tote = 0u;
#pragma unroll
                        for (int e = 0; e < 8; ++e) { m1[e] = __ballot(val && se1 == e); m2[e] = __ballot(val && se2 == e);
                            const unsigned c = (unsigned)__builtin_popcountll(m1[e]) + (unsigned)__builtin_popcountll(m2[e]); tote = (F.lane == e) ? c : tote; }
                        unsigned base = 0u; if (F.lane < 8) base = atomicAdd(F.ctl + CW_CNT + 64 * F.lane, tote);
                        unsigned r1 = 0u, r2 = 0u;
#pragma unroll
                        for (int e = 0; e < 8; ++e) { const unsigned be = (unsigned)__builtin_amdgcn_readlane((int)base, e);
                            const unsigned b1 = __builtin_amdgcn_mbcnt_hi((unsigned)(m1[e] >> 32), __builtin_amdgcn_mbcnt_lo((unsigned)m1[e], 0u));
                            const unsigned b2 = __builtin_amdgcn_mbcnt_hi((unsigned)(m2[e] >> 32), __builtin_amdgcn_mbcnt_lo((unsigned)m2[e], 0u));
                            if (se1 == e) r1 = be + b1;
                            if (se2 == e) r2 = be + (unsigned)__builtin_popcountll(m1[e]) + b2; }
                        if (val) { perm[se1 * M + (int)r1] = srow; perm[se2 * M + (int)r2] = srow;
                            tok_slot[srow * 2] = (se1 << 16) | (int)r1; tok_slot[srow * 2 + 1] = (se2 << 16) | (int)r2; tok_w[srow * 2] = sw1; tok_w[srow * 2 + 1] = sw2; }
                        nb = 0;
                    }
                }
            }
        }
        SEAM(pb + 6);

        if (!moe) {
            if (INS(7, pb + 7)) { ENV();
                { F5 f{mU, DFF}; meta_gemm_pair(F, 1, DFF, D, [=](int, int r) { return mB + (size_t)r * D; }, [=](int, int c) { return FGU + (size_t)c * D; }, [=](int) { return f; }); }
                pg8::SchedDense S; S.init(M, 2 * DFF, F.G, F.bid, HB, D * 2, FGU, D * 2);
                pg8::EpiRow<F5> E{F5{U, DFF}};
                pg8::gemm_phase<pg8::EpiRow<F5>, pg8::SchedDense>(F.lds, F.tid, S, E, D, D * 2, D * 2);
            }
            SEAM(pb + 7);
            if (INS(8, pb + 8)) { ENV();
                { F4 f{mB, mA}; meta_gemm(F, 1, D, DFF, [=](int, int r) { return mU + (size_t)r * DFF; }, [=](int, int c) { return FDd + (size_t)c * DFF; }, [=](int) { return f; }); }
                pg8::SchedDense S; S.init(M, D, F.G, F.bid, U, DFF * 2, FDd, DFF * 2);
                pg8::EpiRowLd<F4> E{F4{HB, HA}};
                pg8::gemm_phase<pg8::EpiRowLd<F4>, pg8::SchedDense>(F.lds, F.tid, S, E, DFF, DFF * 2, DFF * 2);
            }
            SEAM(pb + 8);
            if (INS(11, pb + 11)) { ENV();
                const float* g = in[I_LN2G] + (size_t)l * D; const float* bb = in[I_LN2B] + (size_t)l * D; const LnPar LP = ln_par(g, bb, F.lane);
    #pragma unroll 1
            for (int rep = (PROBE_DUP & 4) ? 0 : 1; rep < 2; ++rep)
            { RawRow nx = raw_load(F.gwave >= M ? mA + (size_t)(F.gwave - M) * D : HA + (size_t)F.gwave * D, F.lane), n2; n2.a = n2.b = zero_u4();
            { const int rn = F.gwave + F.gwaves; if (rn < M + NMETA) n2 = raw_load(rn >= M ? mA + (size_t)(rn - M) * D : HA + (size_t)rn * D, F.lane); }
            for (int r = F.gwave; r < M + NMETA; r += F.gwaves) { const int dry = (rep == 0);
                    const bool ism = r >= M; const int rr = ism ? r - M : r;
                    bf16* p = ism ? mA + (size_t)rr * D : HA + (size_t)rr * D;
                    const RawRow cu = nx; nx = n2; { const int rn = r + 2 * F.gwaves; if (rn < M + NMETA) n2 = raw_load(rn >= M ? mA + (size_t)(rn - M) * D : HA + (size_t)rn * D, F.lane); }
                    f32x4 v[4]; raw_unpack(v, cu); ln_vals(v, LP); rowb_store(v, p, F.lane, dry);
                } }
            }
            SEAM(pb + 11);
        } else {
            if (lo <= pb + 11 && hi > pb + 7) { ENV();
                if (F.tid == 0) {
                    unsigned ts = 0, cb = 0;
                    for (int e = 0; e < NEXP; ++e) { const unsigned c = __hip_atomic_load(F.ctl + CW_CNT + 64 * e, __ATOMIC_RELAXED, __HIP_MEMORY_SCOPE_AGENT);
                        F.MISC[16 + e] = c; F.MISC[24 + e] = ts; F.MISC[40 + e] = cb; ts += (c + 255u) >> 8; cb += c; }
                    F.MISC[32] = ts;
                }
                __syncthreads();
            }
#pragma unroll 1
            for (int hf = 0; hf < 2; ++hf) {
                if (INS(9, pb + 7 + 2 * hf)) { ENV();
                    meta_gemm_pair(F, NEXP, HFF, D, [=](int, int r) { return mB + (size_t)r * D; }, [=](int e, int c) { return FGU + ((size_t)(e * 2 + hf) * DFFE + c) * D; },
                              [=](int e) { return F5{mUall + (size_t)e * NMETA * HFF, HFF}; });
                    SchedMoeUp S{F.MISC, perm, (const char*)HB, (const char*)FGU, F.G, F.bid, hf};
                    pg8::EpiRow<F5> E{F5{U, HFF}};
                    pg8::gemm_phase<pg8::EpiRow<F5>, SchedMoeUp>(F.lds, F.tid, S, E, D, D * 2, D * 2);
                }
                SEAM(pb + 7 + 2 * hf);
                if (INS(10, pb + 8 + 2 * hf)) { ENV();
                    meta_gemm(F, NEXP, D, HFF, [=](int e, int r) { return mUall + ((size_t)e * NMETA + r) * HFF; }, [=](int e, int c) { return FDm + ((size_t)(e * 2 + hf) * D + c) * HFF; },
                              [=](int e) { return F6Mm{mYall + (size_t)e * NMETA * D, hf}; });
                    SchedMoeDown S{F.MISC, (const char*)U, (const char*)FDm, F.G, F.bid, hf};
                    pg8::EpiRowLd<F6M> E{F6M{Y, hf}};
                    pg8::gemm_phase<pg8::EpiRowLd<F6M>, SchedMoeDown>(F.lds, F.tid, S, E, HFF, HFF * 2, HFF * 2);
                }
                SEAM(pb + 8 + 2 * hf);
            }
            if (INS(11, pb + 11)) { ENV();
                const float* g = in[I_LN2G] + (size_t)l * D; const float* bb = in[I_LN2B] + (size_t)l * D; const LnPar LP = ln_par(g, bb, F.lane);
                const int dry = 0;
                for (int rr = F.gwave; rr < NMETA; rr += F.gwaves) {
                    f32x4 v[4]; rowb_load(v, mB + (size_t)rr * D, F.lane);
                    const float w1 = mTokW[rr * 2], w2 = mTokW[rr * 2 + 1]; const int me1 = mTokE[rr * 2], me2 = mTokE[rr * 2 + 1];
#pragma unroll
                    for (int j = 0; j < 4; ++j) { const f32x4 y1 = *(const f32x4*)(mYall + ((size_t)me1 * NMETA + rr) * D + rcol(F.lane, j)), y2 = *(const f32x4*)(mYall + ((size_t)me2 * NMETA + rr) * D + rcol(F.lane, j));
                        v[j] = v[j] * ALPHA + y1 * w1 + y2 * w2; }
                    ln_vals(v, LP); rowb_store(v, mA + (size_t)rr * D, F.lane, dry);
                }
                {
                    const unsigned yb0 = F.MISC[40], yb1 = F.MISC[41], yb2 = F.MISC[42], yb3 = F.MISC[43], yb4 = F.MISC[44], yb5 = F.MISC[45], yb6 = F.MISC[46], yb7 = F.MISC[47];
#define YBASE(e) ((e) == 0 ? yb0 : (e) == 1 ? yb1 : (e) == 2 ? yb2 : (e) == 3 ? yb3 : (e) == 4 ? yb4 : (e) == 5 ? yb5 : (e) == 6 ? yb6 : yb7)
                    int r = F.gwave;
                    int sa1 = 0, sa2 = 0; float wa1 = 0.f, wa2 = 0.f;
                    if (r < M) { sa1 = tok_slot[r * 2]; sa2 = tok_slot[r * 2 + 1]; wa1 = tok_w[r * 2]; wa2 = tok_w[r * 2 + 1]; }
                    RawRow nh, ny1, ny2; nh.a = nh.b = ny1.a = ny1.b = ny2.a = ny2.b = zero_u4(); float nw1 = wa1, nw2 = wa2;
                    if (r < M) { nh = raw_load(HB + (size_t)r * D, F.lane);
                        ny1 = raw_load(Y + ((size_t)YBASE(sa1 >> 16) + (size_t)(sa1 & 0xffff)) * D, F.lane); ny2 = raw_load(Y + ((size_t)YBASE(sa2 >> 16) + (size_t)(sa2 & 0xffff)) * D, F.lane); }
                    { const int r1 = r + F.gwaves; if (r1 < M) { sa1 = tok_slot[r1 * 2]; sa2 = tok_slot[r1 * 2 + 1]; wa1 = tok_w[r1 * 2]; wa2 = tok_w[r1 * 2 + 1]; } }
#pragma unroll 1
                    for (; r < M; r += F.gwaves) {
                        const RawRow ch = nh, cy1 = ny1, cy2 = ny2; const float w1 = nw1, w2 = nw2;
                        const int r1 = r + F.gwaves, r2 = r + 2 * F.gwaves;
                        if (r1 < M) { nh = raw_load(HB + (size_t)r1 * D, F.lane); nw1 = wa1; nw2 = wa2;
                            ny1 = raw_load(Y + ((size_t)YBASE(sa1 >> 16) + (size_t)(sa1 & 0xffff)) * D, F.lane); ny2 = raw_load(Y + ((size_t)YBASE(sa2 >> 16) + (size_t)(sa2 & 0xffff)) * D, F.lane); }
                        if (r2 < M) { sa1 = tok_slot[r2 * 2]; sa2 = tok_slot[r2 * 2 + 1]; wa1 = tok_w[r2 * 2]; wa2 = tok_w[r2 * 2 + 1]; }
                        f32x4 v[4], ya[4], yb[4]; raw_unpack(v, ch); raw_unpack(ya, cy1); raw_unpack(yb, cy2);
#pragma unroll
                        for (int j = 0; j < 4; ++j) v[j] = v[j] * ALPHA + ya[j] * w1 + yb[j] * w2;
                        ln_vals(v, LP);
                        if (l == DEPTH - 1) rowf_store(v, OUTF + (size_t)r * D, F.lane, dry);
                        else rowb_store(v, HA + (size_t)r * D, F.lane, dry);
                    }
#undef YBASE
                }
            }
            SEAM(pb + 11);
        }
    }
    if ((PROBE_STAMP >= 0 || PROBE_SPREAD >= 0) && blockIdx.x == 0 && hi == NPHASES) { __syncthreads(); unsigned a_ = MISC_OFF + 512; asm volatile("" : "+v"(a_)); volatile LAS unsigned long long* ck_ = (volatile LAS unsigned long long*)((LAS unsigned char*)lds_raw + a_);
        const unsigned long long dt = ck_[3] - ck_[2], t0 = __builtin_amdgcn_s_memrealtime();
        if (dt < 100000000ull) while (__builtin_amdgcn_s_memrealtime() - t0 < 10ull * dt) __builtin_amdgcn_s_sleep(8); }
#if PROBE_CLK
    { KArgs B_ = kargs(); XcdBarrier bar; bar.bar = (unsigned*)(B_->ws + WS_CTL) + CW_BAR + B_->li * XCD_BAR_WORDS; bar.x = xb_xcc_id(); bar.tid = TIDX(); bar.st = (volatile LAS unsigned*)((LAS unsigned char*)lds_raw + MISC_OFF); xcd_barrier(bar); }
    if (blockIdx.x == 0 && TIDX() == 0 && hi == NPHASES) { volatile LAS unsigned long long* ck = (volatile LAS unsigned long long*)((LAS unsigned char*)lds_raw + MISC_OFF + 512);
        const unsigned long long dc = (unsigned long long)clock64() - ck[0], dr = __builtin_amdgcn_s_memrealtime() - ck[1];
        args.out[0] = (float)((double)dc / (double)dr * 100.0); }
#endif
#undef IN
#undef SEAM
}

extern "C" void kernel_launch(void* const* d_in, const int* in_sizes, int n_in, void* d_out, int out_size, void* d_ws, size_t ws_size, hipStream_t stream) {
    static int grid = 0;
    if (grid == 0) {
        if (n_in != 23 || in_sizes[0] != M * D || out_size != M * D || ws_size < WS_END) { fprintf(stderr, "kernel_launch: unexpected shapes / workspace (%d inputs, ws %zu)\n", n_in, ws_size); grid = -1; return; }
        int dev = 0, cus = 0, per_cu = 0;
        if (hipGetDevice(&dev) != hipSuccess || hipDeviceGetAttribute(&cus, hipDeviceAttributeMultiprocessorCount, dev) != hipSuccess) { grid = -1; return; }
        if (hipFuncSetAttribute((const void*)fwd_kernel, hipFuncAttributeMaxDynamicSharedMemorySize, LDS_BYTES) != hipSuccess) { fprintf(stderr, "kernel_launch: hipFuncSetAttribute failed\n"); grid = -1; return; }
        if (hipOccupancyMaxActiveBlocksPerMultiprocessor(&per_cu, (const void*)fwd_kernel, NTHR, LDS_BYTES) != hipSuccess || per_cu < 1) fprintf(stderr, "kernel_launch: occupancy query says %d\n", per_cu);
        (void)hipGetLastError();
        grid = cus;
    }
    if (grid < 0) return;
    if (hipMemsetAsync((char*)d_ws + WS_CTL, 0, CTL_ZERO_BYTES, stream) != hipSuccess) return;
    Args a{};
    for (int i = 0; i < 23; ++i) a.in[i] = (const float*)d_in[i];
    a.out = (float*)d_out; a.ws = (unsigned char*)d_ws;
#if defined(PROBE_PHASE)
    a.ph_lo = 0; a.ph_hi = PROBE_PHASE + 1; a.li = 0; hipLaunchKernelGGL(fwd_kernel, dim3(grid), dim3(NTHR), LDS_BYTES, stream, a);
    a.ph_lo = PROBE_PHASE; a.ph_hi = PROBE_PHASE + 1; a.li = 1; hipLaunchKernelGGL(fwd_kernel, dim3(grid), dim3(NTHR), LDS_BYTES, stream, a);
    a.ph_lo = PROBE_PHASE + 1; a.ph_hi = NPHASES; a.li = 2; hipLaunchKernelGGL(fwd_kernel, dim3(grid), dim3(NTHR), LDS_BYTES, stream, a);
#elif N_LAUNCH_MODE == 1
    a.ph_lo = 0; a.ph_hi = NPHASES; a.li = 0;
    hipLaunchKernelGGL(fwd_kernel, dim3(grid), dim3(NTHR), LDS_BYTES, stream, a);
#else
    for (int p = 0; p < NPHASES; ++p) {
        const int l = p / NPH, s = p % NPH;
        if ((l & 1) == 0 && (s == 9 || s == 10)) continue;
        a.ph_lo = p; a.ph_hi = p + 1;
        hipLaunchKernelGGL(fwd_kernel, dim3(grid), dim3(NTHR), LDS_BYTES, stream, a);
    }
#endif
}
```

```cpp
#include <hip/hip_runtime.h>
#include <cstdio>
#include <cstdint>

#ifndef N_LAUNCH_MODE
#define N_LAUNCH_MODE 1
#endif

#ifndef PROBE_SPREAD
#define PROBE_SPREAD (-1)
#endif
#ifndef PROBE_STAMP
#define PROBE_STAMP (-1)
#endif
#ifndef PROBE_CLK
#define PROBE_CLK 0
#endif
#ifndef WGM_MOE
#define WGM_MOE 4
#endif
#ifndef WGM_DENSE
#define WGM_DENSE 4
#endif
#ifndef PROBE_DUP
#define PROBE_DUP 0
#endif
#define LAS __attribute__((address_space(3)))
typedef unsigned short bf16;
typedef short bf16x8 __attribute__((ext_vector_type(8)));
typedef float f32x4 __attribute__((ext_vector_type(4)));
typedef float f32x2 __attribute__((ext_vector_type(2)));
typedef unsigned u32x4 __attribute__((ext_vector_type(4)));
typedef unsigned u32x2 __attribute__((ext_vector_type(2)));

constexpr int D = 1024, NB = 32, SEQ = 2048, DEPTH = 4, NMETA = 16;
constexpr int M = NB * SEQ;
constexpr int NIN = 8208;
constexpr int N1 = 6400;
constexpr int DFF = 2816, DFFE = 3584, NEXP = 8, HFF = 1792;
constexpr float ALPHA = 1.681792830507429f;
constexpr float QSCALE = 0.08838834764831845f;
constexpr float LN_EPS = 1e-5f, GN_EPS = 1e-6f;
constexpr int NPH = 12;
constexpr int NPHASES = DEPTH * NPH;

constexpr size_t MiB = 1u << 20;
constexpr size_t WS_CTL = 0, CTL_ZERO_BYTES = 1 * MiB;
constexpr size_t WS_ROPE = 1 * MiB;
constexpr size_t WS_META = 3 * MiB;
constexpr size_t WS_MOE = 4 * MiB;
constexpr size_t WS_GA = 8 * MiB;
constexpr size_t WS_W = 12 * MiB;
constexpr size_t WS_HB = 204 * MiB;
constexpr size_t WS_Y3 = 332 * MiB;
constexpr size_t WS_HA = 460 * MiB;
constexpr size_t WS_QK = 588 * MiB;
constexpr size_t WS_V = 844 * MiB;
constexpr size_t WS_META2 = 1100 * MiB;
constexpr size_t WS_END = 1102 * MiB;
constexpr size_t W_B1 = 0;
constexpr size_t W_B2 = W_B1 + (size_t)N1 * D * 2;
constexpr size_t W_PA = W_B2 + (size_t)2048 * D * 2;
constexpr size_t W_PB = W_PA + (size_t)D * D * 2;
constexpr size_t W_O = W_PB + (size_t)D * D * 2;
constexpr size_t W_F = W_O + (size_t)D * D * 2;
constexpr size_t W_FD_DENSE = W_F + (size_t)2 * DFF * D * 2;
constexpr size_t W_FD_MOE = W_F + (size_t)NEXP * 2 * DFFE * D * 2;
static_assert(W_FD_MOE + (size_t)NEXP * 2 * D * HFF * 2 <= 192 * MiB, "weights fit");
constexpr size_t MT_HA = 0, MT_HB = 65536, MT_XB = 131072, MT_QK = 163840, MT_V = 229376, MT_SIG = 294912, MT_GA = 360448, MT_MRG = 364544,
                 MT_U = 397312  , MT_Y = 512000  , MT_TOK = 643072  , MT_O = 644096  ;
static_assert(MT_O + 65536 <= MiB, "meta map");
constexpr int CW_CNT = 1024;
constexpr int CW_BAR = 4096;

constexpr int RING_BYTES = 131072;
constexpr int LDS_BYTES = 147456;
constexpr int MISC_OFF = LDS_BYTES - 1024;
constexpr int NWAVES = 8, NTHR = 512;

__device__ __forceinline__ f32x4 zero_f4() { float z = 0.f; asm volatile("" : "+v"(z)); return (f32x4){z, z, z, z}; }
__device__ __forceinline__ u32x4 zero_u4() { unsigned z = 0u; asm volatile("" : "+v"(z)); return (u32x4){z, z, z, z}; }
__device__ __forceinline__ unsigned f2bf(float f) { unsigned u = __builtin_bit_cast(unsigned, f); return (u + 0x7fffu + ((u >> 16) & 1u)) >> 16; }
__device__ __forceinline__ float bf2f(unsigned h) { return __builtin_bit_cast(float, (h & 0xffffu) << 16); }
typedef __bf16 bf16x2_t __attribute__((ext_vector_type(2)));
__device__ __forceinline__ unsigned pk2(float lo, float hi) { const f32x2 v = {lo, hi}; return __builtin_bit_cast(unsigned, __builtin_convertvector(v, bf16x2_t)); }
__device__ __forceinline__ unsigned pk2_sw(float lo, float hi) { return pk2(lo, hi); }
__device__ __forceinline__ void store_bf4(bf16* p, f32x4 v) { u32x2 w; w.x = pk2(v[0], v[1]); w.y = pk2(v[2], v[3]); *(u32x2*)p = w; }
__device__ __forceinline__ f32x4 load_bf4(const bf16* p) { const u32x2 w = *(const u32x2*)p; return (f32x4){bf2f(w.x), bf2f(w.x >> 16), bf2f(w.y), bf2f(w.y >> 16)}; }
__device__ __forceinline__ void store_bf8(bf16* p, f32x4 lo, f32x4 hi) { u32x4 w; w.x = pk2(lo[0], lo[1]); w.y = pk2(lo[2], lo[3]); w.z = pk2(hi[0], hi[1]); w.w = pk2(hi[2], hi[3]); *(u32x4*)p = w; }
__device__ __forceinline__ void load_bf8(const bf16* p, f32x4& lo, f32x4& hi) { const u32x4 w = *(const u32x4*)p; lo = (f32x4){bf2f(w.x), bf2f(w.x >> 16), bf2f(w.y), bf2f(w.y >> 16)}; hi = (f32x4){bf2f(w.z), bf2f(w.z >> 16), bf2f(w.w), bf2f(w.w >> 16)}; }
__device__ __forceinline__ void unpack_bf8(const u32x4 w, f32x4& lo, f32x4& hi) { lo = (f32x4){bf2f(w.x), bf2f(w.x >> 16), bf2f(w.y), bf2f(w.y >> 16)}; hi = (f32x4){bf2f(w.z), bf2f(w.z >> 16), bf2f(w.w), bf2f(w.w >> 16)}; }
__device__ __forceinline__ float sigmoidf_(float x) { return __builtin_amdgcn_rcpf(1.0f + __expf(-x)); }
__device__ __forceinline__ float siluf_(float x) { return x * __builtin_amdgcn_rcpf(1.0f + __expf(-x)); }
template <int CTRL> __device__ __forceinline__ float dpp_f(float v) { return __builtin_bit_cast(float, __builtin_amdgcn_update_dpp(0, __builtin_bit_cast(int, v), CTRL, 0xF, 0xF, true)); }
__device__ __forceinline__ float wave_sum(float v) {
    v += dpp_f<0xB1>(v);
    v += dpp_f<0x4E>(v);
    v += dpp_f<0x141>(v);
    v += dpp_f<0x140>(v);
    const int iv = __builtin_bit_cast(int, v);
    const float r0 = __builtin_bit_cast(float, __builtin_amdgcn_readlane(iv, 0)), r1 = __builtin_bit_cast(float, __builtin_amdgcn_readlane(iv, 16)),
                r2 = __builtin_bit_cast(float, __builtin_amdgcn_readlane(iv, 32)), r3 = __builtin_bit_cast(float, __builtin_amdgcn_readlane(iv, 48));
    return (r0 + r1) + (r2 + r3);
}
__device__ __forceinline__ float sum8(float v) { v += dpp_f<0xB1>(v); v += dpp_f<0x4E>(v); v += dpp_f<0x141>(v); return v; }
#define LDS_WAIT() asm volatile("s_waitcnt lgkmcnt(0)" ::: "memory")
#define VM_WAIT() asm volatile("s_waitcnt vmcnt(0)" ::: "memory")

namespace pg8 {
constexpr int BM = 256, BK = 64, HALF = 128, HTB = HALF * BK * 2, STAGE_BYTES = 8 * HTB, NXCD = 8, IDX_OFF = STAGE_BYTES  ;
__host__ __device__ __forceinline__ int lds_byte(int r, int c) { const int st = (r >> 4) * 2 + (c >> 5), rr = r & 15, cc = c & 31, ob = rr * 64 + cc * 2; return st * 1024 + (ob ^ (((ob >> 9) & 1) << 5)); }
__host__ __device__ __forceinline__ void stage_rc(int b, int& R, int& C) { const int st = b / 1024, sb = b % 1024, swz = sb ^ (((sb >> 9) & 1) << 5); R = (st >> 1) * 16 + swz / 64; C = (st & 1) * 32 + (swz % 64) / 2; }

__host__ __device__ __forceinline__ int perm32(int rho) { const int n = rho >> 4, i = rho & 15; return 8 * (i >> 2) + 4 * n + (i & 3); }
struct Unit { const char* A; const char* B; int row0, col0, e, nvalid; };

__device__ __forceinline__ bool unit_order(long L, int nM, int nN, int& pm, int& pn, const int WGM) {
    const int nwg = nM * nN; if (L >= nwg) return false;
    int wgid = (int)L; { const int q = nwg / NXCD, r = nwg % NXCD, xcd = wgid % NXCD, off = wgid / NXCD; wgid = (xcd < r ? xcd * (q + 1) : r * (q + 1) + (xcd - r) * q) + off; }
    const int nig = WGM * nN, gid = wgid / nig, fm = gid * WGM, gsz = (nM - fm) < WGM ? (nM - fm) : WGM;
    pm = fm + ((wgid % nig) % gsz); pn = (wgid % nig) / gsz; return true;
}
struct SchedDense {
    static constexpr bool GATHER = false;
    int nM, nN, nwg, G, c; const char* A; const char* Bt; unsigned lda, ldb;
    __device__ void init(int Mr, int Nc, int G_, int c_, const void* A_, unsigned lda_, const void* Bt_, unsigned ldb_) { nM = Mr / BM; nN = Nc / BM; nwg = nM * nN; G = G_; c = c_; A = (const char*)A_; Bt = (const char*)Bt_; lda = lda_; ldb = ldb_; }
    __device__ bool next(int i, Unit& u) const {
        int pm, pn; if (!unit_order((long)i * G + c, nM, nN, pm, pn, WGM_DENSE)) return false;
        u.A = A + (size_t)pm * BM * lda; u.B = Bt + (size_t)pn * BM * ldb; u.row0 = pm * BM; u.col0 = pn * BM; u.e = 0; u.nvalid = BM; return true;
    }
    __device__ __forceinline__ unsigned a_off(const Unit&, int R, int h) const { return (unsigned)(h * HALF + R) * lda; }
};

template <class F> struct EpiEl {
    static constexpr bool PERM = false;
    F f;
    template <int MODE> __device__ __forceinline__ void loop(const f32x4 (&acc)[2][2][4][2], const Unit& u, int wr, int wc, int fr, int fq) const {
#pragma unroll
        for (int ai = 0; ai < 2; ++ai)
#pragma unroll
            for (int m = 0; m < 4; ++m) { const int r = ai * HALF + wr * 64 + m * 16 + fr;
#pragma unroll
                for (int bj = 0; bj < 2; ++bj)
#pragma unroll
                    for (int n = 0; n < 2; ++n) f.template at<MODE>(u, r, bj * HALF + wc * 32 + n * 16 + 4 * fq, acc[ai][bj][m][n]);
                if (m == 3) asm volatile("" ::: "memory"); }
    }
    __device__ __forceinline__ void operator()(const f32x4 (&acc)[2][2][4][2], const Unit& u, int wr, int wc, int fr, int fq) const {
        if constexpr (F::NMODES == 1) loop<0>(acc, u, wr, wc, fr, fq);
        else {
            const int mode = __builtin_amdgcn_readfirstlane(f.mode(u));
            if (mode == 0) loop<0>(acc, u, wr, wc, fr, fq);
            else if (mode == 1) loop<1>(acc, u, wr, wc, fr, fq);
            else if (mode == 2) loop<2>(acc, u, wr, wc, fr, fq);
            else if (mode == 3) loop<3>(acc, u, wr, wc, fr, fq);
            else loop<4>(acc, u, wr, wc, fr, fq);
        }
    }
};

template <class F> struct EpiRow {
    static constexpr bool PERM = true;
    F f;
    template <int MODE> __device__ __forceinline__ void loop(const f32x4 (&acc)[2][2][4][2], const Unit& u, int wr, int wc, int fr, int fq) const {
#pragma unroll
        for (int ai = 0; ai < 2; ++ai)
#pragma unroll
            for (int m = 0; m < 4; ++m) { f.template row<MODE>(u, ai * HALF + wr * 64 + m * 16 + fr, wc * 32 + 8 * fq, acc[ai][0][m][0], acc[ai][0][m][1], acc[ai][1][m][0], acc[ai][1][m][1]);
                if (m == 3) asm volatile("" ::: "memory"); }
    }
    __device__ __forceinline__ void operator()(const f32x4 (&acc)[2][2][4][2], const Unit& u, int wr, int wc, int fr, int fq) const {
        if constexpr (F::NMODES == 1) loop<0>(acc, u, wr, wc, fr, fq);
        else {
            const int mode = __builtin_amdgcn_readfirstlane(f.mode(u));
            if (mode == 0) loop<0>(acc, u, wr, wc, fr, fq);
            else if (mode == 1) loop<1>(acc, u, wr, wc, fr, fq);
            else if (mode == 2) loop<2>(acc, u, wr, wc, fr, fq);
            else if (mode == 3) loop<3>(acc, u, wr, wc, fr, fq);
            else loop<4>(acc, u, wr, wc, fr, fq);
        }
    }
};

template <class F> struct EpiRowLd {
    static constexpr bool PERM = true;
    F f;
    __device__ __forceinline__ void operator()(const f32x4 (&acc)[2][2][4][2], const Unit& u, int wr, int wc, int fr, int fq) const {
        const int c8 = wc * 32 + 8 * fq;
#pragma unroll
        for (int g0 = 0; g0 < 8; g0 += F::BATCH) {
            u32x4 pre[F::BATCH][F::NPRE];
#pragma unroll
            for (int g = 0; g < F::BATCH; ++g) { const int ai = (g0 + g) >> 2, m = (g0 + g) & 3; f.ld(u, ai * HALF + wr * 64 + m * 16 + fr, c8, pre[g]); }
            asm volatile("" ::: "memory");
#pragma unroll
            for (int g = 0; g < F::BATCH; ++g) { const int ai = (g0 + g) >> 2, m = (g0 + g) & 3;
                f.fin(u, ai * HALF + wr * 64 + m * 16 + fr, c8, pre[g], acc[ai][0][m][0], acc[ai][0][m][1], acc[ai][1][m][0], acc[ai][1][m][1]); }
            asm volatile("" ::: "memory");
        }
    }
};

template <class F> struct EpiF1 {
    static constexpr bool PERM = true;
    F f;
    template <int MODE> __device__ __forceinline__ void loop(const f32x4 (&acc)[2][2][4][2], const Unit& u, int wr, int wc, int fr, int fq) const {
#pragma unroll
        for (int ai = 0; ai < 2; ++ai)
#pragma unroll
            for (int m = 0; m < 4; ++m) { f.template row<MODE>(u, ai * HALF + wr * 64 + m * 16 + fr, wc * 32 + 8 * fq, acc[ai][0][m][0], acc[ai][0][m][1], acc[ai][1][m][0], acc[ai][1][m][1]);
                if (m == 3) asm volatile("" ::: "memory"); }
    }
    __device__ __forceinline__ void loop_rot(const f32x4 (&acc)[2][2][4][2], const Unit& u, int wr, int wc, int fr, int fq) const {
        const int c8 = wc * 32 + 8 * fq; const float s = u.col0 >= 1536 ? QSCALE : 1.f;
#pragma unroll
        for (int ai = 0; ai < 2; ++ai) {
            f32x4 t[4][2];
#pragma unroll
            for (int m = 0; m < 4; ++m) f.rot_ld(u, ai * HALF + wr * 64 + m * 16 + fr, c8, t[m]);
            asm volatile("" ::: "memory");
#pragma unroll
            for (int m = 0; m < 4; ++m) { const int row = u.row0 + ai * HALF + wr * 64 + m * 16 + fr;
                f.rot_half(row, u.col0 + c8, acc[ai][0][m][0], acc[ai][0][m][1], t[m], s); f.rot_half(row, u.col0 + 128 + c8, acc[ai][1][m][0], acc[ai][1][m][1], t[m], s); }
            asm volatile("" ::: "memory");
        }
    }
    __device__ __forceinline__ void loop_sig(const f32x4 (&acc)[2][2][4][2], const Unit& u, int wr, int wc, int fr, int fq) const {
        const int c8 = wc * 32 + 8 * fq, cc = u.col0 + c8 - 4096;
        const f32x4 b0 = *(const f32x4*)(f.bg + cc), b1 = *(const f32x4*)(f.bg + cc + 4), b2 = *(const f32x4*)(f.bg + cc + 128), b3 = *(const f32x4*)(f.bg + cc + 132);
        asm volatile("" ::: "memory");
#pragma unroll
        for (int ai = 0; ai < 2; ++ai)
#pragma unroll
            for (int m = 0; m < 4; ++m) { const int row = u.row0 + ai * HALF + wr * 64 + m * 16 + fr;
                f.sig_half(row, cc, acc[ai][0][m][0], acc[ai][0][m][1], b0, b1); f.sig_half(row, cc + 128, acc[ai][1][m][0], acc[ai][1][m][1], b2, b3); }
    }
    __device__ __forceinline__ void operator()(const f32x4 (&acc)[2][2][4][2], const Unit& u, int wr, int wc, int fr, int fq) const {
        const int mode = __builtin_amdgcn_readfirstlane(f.mode(u));
        if (mode == 0) loop<0>(acc, u, wr, wc, fr, fq);
        else if (mode == 1) loop_rot(acc, u, wr, wc, fr, fq);
        else if (mode == 2) loop<2>(acc, u, wr, wc, fr, fq);
        else if (mode == 3) loop_sig(acc, u, wr, wc, fr, fq);
        else loop<4>(acc, u, wr, wc, fr, fq);
    }
};

template <class Epi, class Sched, bool ALIGN_EPI = true>
__device__ __forceinline__ void gemm_phase(LAS unsigned char* lds, const int tid, const Sched& S, const Epi& E, const int K, const unsigned lda, const unsigned ldb) {
    const int wid = __builtin_amdgcn_readfirstlane(tid >> 6), lane = tid & 63, wr = wid >> 2, wc = wid & 3, fr = lane & 15, fq = lane >> 4;
    const int nt = K / BK;
    int Rr[2], Cc[2]; unsigned voffA[2], voffB[2];
#pragma unroll
    for (int i = 0; i < 2; ++i) { int R, C; stage_rc(tid * 16 + i * 8192, R, C); Rr[i] = R; Cc[i] = C; const int Rb = Epi::PERM ? ((R & ~31) + perm32(R & 31)) : R; voffA[i] = (unsigned)R * lda + (unsigned)C * 2u; voffB[i] = (unsigned)Rb * ldb + (unsigned)C * 2u; }
    const size_t kstep = (size_t)(BK * 2);
    const size_t hstepA = (size_t)HALF * lda, hstepB = (size_t)HALF * ldb;
    const unsigned ldsw = (unsigned)wid * 1024u;
    const int aoff = lds_byte(wr * 64 + fr, fq * 8), boff = lds_byte(wc * 32 + fr, fq * 8);
#define PG8_SA(b, h) (((b) * 2 + (h)) * HTB)
#define PG8_SB(b, h) ((4 + (b) * 2 + (h)) * HTB)
#define PG8_STAGE_B(bufoff, gbase) do { _Pragma("unroll") for (int _i = 0; _i < 2; ++_i) \
        __builtin_amdgcn_global_load_lds((const unsigned*)((const char*)(gbase) + voffB[_i]), (LAS unsigned*)(lds + (bufoff) + ldsw + _i * 8192), 16, 0, 0); } while (0)
#define PG8_STAGE_A(bufoff, gbase, h, ox) do { _Pragma("unroll") for (int _i = 0; _i < 2; ++_i) { \
        const char* _p = Sched::GATHER ? ((const char*)(gbase) + (ox)[h][_i]) : ((const char*)(gbase) + (h) * hstepA + voffA[_i]); \
        __builtin_amdgcn_global_load_lds((const unsigned*)_p, (LAS unsigned*)(lds + (bufoff) + ldsw + _i * 8192), 16, 0, 0); } } while (0)
#define PG8_LDA(dst, b, h) do { _Pragma("unroll") for (int m = 0; m < 4; ++m) _Pragma("unroll") for (int k = 0; k < 2; ++k) dst[m][k] = *(const LAS bf16x8*)(lds + PG8_SA(b, h) + aoff + m * 2048 + k * 1024); } while (0)
#define PG8_LDB(dst, b, h) do { _Pragma("unroll") for (int n = 0; n < 2; ++n) _Pragma("unroll") for (int k = 0; k < 2; ++k) dst[n][k] = *(const LAS bf16x8*)(lds + PG8_SB(b, h) + boff + n * 2048 + k * 1024); } while (0)
#define PG8_MMA(ai, bj, At, Bt) do { __builtin_amdgcn_s_setprio(1); _Pragma("unroll") for (int m = 0; m < 4; ++m) _Pragma("unroll") for (int n = 0; n < 2; ++n) _Pragma("unroll") for (int k = 0; k < 2; ++k) \
        acc[ai][bj][m][n] = __builtin_amdgcn_mfma_f32_16x16x32_bf16(Bt[n][k], At[m][k], acc[ai][bj][m][n], 0, 0, 0); __builtin_amdgcn_s_setprio(0); } while (0)
#define PG8_WAIT_V(n) asm volatile("s_waitcnt vmcnt(" #n ")" ::: "memory")
#define PG8_WAIT_L(n) asm volatile("s_waitcnt lgkmcnt(" #n ")" ::: "memory")
#define PG8_BAR __builtin_amdgcn_s_barrier()
#define PG8_SCHED __builtin_amdgcn_sched_barrier(0)
    Unit cur, nxt; int ui = 0;
    if (!S.next(0, cur)) return;
    f32x4 acc[2][2][4][2];
    float zf_ = 0.f; asm volatile("" : "+v"(zf_));
#pragma unroll
    for (int a = 0; a < 2; ++a)
#pragma unroll
        for (int b = 0; b < 2; ++b)
#pragma unroll
            for (int m = 0; m < 4; ++m)
#pragma unroll
                for (int n = 0; n < 2; ++n) acc[a][b][m][n] = (f32x4){zf_, zf_, zf_, zf_};
    bf16x8 At[4][2], B0[2][2], B1[2][2];
    unsigned oc[2][2];
#pragma unroll
    for (int h = 0; h < 2; ++h)
#pragma unroll
        for (int i = 0; i < 2; ++i) oc[h][i] = Sched::GATHER ? (S.a_off(cur, Rr[i], h) + (unsigned)Cc[i] * 2u) : 0u;
    const char* cA = cur.A; const char* cB = cur.B;
    PG8_STAGE_B(PG8_SB(0, 0), cB); PG8_STAGE_B(PG8_SB(0, 1), cB + hstepB); PG8_STAGE_A(PG8_SA(0, 0), cA, 0, oc); PG8_STAGE_A(PG8_SA(0, 1), cA, 1, oc);
    if (wr == 1) PG8_BAR;
    PG8_WAIT_V(2); PG8_BAR;
    PG8_STAGE_B(PG8_SB(1, 0), cB + kstep); PG8_STAGE_A(PG8_SA(1, 0), cA + kstep, 0, oc); PG8_STAGE_B(PG8_SB(1, 1), cB + hstepB + kstep);
    PG8_WAIT_V(6); PG8_BAR;
    for (;;) {
        const bool has_next = S.next(ui + 1, nxt);
        const char* nA = has_next ? nxt.A : cA; const char* nB = has_next ? nxt.B : cB;
        if constexpr (Sched::GATHER) {
            if (has_next && wid == 0)
                __builtin_amdgcn_global_load_lds((const unsigned*)(S.idx_base(nxt) + lane * 4), (LAS unsigned*)(lds + IDX_OFF), 16, 0, 0);
        }
        for (int t = 0; t < nt; t += 2) {
            const bool last = (t == nt - 2);
            const char* a1 = cA + (size_t)(t + 1) * kstep;
            const char* a2 = last ? nA : cA + (size_t)(t + 2) * kstep; const char* b2 = last ? nB : cB + (size_t)(t + 2) * kstep;
            const char* a3 = a2 + kstep; const char* b3 = b2 + kstep;
            PG8_LDB(B0, 0, 0); PG8_LDB(B1, 0, 1); PG8_SCHED; PG8_LDA(At, 0, 0); PG8_STAGE_A(PG8_SA(1, 1), a1, 1, oc);
            if constexpr (Sched::GATHER) { if (last && has_next) {
#pragma unroll
                for (int h = 0; h < 2; ++h)
#pragma unroll
                    for (int i = 0; i < 2; ++i) { const int rt = h * HALF + Rr[i]; const unsigned tok = *(const LAS unsigned*)(lds + IDX_OFF + (S.row_ok(nxt, rt) ? rt : 0) * 4);
                        oc[h][i] = tok * lda + (unsigned)Cc[i] * 2u; } } }
            PG8_WAIT_V(8); PG8_WAIT_L(0); PG8_BAR; PG8_MMA(0, 0, At, B0); PG8_MMA(0, 1, At, B1); PG8_BAR; PG8_SCHED;
            PG8_LDA(At, 0, 1); PG8_STAGE_B(PG8_SB(0, 0), b2); PG8_STAGE_B(PG8_SB(0, 1), b2 + hstepB); PG8_STAGE_A(PG8_SA(0, 0), a2, 0, oc);
            PG8_WAIT_V(8); PG8_WAIT_L(0); PG8_BAR; PG8_MMA(1, 0, At, B0); PG8_MMA(1, 1, At, B1); PG8_BAR; PG8_SCHED;
            PG8_LDB(B0, 1, 0); PG8_LDB(B1, 1, 1); PG8_SCHED; PG8_LDA(At, 1, 0); PG8_STAGE_A(PG8_SA(0, 1), a2, 1, oc);
            PG8_WAIT_V(8); PG8_WAIT_L(0); PG8_BAR; PG8_MMA(0, 0, At, B0); PG8_MMA(0, 1, At, B1); PG8_BAR; PG8_SCHED;
            PG8_LDA(At, 1, 1); PG8_STAGE_B(PG8_SB(1, 0), b3); PG8_STAGE_B(PG8_SB(1, 1), b3 + hstepB); PG8_STAGE_A(PG8_SA(1, 0), a3, 0, oc);
            PG8_WAIT_V(8); PG8_WAIT_L(0); PG8_BAR; PG8_MMA(1, 0, At, B0); PG8_MMA(1, 1, At, B1); PG8_BAR; PG8_SCHED;
        }
        if constexpr (ALIGN_EPI) { if (wr == 0) PG8_BAR; }
        E(acc, cur, wr, wc, fr, fq);
        if (!has_next) break;
#pragma unroll
        for (int a = 0; a < 2; ++a)
#pragma unroll
            for (int b = 0; b < 2; ++b)
#pragma unroll
                for (int m = 0; m < 4; ++m)
#pragma unroll
                    for (int n = 0; n < 2; ++n) acc[a][b][m][n] = (f32x4){zf_, zf_, zf_, zf_};
        cur = nxt; cA = nA; cB = nB; ++ui;
        if constexpr (ALIGN_EPI) { if (wr == 1) PG8_BAR; }
    }
    PG8_WAIT_V(0);
    if constexpr (!ALIGN_EPI) { if (wr == 0) PG8_BAR; }
    PG8_BAR;
#undef PG8_SA
#undef PG8_SB
#undef PG8_STAGE_A
#undef PG8_STAGE_B
#undef PG8_LDA
#undef PG8_LDB
#undef PG8_MMA
#undef PG8_WAIT_V
#undef PG8_WAIT_L
#undef PG8_BAR
#undef PG8_SCHED
}
}

#define XB_TMO      128
#define XB_XCNT(j)  (256  + 64 * (j))
#define XB_XSUB(j)  (1280 + 64 * (j))
#define XB_XGEN(j)  (2304 + 64 * (j))
#define XB_TOP      3328
#define XB_TOPGEN   3392
#define XCD_BAR_WORDS 3456
#define XB_SPIN_CAP (1u << 18)
__device__ __forceinline__ unsigned xb_ld(unsigned* p)              { return __hip_atomic_load(p, __ATOMIC_RELAXED, __HIP_MEMORY_SCOPE_AGENT); }
__device__ __forceinline__ unsigned xb_add(unsigned* p, unsigned v) { return __hip_atomic_fetch_add(p, v, __ATOMIC_RELAXED, __HIP_MEMORY_SCOPE_AGENT); }
__device__ __forceinline__ unsigned xb_xcc_id() { return (unsigned)__builtin_amdgcn_s_getreg((3 << 11) | 20) & 0xFu; }
#define XB_SPIN(cond, bar) do { unsigned _sp = 0; while (cond) { __builtin_amdgcn_s_sleep(1); \
    if ((++_sp & 255u) == 0u) { if (xb_ld(&(bar)[XB_TMO])) break; if (_sp > XB_SPIN_CAP) { atomicAdd(&(bar)[XB_TMO], 1u); break; } } } } while (0)
__device__ __forceinline__ int tid_from_wave(int wv) { int x; asm volatile("v_mbcnt_lo_u32_b32 %0, -1, 0\n\tv_mbcnt_hi_u32_b32 %0, -1, %0" : "=v"(x)); return (wv << 6) | x; }
struct XcdBarrier { unsigned* bar; unsigned x; volatile LAS unsigned* st; int tid; };
__device__ __forceinline__ XcdBarrier xcd_barrier_post(unsigned* bar, volatile LAS unsigned* st, int tid) {
    XcdBarrier b; b.bar = bar; b.x = xb_xcc_id(); b.st = st; b.tid = tid;
    if (tid == 0) (void)xb_add(&bar[XB_XCNT(b.x)], 1u);
    return b;
}
__device__ __forceinline__ void xcd_barrier_complete(unsigned* bar, unsigned x, unsigned& nloc, unsigned& nx) {
    const unsigned G = gridDim.x * gridDim.y * gridDim.z;
    unsigned sum, cnt, mine, sp = 0u;
    for (;;) {
        sum = 0u; cnt = 0u; mine = 0u;
#pragma unroll
        for (unsigned j = 0; j < 16; ++j) { const unsigned c = xb_ld(&bar[XB_XCNT(j)]); sum += c; cnt += (c > 0u) ? 1u : 0u; mine = (j == x) ? c : mine; }
        if (sum == G) break;
        __builtin_amdgcn_s_sleep(1);
        if ((++sp & 255u) == 0u) { if (xb_ld(&bar[XB_TMO])) break; if (sp > XB_SPIN_CAP) { atomicAdd(&bar[XB_TMO], 1u); break; } }
    }
    nloc = mine > 0u ? mine : 1u; nx = cnt > 0u ? cnt : 1u;
}
__device__ __forceinline__ void xcd_barrier(const XcdBarrier& b) {
    asm volatile("s_waitcnt vmcnt(0)" ::: "memory");
    __syncthreads();
    if (b.tid == 0) {
        unsigned* bar = b.bar;
        __builtin_amdgcn_s_waitcnt(0);
        unsigned nloc = b.st[0], nx = b.st[1];
        if (nloc == 0u) { xcd_barrier_complete(bar, b.x, nloc, nx); b.st[0] = nloc; b.st[1] = nx; }
        const unsigned old = xb_add(&bar[XB_XSUB(b.x)], 1u);
        const unsigned gen = old / nloc;
        if (old + 1u == (gen + 1u) * nloc) {
            __builtin_amdgcn_fence(__ATOMIC_RELEASE, "agent");
            asm volatile("s_waitcnt vmcnt(0)" ::: "memory");
            const unsigned og = xb_add(&bar[XB_TOP], 1u);
            const unsigned tg = og / nx;
            if (og + 1u == (tg + 1u) * nx) xb_add(&bar[XB_TOPGEN], 1u);
            else XB_SPIN(xb_ld(&bar[XB_TOPGEN]) == tg, bar);
            __builtin_amdgcn_fence(__ATOMIC_ACQUIRE, "agent");
            xb_add(&bar[XB_XGEN(b.x)], 1u);
            asm volatile("s_waitcnt vmcnt(0)" ::: "memory");
        } else {
            XB_SPIN(xb_ld(&bar[XB_XGEN(b.x)]) == gen, bar);
            __builtin_amdgcn_fence(__ATOMIC_ACQUIRE, "agent");
            asm volatile("s_waitcnt vmcnt(0)" ::: "memory");
        }
    }
    __syncthreads();
}

struct Args { const float* in[23]; float* out; unsigned char* ws; int ph_lo, ph_hi, li, pad; };
enum { I_X = 0, I_META, I_WIN, I_BGATE, I_WA2, I_BA, I_GNG, I_RNG, I_RNB, I_WPA, I_WPB, I_WO, I_LN1G, I_LN1B, I_FG, I_FU, I_FD, I_RT, I_MG, I_MU, I_MD, I_LN2G, I_LN2B };

struct Frame {
    LAS unsigned char* lds; volatile LAS unsigned* MISC; unsigned* ctl;
    int tid, lane, wave, G, bid, gtid, gthreads, gwave, gwaves;
    unsigned char* ws;
};

template <int N> struct IntC { static constexpr int value = N; };
template <class AR, class BC, class FM>
__device__ __forceinline__ void meta_gemm(const Frame& Fr, int nouter, int ncols, int K, AR arow, BC bcol, FM fmk) {
    const int ntile = ncols >> 4, ntask = nouter * ntile, kw = K >> 3;
    const int lane = Fr.lane, l16 = lane & 15, quad = lane >> 4;
    LAS f32x4* part = (LAS f32x4*)Fr.lds;
#pragma unroll 1
    for (int rep = (PROBE_DUP & 1) ? 0 : 1; rep < 2; ++rep)
#pragma unroll 1
    for (int task = Fr.bid; task < ntask; task += Fr.G) {
        const int o = task / ntile, c0 = (task - o * ntile) * 16;
        const bf16* ap = arow(o, l16) + Fr.wave * kw + 8 * quad; const bf16* bp = bcol(o, c0 + l16) + Fr.wave * kw + 8 * quad;
        f32x4 acc = zero_f4();
        auto batch = [&](auto NB_, int k) __attribute__((always_inline)) { constexpr int NB = decltype(NB_)::value; bf16x8 av[NB], bv[NB];
#pragma unroll
            for (int j = 0; j < NB; ++j) { av[j] = *(const bf16x8*)(ap + k + 32 * j); bv[j] = *(const bf16x8*)(bp + k + 32 * j); }
#pragma unroll
            for (int j = 0; j < NB; ++j) acc = __builtin_amdgcn_mfma_f32_16x16x32_bf16(bv[j], av[j], acc, 0, 0, 0); };
        { int k = 0;
          for (; k + 128 <= kw; k += 128) batch(IntC<4>{}, k);
          const int r_ = (kw - k) >> 5; if (r_ == 3) batch(IntC<3>{}, k); else if (r_ == 2) batch(IntC<2>{}, k); else if (r_ == 1) batch(IntC<1>{}, k); }
        part[Fr.wave * 64 + lane] = acc;
        __syncthreads();
        if (Fr.wave == 0) {
            f32x4 t = part[lane];
#pragma unroll
            for (int w = 1; w < 8; ++w) t = t + part[w * 64 + lane];
            if (rep == 1) {
                auto f = fmk(o);
                pg8::Unit u; u.A = nullptr; u.B = nullptr; u.row0 = 0; u.col0 = c0 & ~255; u.e = 0; u.nvalid = 16;
                const int cc = (c0 & 255) + 4 * quad;
                if constexpr (decltype(f)::NMODES == 1) f.template at<0>(u, l16, cc, t);
                else { const int mode = f.mode(u);
                    if (mode == 0) f.template at<0>(u, l16, cc, t); else if (mode == 1) f.template at<1>(u, l16, cc, t); else if (mode == 2) f.template at<2>(u, l16, cc, t);
                    else if (mode == 3) f.template at<3>(u, l16, cc, t); else f.template at<4>(u, l16, cc, t); }
            }
        }
        __syncthreads();
    }
}

template <class AR, class BC, class FM>
__device__ __forceinline__ void meta_gemm_pair(const Frame& Fr, int nouter, int nff, int K, AR arow, BC bcol, FM fmk) {
    const int ntile = nff >> 4, ntask = nouter * ntile, kw = K >> 3;
    const int lane = Fr.lane, l16 = lane & 15, quad = lane >> 4;
    LAS f32x4* part = (LAS f32x4*)Fr.lds;
#pragma unroll 1
    for (int rep = (PROBE_DUP & 1) ? 0 : 1; rep < 2; ++rep)
#pragma unroll 1
    for (int task = Fr.bid; task < ntask; task += Fr.G) {
        const int o = task / ntile, f0 = (task - o * ntile) * 16, wrow = 256 * (f0 >> 7) + (f0 & 127);
        const bf16* ap = arow(o, l16) + Fr.wave * kw + 8 * quad; const bf16* bp = bcol(o, wrow + l16) + Fr.wave * kw + 8 * quad; const bf16* bp2 = bp + (size_t)128 * K;
        f32x4 ag = zero_f4(), au = ag;
        auto batch = [&](auto NB_, int k) __attribute__((always_inline)) { constexpr int NB = decltype(NB_)::value; bf16x8 av[NB], bg[NB], bu[NB];
#pragma unroll
            for (int j = 0; j < NB; ++j) { av[j] = *(const bf16x8*)(ap + k + 32 * j); bg[j] = *(const bf16x8*)(bp + k + 32 * j); bu[j] = *(const bf16x8*)(bp2 + k + 32 * j); }
#pragma unroll
            for (int j = 0; j < NB; ++j) { ag = __builtin_amdgcn_mfma_f32_16x16x32_bf16(bg[j], av[j], ag, 0, 0, 0); au = __builtin_amdgcn_mfma_f32_16x16x32_bf16(bu[j], av[j], au, 0, 0, 0); } };
        { int k = 0;
          for (; k + 128 <= kw; k += 128) batch(IntC<4>{}, k);
          const int r_ = (kw - k) >> 5; if (r_ == 3) batch(IntC<3>{}, k); else if (r_ == 2) batch(IntC<2>{}, k); else if (r_ == 1) batch(IntC<1>{}, k); }
        part[Fr.wave * 64 + lane] = ag; part[512 + Fr.wave * 64 + lane] = au;
        __syncthreads();
        if (Fr.wave == 0) {
            f32x4 tg = part[lane], tu = part[512 + lane];
#pragma unroll
            for (int w = 1; w < 8; ++w) { tg = tg + part[w * 64 + lane]; tu = tu + part[512 + w * 64 + lane]; }
            if (rep == 1) { auto f = fmk(o); f.pair(l16, f0 + 4 * quad, tg, tu); }
        }
        __syncthreads();
    }
}

struct F1 {
    static constexpr int NMODES = 5;
    bf16* QK; bf16* V; bf16* SIG; float* GA; const f32x2* rope; const float* bg; int posmask, posbase;
    __device__ __forceinline__ int mode(const pg8::Unit& u) const { const int c = u.col0; return c < 1024 ? 0 : (c < 2048 ? 1 : (c < 4096 ? 2 : (c < 6144 ? 3 : 4))); }
    template <int MODE> __device__ __forceinline__ void at(const pg8::Unit& u, int r, int c, f32x4 v) const {
        const int row = u.row0 + r, col = u.col0 + c;
        if (MODE == 0) { const float s = col < 512 ? QSCALE : 1.f; store_bf4(QK + (size_t)row * 2048 + col, v * s); }
        else if (MODE == 1) {
            const int j = (col - 1024) & 127, pos = (row & posmask) + posbase; const f32x2 c0 = rope[pos * 64 + (j >> 1)], c1 = rope[pos * 64 + (j >> 1) + 1];
            const float s = col >= 1536 ? QSCALE : 1.f;
            f32x4 o; o[0] = (v[0] * c0.x - v[1] * c0.y) * s; o[1] = (v[0] * c0.y + v[1] * c0.x) * s; o[2] = (v[2] * c1.x - v[3] * c1.y) * s; o[3] = (v[2] * c1.y + v[3] * c1.x) * s;
            store_bf4(QK + (size_t)row * 2048 + col, o);
        }
        else if (MODE == 2) store_bf4(V + (size_t)row * 2048 + (col - 2048), v);
        else if (MODE == 3) { const int cc = col - 4096; const f32x4 b = *(const f32x4*)(bg + cc);
            f32x4 o; o[0] = sigmoidf_(v[0] + b[0]); o[1] = sigmoidf_(v[1] + b[1]); o[2] = sigmoidf_(v[2] + b[2]); o[3] = sigmoidf_(v[3] + b[3]);
            store_bf4(SIG + (size_t)row * 2048 + cc, o); }
        else { if (col < 6160) *(f32x4*)(GA + (size_t)row * 16 + (col - 6144)) = v; }
    }
    template <int MODE> __device__ __forceinline__ void half8(int row, int col, f32x4 lo, f32x4 hi) const {
        if (MODE == 0) { const float s = col < 512 ? QSCALE : 1.f; store_bf8(QK + (size_t)row * 2048 + col, lo * s, hi * s); }
        else if (MODE == 1) {
            const int j = (col - 1024) & 127, pos = (row & posmask) + posbase; const f32x4* rp = (const f32x4*)(rope + pos * 64 + (j >> 1)); const f32x4 t0 = rp[0], t1 = rp[1];
            const float s = col >= 1536 ? QSCALE : 1.f;
            f32x4 o0, o1;
            o0[0] = (lo[0] * t0[0] - lo[1] * t0[1]) * s; o0[1] = (lo[0] * t0[1] + lo[1] * t0[0]) * s; o0[2] = (lo[2] * t0[2] - lo[3] * t0[3]) * s; o0[3] = (lo[2] * t0[3] + lo[3] * t0[2]) * s;
            o1[0] = (hi[0] * t1[0] - hi[1] * t1[1]) * s; o1[1] = (hi[0] * t1[1] + hi[1] * t1[0]) * s; o1[2] = (hi[2] * t1[2] - hi[3] * t1[3]) * s; o1[3] = (hi[2] * t1[3] + hi[3] * t1[2]) * s;
            store_bf8(QK + (size_t)row * 2048 + col, o0, o1);
        }
        else if (MODE == 2) store_bf8(V + (size_t)row * 2048 + (col - 2048), lo, hi);
        else if (MODE == 3) { const int cc = col - 4096; const f32x4 b0 = *(const f32x4*)(bg + cc), b1 = *(const f32x4*)(bg + cc + 4);
            f32x4 o0, o1;
#pragma unroll
            for (int i = 0; i < 4; ++i) { o0[i] = sigmoidf_(lo[i] + b0[i]); o1[i] = sigmoidf_(hi[i] + b1[i]); }
            store_bf8(SIG + (size_t)row * 2048 + cc, o0, o1); }
        else { if (col < 6160) { *(f32x4*)(GA + (size_t)row * 16 + (col - 6144)) = lo; *(f32x4*)(GA + (size_t)row * 16 + (col - 6144) + 4) = hi; } }
    }
    template <int MODE> __device__ __forceinline__ void row(const pg8::Unit& u, int r, int c8, f32x4 a0, f32x4 a1, f32x4 b0, f32x4 b1) const {
        half8<MODE>(u.row0 + r, u.col0 + c8, a0, a1); half8<MODE>(u.row0 + r, u.col0 + 128 + c8, b0, b1);
    }
    __device__ __forceinline__ void rot_ld(const pg8::Unit& u, int r, int c8, f32x4 (&t)[2]) const {
        const int pos = ((u.row0 + r) & posmask) + posbase; const f32x4* rp = (const f32x4*)(rope + pos * 64 + (c8 >> 1)); t[0] = rp[0]; t[1] = rp[1]; }
    __device__ __forceinline__ void rot_half(int row, int col, f32x4 lo, f32x4 hi, const f32x4 (&t)[2], float s) const {
        const f32x4 t0 = t[0], t1 = t[1]; f32x4 o0, o1;
        o0[0] = (lo[0] * t0[0] - lo[1] * t0[1]) * s; o0[1] = (lo[0] * t0[1] + lo[1] * t0[0]) * s; o0[2] = (lo[2] * t0[2] - lo[3] * t0[3]) * s; o0[3] = (lo[2] * t0[3] + lo[3] * t0[2]) * s;
        o1[0] = (hi[0] * t1[0] - hi[1] * t1[1]) * s; o1[1] = (hi[0] * t1[1] + hi[1] * t1[0]) * s; o1[2] = (hi[2] * t1[2] - hi[3] * t1[3]) * s; o1[3] = (hi[2] * t1[3] + hi[3] * t1[2]) * s;
        store_bf8(QK + (size_t)row * 2048 + col, o0, o1); }
    __device__ __forceinline__ void sig_half(int row, int cc, f32x4 lo, f32x4 hi, f32x4 b0, f32x4 b1) const {
        f32x4 o0, o1;
#pragma unroll
        for (int i = 0; i < 4; ++i) { o0[i] = sigmoidf_(lo[i] + b0[i]); o1[i] = sigmoidf_(hi[i] + b1[i]); }
        store_bf8(SIG + (size_t)row * 2048 + cc, o0, o1); }
};
struct F2 {
    static constexpr int NMODES = 1;
    const bf16* O; bf16* V;
    template <int MODE> __device__ __forceinline__ void at(const pg8::Unit& u, int r, int c, f32x4 v) const {
        const size_t off = (size_t)(u.row0 + r) * 2048 + u.col0 + c; bf16* p = V + off; const f32x4 o = load_bf4(O + off);
        f32x4 w; w[0] = siluf_(v[0]) * o[0]; w[1] = siluf_(v[1]) * o[1]; w[2] = siluf_(v[2]) * o[2]; w[3] = siluf_(v[3]) * o[3];
        store_bf4(p, w);
    }
    __device__ __forceinline__ void half8(size_t off, f32x4 lo, f32x4 hi) const {
        f32x4 o0, o1; load_bf8(O + off, o0, o1);
#pragma unroll
        for (int i = 0; i < 4; ++i) { o0[i] *= siluf_(lo[i]); o1[i] *= siluf_(hi[i]); }
        store_bf8(V + off, o0, o1);
    }
    template <int MODE> __device__ __forceinline__ void row(const pg8::Unit& u, int r, int c8, f32x4 a0, f32x4 a1, f32x4 b0, f32x4 b1) const {
        const size_t off = (size_t)(u.row0 + r) * 2048 + u.col0 + c8; half8(off, a0, a1); half8(off + 128, b0, b1);
    }
    static constexpr int NPRE = 2, BATCH = 2;
    __device__ __forceinline__ void ld(const pg8::Unit& u, int r, int c8, u32x4 (&p)[2]) const { const size_t off = (size_t)(u.row0 + r) * 2048 + u.col0 + c8; p[0] = *(const u32x4*)(O + off); p[1] = *(const u32x4*)(O + off + 128); }
    __device__ __forceinline__ void fin(const pg8::Unit& u, int r, int c8, const u32x4 (&p)[2], f32x4 a0, f32x4 a1, f32x4 b0, f32x4 b1) const {
        const size_t off = (size_t)(u.row0 + r) * 2048 + u.col0 + c8; f32x4 o0, o1, o2, o3; unpack_bf8(p[0], o0, o1); unpack_bf8(p[1], o2, o3);
#pragma unroll
        for (int i = 0; i < 4; ++i) { o0[i] *= siluf_(a0[i]); o1[i] *= siluf_(a1[i]); o2[i] *= siluf_(b0[i]); o3[i] *= siluf_(b1[i]); }
        store_bf8(V + off, o0, o1); store_bf8(V + off + 128, o2, o3);
    }
};
struct F3 {
    static constexpr int NMODES = 1;
    bf16* MRG; const bf16* SIG; int second;
    template <int MODE> __device__ __forceinline__ void at(const pg8::Unit& u, int r, int c, f32x4 v) const {
        const int row = u.row0 + r, col = u.col0 + c; bf16* p = MRG + (size_t)row * 1024 + col;
        const f32x4 g = load_bf4(SIG + (size_t)row * 2048 + second * 1024 + col); f32x4 o = g * v;
        if (second) o = o + load_bf4(p);
        store_bf4(p, o);
    }
    __device__ __forceinline__ void half8(int row, int col, f32x4 lo, f32x4 hi) const {
        bf16* p = MRG + (size_t)row * 1024 + col; f32x4 g0, g1; load_bf8(SIG + (size_t)row * 2048 + second * 1024 + col, g0, g1);
        f32x4 o0 = g0 * lo, o1 = g1 * hi;
        if (second) { f32x4 m0, m1; load_bf8(p, m0, m1); o0 = o0 + m0; o1 = o1 + m1; }
        store_bf8(p, o0, o1);
    }
    template <int MODE> __device__ __forceinline__ void row(const pg8::Unit& u, int r, int c8, f32x4 a0, f32x4 a1, f32x4 b0, f32x4 b1) const {
        half8(u.row0 + r, u.col0 + c8, a0, a1); half8(u.row0 + r, u.col0 + 128 + c8, b0, b1);
    }
    static constexpr int NPRE = 4, BATCH = 2;
    __device__ __forceinline__ void ld(const pg8::Unit& u, int r, int c8, u32x4 (&p)[4]) const {
        const int row = u.row0 + r, col = u.col0 + c8; const bf16* sg = SIG + (size_t)row * 2048 + second * 1024 + col; const bf16* mp = MRG + (size_t)row * 1024 + col;
        p[0] = *(const u32x4*)sg; p[1] = *(const u32x4*)(sg + 128);
        if (second) { p[2] = *(const u32x4*)mp; p[3] = *(const u32x4*)(mp + 128); } else { p[2] = p[0]; p[3] = p[1]; }
    }
    __device__ __forceinline__ void fin(const pg8::Unit& u, int r, int c8, const u32x4 (&p)[4], f32x4 a0, f32x4 a1, f32x4 b0, f32x4 b1) const {
        const int row = u.row0 + r, col = u.col0 + c8; bf16* mp = MRG + (size_t)row * 1024 + col;
        f32x4 g0, g1, g2, g3, m0, m1, m2, m3; unpack_bf8(p[0], g0, g1); unpack_bf8(p[1], g2, g3); unpack_bf8(p[2], m0, m1); unpack_bf8(p[3], m2, m3);
        f32x4 o0 = g0 * a0, o1 = g1 * a1, o2 = g2 * b0, o3 = g3 * b1;
        if (second) { o0 = o0 + m0; o1 = o1 + m1; o2 = o2 + m2; o3 = o3 + m3; }
        store_bf8(mp, o0, o1); store_bf8(mp + 128, o2, o3);
    }
};
struct F4 {
    static constexpr int NMODES = 1;
    const bf16* RES; bf16* OUT;
    template <int MODE> __device__ __forceinline__ void at(const pg8::Unit& u, int r, int c, f32x4 v) const {
        const size_t o = (size_t)(u.row0 + r) * 1024 + u.col0 + c; store_bf4(OUT + o, load_bf4(RES + o) * ALPHA + v);
    }
    __device__ __forceinline__ void half8(size_t o, f32x4 lo, f32x4 hi) const { f32x4 r0, r1; load_bf8(RES + o, r0, r1); store_bf8(OUT + o, r0 * ALPHA + lo, r1 * ALPHA + hi); }
    template <int MODE> __device__ __forceinline__ void row(const pg8::Unit& u, int r, int c8, f32x4 a0, f32x4 a1, f32x4 b0, f32x4 b1) const {
        const size_t o = (size_t)(u.row0 + r) * 1024 + u.col0 + c8; half8(o, a0, a1); half8(o + 128, b0, b1);
    }
    static constexpr int NPRE = 2, BATCH = 4;
    __device__ __forceinline__ void ld(const pg8::Unit& u, int r, int c8, u32x4 (&p)[2]) const { const size_t o = (size_t)(u.row0 + r) * 1024 + u.col0 + c8; p[0] = *(const u32x4*)(RES + o); p[1] = *(const u32x4*)(RES + o + 128); }
    __device__ __forceinline__ void fin(const pg8::Unit& u, int r, int c8, const u32x4 (&p)[2], f32x4 a0, f32x4 a1, f32x4 b0, f32x4 b1) const {
        const size_t o = (size_t)(u.row0 + r) * 1024 + u.col0 + c8; f32x4 r0, r1, r2, r3; unpack_bf8(p[0], r0, r1); unpack_bf8(p[1], r2, r3);
        store_bf8(OUT + o, r0 * ALPHA + a0, r1 * ALPHA + a1); store_bf8(OUT + o + 128, r2 * ALPHA + b0, r3 * ALPHA + b1);
    }
};
struct F5 {
    static constexpr int NMODES = 1;
    bf16* U; int ldu;
    template <int MODE> __device__ __forceinline__ void row(const pg8::Unit& u, int r, int c8, f32x4 a0, f32x4 a1, f32x4 b0, f32x4 b1) const {
        f32x4 o0, o1;
#pragma unroll
        for (int i = 0; i < 4; ++i) { o0[i] = siluf_(a0[i]) * b0[i]; o1[i] = siluf_(a1[i]) * b1[i]; }
        store_bf8(U + (size_t)(u.row0 + r) * ldu + (u.col0 >> 1) + c8, o0, o1);
    }
    __device__ __forceinline__ void pair(int r, int f, f32x4 g, f32x4 uu) const {
        f32x4 o; o[0] = siluf_(g[0]) * uu[0]; o[1] = siluf_(g[1]) * uu[1]; o[2] = siluf_(g[2]) * uu[2]; o[3] = siluf_(g[3]) * uu[3];
        store_bf4(U + (size_t)r * ldu + f, o);
    }
};
struct F6M {
    static constexpr int NMODES = 1;
    bf16* Y; int second;
    template <int MODE> __device__ __forceinline__ void at(const pg8::Unit& u, int r, int c, f32x4 v) const {
        if (r >= u.nvalid) return;
        bf16* p = Y + (size_t)(u.row0 + r) * 1024 + u.col0 + c;
        if (second) v = v + load_bf4(p);
        store_bf4(p, v);
    }
    template <int MODE> __device__ __forceinline__ void row(const pg8::Unit& u, int r, int c8, f32x4 a0, f32x4 a1, f32x4 b0, f32x4 b1) const {
        if (r >= u.nvalid) return;
        bf16* p = Y + (size_t)(u.row0 + r) * 1024 + u.col0 + c8;
        if (second) { f32x4 m0, m1; load_bf8(p, m0, m1); a0 = a0 + m0; a1 = a1 + m1; load_bf8(p + 128, m0, m1); b0 = b0 + m0; b1 = b1 + m1; }
        store_bf8(p, a0, a1); store_bf8(p + 128, b0, b1);
    }
    static constexpr int NPRE = 2, BATCH = 4;
    __device__ __forceinline__ void ld(const pg8::Unit& u, int r, int c8, u32x4 (&p)[2]) const {
        { unsigned z_ = (unsigned)r; z_ ^= z_; asm volatile("" : "+v"(z_)); p[0] = (u32x4){z_, z_, z_, z_}; p[1] = p[0]; }
        if (second && r < u.nvalid) { const bf16* q = Y + (size_t)(u.row0 + r) * 1024 + u.col0 + c8; p[0] = *(const u32x4*)q; p[1] = *(const u32x4*)(q + 128); }
    }
    __device__ __forceinline__ void fin(const pg8::Unit& u, int r, int c8, const u32x4 (&p)[2], f32x4 a0, f32x4 a1, f32x4 b0, f32x4 b1) const {
        if (r >= u.nvalid) return;
        bf16* q = Y + (size_t)(u.row0 + r) * 1024 + u.col0 + c8; f32x4 m0, m1, m2, m3; unpack_bf8(p[0], m0, m1); unpack_bf8(p[1], m2, m3);
        store_bf8(q, a0 + m0, a1 + m1); store_bf8(q + 128, b0 + m2, b1 + m3);
    }
};
struct F6Mm {
    static constexpr int NMODES = 1;
    float* Y; int second;
    template <int MODE> __device__ __forceinline__ void at(const pg8::Unit& u, int r, int c, f32x4 v) const {
        float* p = Y + (size_t)r * 1024 + u.col0 + c;
        if (second) v = v + *(const f32x4*)p;
        *(f32x4*)p = v;
    }
};

struct SchedMoeUp {
    static constexpr bool GATHER = true;
    volatile LAS unsigned* T; const int* perm; const char* A; const char* W; int G, c, hf;
    __device__ bool next(int i, pg8::Unit& u) const {
        const int TT = (int)T[32]; int gt, pn; if (!pg8::unit_order((long)i * G + c, TT, 14, gt, pn, WGM_MOE)) return false;
        int e = 0;
#pragma unroll
        for (int j = 1; j < 8; ++j) e += (gt >= (int)T[24 + j]) ? 1 : 0;
        u.A = A; u.B = W + ((size_t)(e * 2 + hf) * DFFE + (size_t)pn * 256) * (D * 2); u.row0 = gt * 256; u.col0 = pn * 256; u.e = e; u.nvalid = gt - (int)T[24 + e];
        return true;
    }
    __device__ __forceinline__ const int* idx_ptr(const pg8::Unit& u, int R, int h) const {
        const int rank = u.nvalid * 256 + h * 128 + R, cnt = (int)T[16 + u.e];
        return perm + u.e * M + (rank < cnt ? rank : 0);
    }
    __device__ __forceinline__ unsigned a_off(const pg8::Unit& u, int R, int h) const { return (unsigned)(*idx_ptr(u, R, h)) * (unsigned)(D * 2); }
    __device__ __forceinline__ const int* idx_base(const pg8::Unit& u) const { return perm + u.e * M + u.nvalid * 256; }
    __device__ __forceinline__ bool row_ok(const pg8::Unit& u, int rt) const { return u.nvalid * 256 + rt < (int)T[16 + u.e]; }
};
struct SchedMoeDown {
    static constexpr bool GATHER = false;
    volatile LAS unsigned* T; const char* A; const char* W; int G, c, hf;
    __device__ bool next(int i, pg8::Unit& u) const {
        const int TT = (int)T[32]; int gt, pn; if (!pg8::unit_order((long)i * G + c, TT, 4, gt, pn, WGM_MOE)) return false;
        int e = 0;
#pragma unroll
        for (int j = 1; j < 8; ++j) e += (gt >= (int)T[24 + j]) ? 1 : 0;
        const int ti = gt - (int)T[24 + e], cnt = (int)T[16 + e];
        u.A = A + (size_t)gt * 256 * (HFF * 2); u.B = W + ((size_t)(e * 2 + hf) * D + (size_t)pn * 256) * (HFF * 2);
        u.row0 = (int)T[40 + e] + ti * 256; u.col0 = pn * 256; u.e = e; u.nvalid = (cnt - ti * 256) < 256 ? (cnt - ti * 256) : 256;
        return true;
    }
    __device__ __forceinline__ unsigned a_off(const pg8::Unit&, int R, int h) const { return (unsigned)(h * 128 + R) * (unsigned)(HFF * 2); }
};

template <class DST>
__device__ __forceinline__ void cvt_tiles(const Frame& F, int& rot, const float* W, int ldsrc, int koff, int K, int ns, DST dst) {
    LAS unsigned char* T = F.lds + F.wave * 16384;
    const int nsb = (ns + 63) >> 6, items = (K >> 6) * nsb, lane = F.lane;
    int start = F.gwave - rot; if (start < 0) start += F.gwaves;
    const int sl4 = 4 * (lane & 15), c = lane & 7;
    f32x4 cur[16], nxt[16];
#pragma unroll
    for (int j = 0; j < 16; ++j) { cur[j] = zero_f4(); nxt[j] = cur[j]; }
#define CVT_LOAD(dst, it_) do { const int sb_ = (it_) / (K >> 6), kb_ = (it_) - sb_ * (K >> 6), s_ = 64 * sb_ + sl4; \
        if (s_ < ns) { const float* src_ = W + (size_t)(koff + 64 * kb_ + (lane >> 4)) * ldsrc + s_; \
            _Pragma("unroll") for (int j = 0; j < 16; ++j) dst[j] = *(const f32x4*)(src_ + (size_t)(4 * j) * ldsrc); } \
        else { _Pragma("unroll") for (int j = 0; j < 16; ++j) dst[j] = zero_f4(); } } while (0)
    if (start < items) CVT_LOAD(cur, start);
    for (int it = start; it < items; it += F.gwaves) {
        const int sb = it / (K >> 6), kb = it - sb * (K >> 6), k0 = 64 * kb, s0 = 64 * sb;
        { const int itn = it + F.gwaves; if (itn < items) CVT_LOAD(nxt, itn); }
#pragma unroll
        for (int j = 0; j < 16; ++j) { const int kk = 4 * j + (lane >> 4); const f32x4 v = cur[j];
            u32x2 w; w.x = pk2(v[0], v[1]); w.y = pk2(v[2], v[3]);
            *(LAS u32x2*)(T + kk * 136 + sl4 * 2) = w; }
        LDS_WAIT(); asm volatile("" ::: "memory");
#pragma unroll
        for (int jj = 0; jj < 8; ++jj) { const int sl = (lane >> 3) + 8 * jj; const LAS bf16* t = (const LAS bf16*)(T + (8 * c) * 136 + sl * 2);
            u32x4 o; o.x = (unsigned)t[0] | ((unsigned)t[68] << 16); o.y = (unsigned)t[136] | ((unsigned)t[204] << 16); o.z = (unsigned)t[272] | ((unsigned)t[340] << 16); o.w = (unsigned)t[408] | ((unsigned)t[476] << 16);
            bf16* d = (s0 + sl < ns) ? dst(s0 + sl) : nullptr;
            if (d) *(u32x4*)(d + k0 + 8 * c) = o; }
        LDS_WAIT(); asm volatile("" ::: "memory");
#pragma unroll
        for (int j = 0; j < 16; ++j) cur[j] = nxt[j];
    }
#undef CVT_LOAD
    rot = (rot + items) % F.gwaves;
}
__device__ __forceinline__ bf16* dst_win(int s, bf16* B1, bf16* B2) {
    int n; bf16* base = B1;
    if (s < 1024) n = s;
    else if (s < 2048) n = 2048 + (s - 1024);
    else if (s < 3072) { base = B2; n = s - 2048; }
    else if (s < 3088) n = 6144 + (s - 3072);
    else if (s < 4112) { const int t = s - 3088, blk = t >> 9, hh = (t >> 7) & 3, jp = t & 127; n = 1024 + blk * 512 + hh * 128 + 2 * (jp & 63) + (jp >> 6); }
    else if (s < 5136) n = 3072 + (s - 4112);
    else if (s < 6160) { base = B2; n = 1024 + (s - 5136); }
    else if (s < 7184) n = 4096 + (s - 6160);
    else n = 5120 + (s - 7184);
    return base + (size_t)n * D;
}

__device__ __forceinline__ int rcol(int lane, int k) { return 8 * lane + 512 * (k >> 1) + 4 * (k & 1); }
struct LnPar { f32x4 g[4], b[4]; };
__device__ __forceinline__ LnPar ln_par(const float* g, const float* b, int lane) { LnPar P;
#pragma unroll
    for (int j = 0; j < 4; ++j) { P.g[j] = *(const f32x4*)(g + rcol(lane, j)); P.b[j] = *(const f32x4*)(b + rcol(lane, j)); }
    return P; }
__device__ __forceinline__ void ln_vals(f32x4 (&v)[4], const LnPar& P) {
    float s = 0.f;
#pragma unroll
    for (int j = 0; j < 4; ++j) s += (v[j][0] + v[j][1]) + (v[j][2] + v[j][3]);
    const float mean = wave_sum(s) * (1.f / D); float s2 = 0.f;
#pragma unroll
    for (int j = 0; j < 4; ++j) { v[j] = v[j] - mean; s2 += (v[j][0] * v[j][0] + v[j][1] * v[j][1]) + (v[j][2] * v[j][2] + v[j][3] * v[j][3]); }
    const float rstd = 1.f / sqrtf(wave_sum(s2) * (1.f / D) + LN_EPS);
#pragma unroll
    for (int j = 0; j < 4; ++j) v[j] = v[j] * rstd * P.g[j] + P.b[j];
}
struct RawRow { u32x4 a, b; };
__device__ __forceinline__ RawRow raw_load(const bf16* p, int lane) { RawRow r; r.a = *(const u32x4*)(p + 8 * lane); r.b = *(const u32x4*)(p + 512 + 8 * lane); return r; }
__device__ __forceinline__ void raw_unpack(f32x4 (&v)[4], const RawRow& r) {
    v[0] = (f32x4){bf2f(r.a.x), bf2f(r.a.x >> 16), bf2f(r.a.y), bf2f(r.a.y >> 16)}; v[1] = (f32x4){bf2f(r.a.z), bf2f(r.a.z >> 16), bf2f(r.a.w), bf2f(r.a.w >> 16)};
    v[2] = (f32x4){bf2f(r.b.x), bf2f(r.b.x >> 16), bf2f(r.b.y), bf2f(r.b.y >> 16)}; v[3] = (f32x4){bf2f(r.b.z), bf2f(r.b.z >> 16), bf2f(r.b.w), bf2f(r.b.w >> 16)};
}
__device__ __forceinline__ void rowb_load(f32x4 (&v)[4], const bf16* p, int lane) { load_bf8(p + 8 * lane, v[0], v[1]); load_bf8(p + 512 + 8 * lane, v[2], v[3]); }
__device__ __forceinline__ void rowb_store(const f32x4 (&v)[4], bf16* p, int lane, int dry = 0) { if (dry) return; store_bf8(p + 8 * lane, v[0], v[1]); store_bf8(p + 512 + 8 * lane, v[2], v[3]); }
__device__ __forceinline__ void rowf_store(const f32x4 (&v)[4], float* p, int lane, int dry = 0) {
    if (dry) return;
#pragma unroll
    for (int j = 0; j < 4; ++j) *(f32x4*)(p + rcol(lane, j)) = v[j];
}
__device__ __forceinline__ void route_row(const f32x4 (&v)[4], const f32x4 (&wr)[8][4], int lane, int& e1, int& e2, float& w1, float& w2) {
    float lg[8];
#pragma unroll
    for (int e = 0; e < 8; ++e) { f32x2 a2;
#pragma unroll
        for (int k = 0; k < 4; ++k) { const f32x4 w = wr[e][k];
            if (k == 0) a2 = (f32x2){v[0][0], v[0][1]} * (f32x2){w[0], w[1]}; else a2 += (f32x2){v[k][0], v[k][1]} * (f32x2){w[0], w[1]};
            a2 += (f32x2){v[k][2], v[k][3]} * (f32x2){w[2], w[3]}; }
        lg[e] = a2.x + a2.y; }
    {
        const bool b3 = (lane & 8) != 0, b2 = (lane & 4) != 0, b1 = (lane & 2) != 0;
        float t[4], u[2];
#pragma unroll
        for (int e = 0; e < 4; ++e) { const float keep = b3 ? lg[e + 4] : lg[e], send = b3 ? lg[e] : lg[e + 4]; t[e] = keep + dpp_f<0x140>(send); }
#pragma unroll
        for (int e = 0; e < 2; ++e) { const float keep = b2 ? t[e + 2] : t[e], send = b2 ? t[e] : t[e + 2]; u[e] = keep + dpp_f<0x141>(send); }
        float x = (b1 ? u[1] : u[0]) + dpp_f<0x4E>(b1 ? u[0] : u[1]);
        x += dpp_f<0xB1>(x);
        x += __builtin_bit_cast(float, __builtin_amdgcn_ds_bpermute((lane ^ 16) << 2, __builtin_bit_cast(int, x)));
        x += __builtin_bit_cast(float, __builtin_amdgcn_ds_bpermute((lane ^ 32) << 2, __builtin_bit_cast(int, x)));
        const int xi = __builtin_bit_cast(int, x);
#pragma unroll
        for (int e = 0; e < 8; ++e) lg[e] = __builtin_bit_cast(float, __builtin_amdgcn_readlane(xi, 2 * e));
    }
    int a = 0; float la = lg[0];
#pragma unroll
    for (int e = 1; e < 8; ++e) if (lg[e] > la) { la = lg[e]; a = e; }
    int b = -1; float lb = -3.0e38f;
#pragma unroll
    for (int e = 0; e < 8; ++e) if (e != a && lg[e] > lb) { lb = lg[e]; b = e; }
    const float t = __expf(lb - la);
    e1 = a; e2 = b; w1 = 1.f / (1.f + t); w2 = t / (1.f + t);
}

struct MixArgs {
    bf16* QK; bf16* V; const float* GA;
    bf16* mQK; bf16* mV; const float* mGA; bf16* mO;
    const float* wa2; const float* ba; const float* gng; const float* rng; const float* rnb;
    int dry;
};
typedef float f32x16 __attribute__((ext_vector_type(16)));
typedef short s16x4 __attribute__((ext_vector_type(4)));
constexpr int QROW = 272, PROW = 144, KTROW = 144, OROWF = 260;
constexpr int FM_QIN = 0, FM_KIN = 17408, FM_PT = 34816, FM_KT = 44032  , FM_OT = 0  ,
              FM_VS = 66560  , FM_SEG = 99328, FM_DEC = 101376, FM_GA = 101888  , FM_NG = 118272  , FM_WB = 120320  , FM_END = 136704;
static_assert(FM_KT + 128 * KTROW <= FM_VS && FM_END <= MISC_OFF, "fast mixer LDS map");
__device__ __forceinline__ bf16x8 pack8(float a0, float a1, float a2, float a3, float a4, float a5, float a6, float a7) {
    u32x4 p; p.x = pk2_sw(a0, a1); p.y = pk2_sw(a2, a3); p.z = pk2_sw(a4, a5); p.w = pk2_sw(a6, a7); return __builtin_bit_cast(bf16x8, p);
}
#define MIX_BAR() do { asm volatile("s_waitcnt lgkmcnt(0)" ::: "memory"); __builtin_amdgcn_s_barrier(); asm volatile("" ::: "memory"); } while (0)
__device__ __forceinline__ void mixer_fast(const Frame& F, const MixArgs& a) {
    LAS unsigned char* L = F.lds;
    LAS float* seg = (LAS float*)(L + FM_SEG); LAS float* dec = (LAS float*)(L + FM_DEC); LAS float* ot = (LAS float*)(L + FM_OT);
    const int tid0 = F.tid, wave = F.wave;
    LAS unsigned char* slab = L + FM_VS + wave * 4096;
    for (int it = F.bid; it < NB * 8; it += F.G) {
        int tid = tid0; asm volatile("" : "+v"(tid));
        int lane = tid & 63, l32 = lane & 31, hh = lane >> 5, l16 = lane & 15, quad = lane >> 4;
        const int b = it >> 3, type_rt = (a.dry == 2) ? 1 : ((it >> 2) & 1), head = it & 3;
        auto item_body = [&](auto TY_) __attribute__((always_inline)) {
        constexpr int type = decltype(TY_)::value;
        const int qcol = (type ? 1024 : 0) + head * 128, kcol = qcol + 512, vcol = type * 1024 + head * 256;
        const float lng = __log2f(1.0f - exp2f(-5.0f - (float)head));
        f32x16 S[4];
#pragma unroll
        for (int T = 0; T < 4; ++T)
#pragma unroll
            for (int r = 0; r < 16; ++r) S[T][r] = 0.f;
        LAS float* ngL = (LAS float*)(L + FM_NG);
        if (tid0 < 256) { ngL[tid0] = (type == 0) ? a.gng[tid0] : a.rng[head * 256 + tid0]; ngL[256 + tid0] = (type == 0) ? 0.f : a.rnb[head * 256 + tid0]; }
        const int mt = wave >> 2, nt = wave & 3;
        float bad = 0.f;
        if (type == 0) { const int d0 = head * 128 + 32 * nt + l32; bad = a.ba[d0]; float wv[8];
#pragma unroll
            for (int j = 0; j < 8; ++j) wv[j] = a.wa2[(8 * hh + j) * 512 + d0];
            unsigned h_[4], l_[4];
#pragma unroll
            for (int j = 0; j < 4; ++j) { h_[j] = pk2(wv[2 * j], wv[2 * j + 1]); l_[j] = pk2(wv[2 * j] - bf2f(h_[j]), wv[2 * j + 1] - bf2f(h_[j] >> 16)); }
            *(LAS u32x4*)(L + FM_WB + tid * 32) = (u32x4){h_[0], h_[1], h_[2], h_[3]}; *(LAS u32x4*)(L + FM_WB + tid * 32 + 16) = (u32x4){l_[0], l_[1], l_[2], l_[3]}; }
        unsigned qraw[16], kraw[16];
        { const unsigned qoff = (unsigned)(qcol + 32 * nt + l32) * 2u, koff = (unsigned)(kcol + 32 * nt + l32) * 2u;
#pragma unroll
        for (int r = 0; r < 16; ++r) { qraw[r] = 0u; kraw[r] = 0u; }
        if (mt == 1) {
#pragma unroll
            for (int r = 8; r < 16; ++r) { const char* rb = (const char*)a.mQK + (size_t)((r & 3) + 8 * (r >> 2) - 16) * 4096 + (size_t)hh * 4 * 4096; qraw[r] = *(const bf16*)(rb + qoff); kraw[r] = *(const bf16*)(rb + koff); }
        } }
        {
            unsigned z0 = 0u; asm volatile("" : "+v"(z0));
            const u32x4 z = (u32x4){z0, z0, z0, z0};
#pragma unroll
            for (int j = 0; j < 3; ++j) *(LAS u32x4*)(slab + j * 1024 + lane * 16) = z;
            __builtin_amdgcn_global_load_lds((const unsigned*)(a.mV + (size_t)(lane >> 2) * 2048 + vcol + 32 * wave + 8 * (lane & 3)), (LAS unsigned*)(slab + 3 * 1024), 16, 0, 0);
        }
        float bq[16], tot_n = 0.f;
        if (type == 0 && mt == 1) __builtin_amdgcn_global_load_lds((const unsigned*)(a.mGA + lane * 4), (LAS unsigned*)(L + FM_GA + wave * 2048 + 1024), 16, 0, 0);
        auto gates = [&](const bool metaN, const int tid_, const int lane_, const int hh_, const int dch_) __attribute__((always_inline)) {
            const LAS f32x4* gp = (const LAS f32x4*)(L + FM_GA + wave * 2048 + (lane_ & 31) * 64 + hh_ * 32);
            const f32x4 g0 = gp[0], g1 = gp[1];
            unsigned h_[4], l_[4];
            h_[0] = pk2(g0[0], g0[1]); h_[1] = pk2(g0[2], g0[3]); h_[2] = pk2(g1[0], g1[1]); h_[3] = pk2(g1[2], g1[3]);
            l_[0] = pk2(g0[0] - bf2f(h_[0]), g0[1] - bf2f(h_[0] >> 16)); l_[1] = pk2(g0[2] - bf2f(h_[1]), g0[3] - bf2f(h_[1] >> 16));
            l_[2] = pk2(g1[0] - bf2f(h_[2]), g1[1] - bf2f(h_[2] >> 16)); l_[3] = pk2(g1[2] - bf2f(h_[3]), g1[3] - bf2f(h_[3] >> 16));
            const bf16x8 a_hi = __builtin_bit_cast(bf16x8, (u32x4){h_[0], h_[1], h_[2], h_[3]}), a_lo = __builtin_bit_cast(bf16x8, (u32x4){l_[0], l_[1], l_[2], l_[3]});
            const bf16x8 wb_hi = *(const LAS bf16x8*)(L + FM_WB + tid_ * 32), wb_lo = *(const LAS bf16x8*)(L + FM_WB + tid_ * 32 + 16);
            f32x16 pre;
#pragma unroll
            for (int r = 0; r < 16; ++r) pre[r] = 0.f;
            pre = __builtin_amdgcn_mfma_f32_32x32x16_bf16(a_hi, wb_hi, pre, 0, 0, 0);
            pre = __builtin_amdgcn_mfma_f32_32x32x16_bf16(a_lo, wb_hi, pre, 0, 0, 0);
            pre = __builtin_amdgcn_mfma_f32_32x32x16_bf16(a_hi, wb_lo, pre, 0, 0, 0);
#pragma unroll
            for (int r = 0; r < 16; ++r) { const float x = pre[r] + bad;
                bq[r] = fminf(x, 0.f) * (1.44269504f / 16.0f) - __builtin_amdgcn_logf(1.0f + __builtin_amdgcn_exp2f(fabsf(x) * -1.44269504f)) * (1.0f / 16.0f); }
            if (metaN) {
#pragma unroll
                for (int r = 0; r < 16; ++r) { const int c = 32 * mt + (r & 3) + 8 * (r >> 2) + 4 * hh_; bq[r] = (c >= 48) ? bq[r] : 0.f; }
            }
            float T[4];
#pragma unroll
            for (int q = 0; q < 4; ++q) { bq[4 * q + 1] += bq[4 * q]; bq[4 * q + 2] += bq[4 * q + 1]; bq[4 * q + 3] += bq[4 * q + 2]; T[q] = bq[4 * q + 3]; }
            float tot = 0.f;
#pragma unroll
            for (int q = 0; q < 4; ++q) { const float To = __builtin_bit_cast(float, __builtin_amdgcn_ds_bpermute((lane_ ^ 32) << 2, __builtin_bit_cast(int, T[q])));
                const float t0 = hh_ ? To : T[q], t1 = hh_ ? T[q] : To;
                const float mine = tot + (hh_ ? t0 : 0.f);
#pragma unroll
                for (int j = 0; j < 4; ++j) bq[4 * q + j] += mine;
                tot += t0 + t1; }
            if (mt == 0 && hh_ == 0) seg[dch_] = tot;
            tot_n = tot;
        };
        auto finalize = [&](const int hh_, const int dch_) __attribute__((always_inline)) {
            if (mt == 1) { const float base = seg[dch_];
#pragma unroll
                for (int r = 0; r < 16; ++r) bq[r] += base;
                if (hh_ == 0) dec[dch_] = __builtin_amdgcn_exp2f(base + tot_n); }
        };
        MIX_BAR();
        if (type == 0) { asm volatile("s_waitcnt vmcnt(0)" ::: "memory"); gates(true, tid, lane, hh, 32 * nt + l32); MIX_BAR(); finalize(hh, 32 * nt + l32); }
        else {
#pragma unroll
            for (int r = 0; r < 16; ++r) bq[r] = (float)(32 * mt + (r & 3) + 8 * (r >> 2) + 4 * hh + 1) * lng;
            if (mt == 1 && hh == 0) dec[32 * nt + l32] = __builtin_amdgcn_exp2f(64.0f * lng);
        }
#pragma unroll 1
        for (int ch = -1; ch < 32; ++ch) {
            const bool meta = ch < 0;
            bf16* vb = meta ? a.mV : a.V + (size_t)(b * SEQ + ch * 64) * 2048;
            tid = tid0; asm volatile("" : "+v"(tid));
            lane = tid & 63; l32 = lane & 31; hh = lane >> 5; l16 = lane & 15; quad = lane >> 4;
            const int dch = 32 * nt + l32;
            const unsigned qoff = (unsigned)(qcol + dch) * 2u + (unsigned)hh * 16384u, koff = (unsigned)(kcol + dch) * 2u + (unsigned)hh * 16384u;
            asm volatile("s_waitcnt vmcnt(0)" ::: "memory");
            MIX_BAR();
            if (type == 0) { const float* ng_ = a.GA + (size_t)(b * SEQ + (ch < 31 ? ch + 1 : 31) * 64 + 32 * mt) * 16 + lane * 4;
                __builtin_amdgcn_global_load_lds((const unsigned*)ng_, (LAS unsigned*)(L + FM_GA + wave * 2048), 16, 0, 0);
                __builtin_amdgcn_global_load_lds((const unsigned*)(ng_ + 256), (LAS unsigned*)(L + FM_GA + wave * 2048 + 1024), 16, 0, 0); }
            {
                const int dchp = (dch & ~12) | ((dch & 4) << 1) | ((dch & 8) >> 1);
#pragma unroll
                for (int q = 0; q < 4; ++q) { unsigned kt0 = 0u, kt1 = 0u;
#pragma unroll
                    for (int j = 0; j < 4; ++j) { const int r = 4 * q + j; const int c = 32 * mt + j + 8 * q + 4 * hh; const float eb = __builtin_amdgcn_exp2f(bq[r]), en = __builtin_amdgcn_exp2f(-bq[r]);
                        const unsigned qkv = pk2(bf2f(qraw[r]) * eb, bf2f(kraw[r]) * en); const unsigned qv = qkv & 0xffffu, kv = qkv >> 16;
                        *(LAS bf16*)(L + FM_QIN + c * QROW + dchp * 2) = (bf16)qv; *(LAS bf16*)(L + FM_KIN + c * QROW + dchp * 2) = (bf16)kv;
                        if (j == 0) kt0 = kv; else if (j == 1) kt0 |= kv << 16; else if (j == 2) kt1 = kv; else kt1 |= kv << 16; }
                    *(LAS u32x2*)(L + FM_KT + dch * KTROW + (32 * mt + 8 * q + 4 * hh) * 2) = (u32x2){kt0, kt1}; }
            }
            MIX_BAR();
#pragma unroll 1
            for (int tt = wave; tt < 10; tt += 8) {
                const int ti = (tt >= 6) ? 3 : (tt >= 3) ? 2 : (tt >= 1) ? 1 : 0, tj = tt - ti * (ti + 1) / 2;
                f32x4 pacc = zero_f4();
#pragma unroll
                for (int ks = 0; ks < 4; ++ks) {
                    const bf16x8 A = *(const LAS bf16x8*)(L + FM_QIN + (16 * ti + l16) * QROW + (32 * ks + 8 * quad) * 2);
                    const bf16x8 B = *(const LAS bf16x8*)(L + FM_KIN + (16 * tj + l16) * QROW + (32 * ks + 8 * quad) * 2);
                    pacc = __builtin_amdgcn_mfma_f32_16x16x32_bf16(A, B, pacc, 0, 0, 0);
                }
#pragma unroll
                for (int jj = 0; jj < 4; jj += 2) { const int row = 16 * ti + 4 * quad + jj, col = 16 * tj + l16;
                    const unsigned pp = pk2((col > row) ? 0.f : pacc[jj], (col > row + 1) ? 0.f : pacc[jj + 1]);
                    *(LAS bf16*)(L + FM_PT + row * PROW + col * 2) = (bf16)(pp & 0xffffu); *(LAS bf16*)(L + FM_PT + (row + 1) * PROW + col * 2) = (bf16)(pp >> 16); }
            }
            if (wave == 2 || wave == 3) {
                const int ti = (wave == 2) ? 0 : 2, tj = ti + 1;
#pragma unroll
                for (int jj = 0; jj < 4; ++jj) *(LAS bf16*)(L + FM_PT + (16 * ti + 4 * quad + jj) * PROW + (16 * tj + l16) * 2) = (bf16)0;
            }
            MIX_BAR();
            bf16x8 vf[4];
            {
                const unsigned base = (unsigned)(size_t)(slab + (8 * hh + (l16 >> 2)) * 64 + 32 * (quad & 1) + 8 * (l16 & 3));
                s16x4 t0, t1, t2, t3, t4, t5, t6, t7;
                asm volatile("ds_read_b64_tr_b16 %0, %8\n\tds_read_b64_tr_b16 %1, %8 offset:256\n\tds_read_b64_tr_b16 %2, %8 offset:1024\n\tds_read_b64_tr_b16 %3, %8 offset:1280\n\t"
                             "ds_read_b64_tr_b16 %4, %8 offset:2048\n\tds_read_b64_tr_b16 %5, %8 offset:2304\n\tds_read_b64_tr_b16 %6, %8 offset:3072\n\tds_read_b64_tr_b16 %7, %8 offset:3328\n\ts_waitcnt lgkmcnt(0)"
                             : "=&v"(t0), "=&v"(t1), "=&v"(t2), "=&v"(t3), "=&v"(t4), "=&v"(t5), "=&v"(t6), "=&v"(t7) : "v"(base) : "memory");
                vf[0] = (bf16x8){t0[0], t0[1], t0[2], t0[3], t1[0], t1[1], t1[2], t1[3]}; vf[1] = (bf16x8){t2[0], t2[1], t2[2], t2[3], t3[0], t3[1], t3[2], t3[3]};
                vf[2] = (bf16x8){t4[0], t4[1], t4[2], t4[3], t5[0], t5[1], t5[2], t5[3]}; vf[3] = (bf16x8){t6[0], t6[1], t6[2], t6[3], t7[0], t7[1], t7[2], t7[3]};
            }
            { const bf16* nv = a.V + (size_t)(b * SEQ + (ch < 31 ? ch + 1 : 31) * 64) * 2048 + vcol + 32 * wave + 8 * (lane & 3);
#pragma unroll
                for (int j = 0; j < 4; ++j) __builtin_amdgcn_global_load_lds((const unsigned*)(nv + (size_t)(16 * j + (lane >> 2)) * 2048), (LAS unsigned*)(slab + j * 1024), 16, 0, 0);
            }
            __builtin_amdgcn_sched_barrier(0);
            f32x16 O[2];
#pragma unroll
            for (int mt = 0; mt < 2; ++mt)
#pragma unroll
                for (int r = 0; r < 16; ++r) O[mt][r] = 0.f;
            auto mfma_stage = [&]() __attribute__((always_inline)) {
#pragma unroll
            for (int mt = 0; mt < 2; ++mt)
#pragma unroll
                for (int ks = 0; ks < 2 * mt + 2; ++ks) {
                    const bf16x8 A = *(const LAS bf16x8*)(L + FM_PT + (32 * mt + l32) * PROW + (16 * ks + 8 * hh) * 2);
                    O[mt] = __builtin_amdgcn_mfma_f32_32x32x16_bf16(A, vf[ks], O[mt], 0, 0, 0);
                }
#pragma unroll
            for (int T = 0; T < 4; ++T) {
                bf16x8 Aq[2][2];
#pragma unroll
                for (int s2 = 0; s2 < 2; ++s2)
#pragma unroll
                    for (int mt = 0; mt < 2; ++mt) {
                        Aq[s2][mt] = *(const LAS bf16x8*)(L + FM_QIN + (32 * mt + l32) * QROW + (32 * T + 16 * s2 + 8 * hh) * 2);
                    }
#pragma unroll
                for (int s2 = 0; s2 < 2; ++s2) {
                    const bf16x8 Bs = pack8(S[T][8 * s2], S[T][8 * s2 + 1], S[T][8 * s2 + 2], S[T][8 * s2 + 3], S[T][8 * s2 + 4], S[T][8 * s2 + 5], S[T][8 * s2 + 6], S[T][8 * s2 + 7]);
                    O[0] = __builtin_amdgcn_mfma_f32_32x32x16_bf16(Aq[s2][0], Bs, O[0], 0, 0, 0);
                    O[1] = __builtin_amdgcn_mfma_f32_32x32x16_bf16(Aq[s2][1], Bs, O[1], 0, 0, 0);
                }
            }
#pragma unroll
            for (int T = 0; T < 4; ++T) {
                bf16x8 Ak[4]; f32x4 dc[4];
#pragma unroll
                for (int ks = 0; ks < 4; ++ks) Ak[ks] = *(const LAS bf16x8*)(L + FM_KT + (32 * T + l32) * KTROW + (16 * ks + 8 * hh) * 2);
#pragma unroll
                for (int q4 = 0; q4 < 4; ++q4) dc[q4] = *(const LAS f32x4*)(dec + 32 * T + 8 * q4 + 4 * hh);
#pragma unroll
                for (int ks = 0; ks < 4; ++ks) S[T] = __builtin_amdgcn_mfma_f32_32x32x16_bf16(Ak[ks], vf[ks], S[T], 0, 0, 0);
#pragma unroll
                for (int q4 = 0; q4 < 4; ++q4) { S[T][4 * q4] *= dc[q4][0]; S[T][4 * q4 + 1] *= dc[q4][1]; S[T][4 * q4 + 2] *= dc[q4][2]; S[T][4 * q4 + 3] *= dc[q4][3]; }
            }
            };
            const bool gnext = (type == 0);
#pragma unroll 1
            for (int st = 0; st < 2; ++st) {
                if ((st == 0) == (wave < 4)) { if (gnext) { asm volatile("s_waitcnt vmcnt(4)" ::: "memory"); gates(false, tid, lane, hh, dch); } }
                else mfma_stage();
            }
            __builtin_amdgcn_sched_barrier(0);
            { const bf16* nq = a.QK + (size_t)(b * SEQ + (ch < 31 ? ch + 1 : 31) * 64 + 32 * mt) * 2048;
#pragma unroll
                for (int r = 0; r < 16; ++r) { const char* rb = (const char*)nq + (size_t)((r & 3) + 8 * (r >> 2)) * 4096; qraw[r] = *(const bf16*)(rb + qoff); kraw[r] = *(const bf16*)(rb + koff); } }
            MIX_BAR();
#pragma unroll
            for (int mt = 0; mt < 2; ++mt)
#pragma unroll
                for (int r = 0; r < 16; ++r) ot[(32 * mt + (r & 3) + 8 * (r >> 2) + 4 * hh) * OROWF + 32 * wave + l32] = O[mt][r];
            if (gnext) finalize(hh, dch);
            MIX_BAR();
            {
                const int r8 = lane >> 3, s8 = lane & 7, i = wave + 8 * r8;
                const LAS float* orow = ot + i * OROWF + 4 * s8;
                f32x4 o[8];
#pragma unroll
                for (int j = 0; j < 8; ++j) o[j] = *(const LAS f32x4*)(orow + 32 * j);
                float rs;
                if (type == 0) {
                    f32x4 q = o[0] * o[0];
#pragma unroll
                    for (int j = 1; j < 8; ++j) q = q + o[j] * o[j];
                    const float ss = sum8((q[0] + q[1]) + (q[2] + q[3]));
                    rs = __builtin_amdgcn_rsqf(ss * (1.0f / 256.0f) + LN_EPS);
                } else {
                    const f32x4 t = ((o[0] + o[1]) + (o[2] + o[3])) + ((o[4] + o[5]) + (o[6] + o[7]));
                    const float mu = sum8((t[0] + t[1]) + (t[2] + t[3])) * (1.0f / 256.0f);
#pragma unroll
                    for (int j = 0; j < 8; ++j) o[j] = o[j] - mu;
                    f32x4 q = o[0] * o[0];
#pragma unroll
                    for (int j = 1; j < 8; ++j) q = q + o[j] * o[j];
                    const float var = sum8((q[0] + q[1]) + (q[2] + q[3])) * (1.0f / 256.0f);
                    rs = __builtin_amdgcn_rsqf(var + GN_EPS);
                }
                const bool st = !a.dry && (!meta || (b == 0 && i >= 48));
                bf16* dst = (meta ? a.mO + (size_t)(i - 48) * 2048 : vb + (size_t)i * 2048) + vcol + 4 * s8;
                const LAS float* gp = ngL + 4 * s8;
#pragma unroll
                for (int j = 0; j < 8; ++j) { const f32x4 ng = *(const LAS f32x4*)(gp + 32 * j), nb = *(const LAS f32x4*)(gp + 256 + 32 * j);
                    const f32x4 y = o[j] * rs * ng + nb;
                    if (st) store_bf4(dst + 32 * j, y);
                    __builtin_amdgcn_sched_barrier(0); }
            }
        }
        asm volatile("s_waitcnt vmcnt(0)" ::: "memory");
        MIX_BAR();
        };
        if (type_rt == 0) item_body(IntC<0>{}); else item_body(IntC<1>{});
    }
}

typedef const __attribute__((address_space(4))) Args* KArgs;
__device__ __forceinline__ KArgs kargs() { KArgs p = (KArgs)__builtin_amdgcn_kernarg_segment_ptr(); asm volatile("" : "+s"(p)); return p; }
#define ENV() \
    KArgs A_ = kargs(); \
    Frame F; { int t_ = TIDX(); int b_ = blockIdx.x; asm volatile("" : "+s"(b_)); \
        { LAS unsigned char* l_ = (LAS unsigned char*)lds_raw; asm volatile("" : "+s"(l_)); F.lds = l_; } F.MISC = (volatile LAS unsigned*)(F.lds + MISC_OFF); F.tid = t_; F.lane = t_ & 63; F.wave = __builtin_amdgcn_readfirstlane(t_ >> 6); \
        F.G = gridDim.x; F.bid = b_; F.gtid = b_ * NTHR + t_; F.gthreads = F.G * NTHR; F.gwave = b_ * NWAVES + F.wave; F.gwaves = F.G * NWAVES; F.ws = A_->ws; F.ctl = (unsigned*)(A_->ws + WS_CTL); } \
    unsigned char* ws = A_->ws; typedef const float* cfp_; const __attribute__((address_space(4))) cfp_* in = A_->in; \
    bf16* HA = (bf16*)(ws + WS_HA); bf16* HB = (bf16*)(ws + WS_HB); float* OUTF = A_->out; \
    bf16* QK = (bf16*)(ws + WS_QK); bf16* V = (bf16*)(ws + WS_V); float* GA = (float*)(ws + WS_GA); \
    bf16* MRG = QK; bf16* U = QK; const f32x2* rope = (const f32x2*)(ws + WS_ROPE); \
    unsigned char* mt = ws + WS_META; \
    bf16* mA = (bf16*)(mt + MT_XB); bf16* mB = (bf16*)(mt + MT_HA); bf16* mQK = (bf16*)(mt + MT_QK); bf16* mV = (bf16*)(mt + MT_V); \
    bf16* mSIG = (bf16*)(mt + MT_SIG); float* mGA = (float*)(mt + MT_GA); bf16* mMRG = (bf16*)(mt + MT_MRG); bf16* mU = (bf16*)(mt + MT_U); float* mY = (float*)(mt + MT_Y); \
    bf16* mUall = (bf16*)(ws + WS_META2); float* mYall = (float*)(ws + WS_META2 + 512 * 1024); (void)mUall; (void)mYall; \
    bf16* mO = (bf16*)(mt + MT_O); int* mTokE = (int*)(mt + MT_TOK); float* mTokW = (float*)(mt + MT_TOK + 128); \
    int* perm = (int*)(ws + WS_MOE); int* tok_slot = (int*)(ws + WS_MOE + 2 * MiB); float* tok_w = (float*)(ws + WS_MOE + 2 * MiB + 512 * 1024); \
    const bf16* B1t = (const bf16*)(ws + WS_W + W_B1); const bf16* B2t = (const bf16*)(ws + WS_W + W_B2); const bf16* PAt = (const bf16*)(ws + WS_W + W_PA); \
    const bf16* PBt = (const bf16*)(ws + WS_W + W_PB); const bf16* Ot = (const bf16*)(ws + WS_W + W_O); const bf16* FGU = (const bf16*)(ws + WS_W + W_F); \
    const bf16* FDd = (const bf16*)(ws + WS_W + W_FD_DENSE); const bf16* FDm = (const bf16*)(ws + WS_W + W_FD_MOE); \
    bf16* SIG = (bf16*)A_->out; bf16* Y = (l == DEPTH - 1) ? (bf16*)(ws + WS_Y3) : (bf16*)A_->out;     \
    (void)HA; (void)HB; (void)OUTF; (void)mA; (void)mB; (void)QK; (void)V; (void)GA; (void)MRG; (void)U; (void)rope; (void)mQK; (void)mV; (void)mSIG; (void)mGA; (void)mMRG; (void)mU; (void)mY; \
    (void)mO; (void)mTokE; (void)mTokW; (void)perm; (void)tok_slot; (void)tok_w; (void)B1t; (void)B2t; (void)PAt; (void)PBt; (void)Ot; (void)FGU; (void)FDd; (void)FDm; \
    (void)SIG; (void)Y; (void)in

__global__ void __launch_bounds__(NTHR, 2) fwd_kernel(Args args) {
    extern __shared__ __attribute__((aligned(16))) unsigned char lds_raw[];
    const int lo = args.ph_lo, hi = args.ph_hi;
    const int wv0_ = __builtin_amdgcn_readfirstlane((int)(threadIdx.x >> 6));
#define TIDX() tid_from_wave(wv0_)
    const bool multi = (hi - lo) > 1;
    {
        volatile LAS unsigned* MISC0 = (volatile LAS unsigned*)((LAS unsigned char*)lds_raw + MISC_OFF);
        for (int u = TIDX(); u < 256; u += NTHR) MISC0[u] = 0u;
        __syncthreads();
        if (multi) (void)xcd_barrier_post((unsigned*)(args.ws + WS_CTL) + CW_BAR + args.li * XCD_BAR_WORDS, MISC0, TIDX());
    }
#if PROBE_CLK
    if (blockIdx.x == 0 && TIDX() == 0) { volatile LAS unsigned long long* ck = (volatile LAS unsigned long long*)((LAS unsigned char*)lds_raw + MISC_OFF + 512); ck[0] = (unsigned long long)clock64(); ck[1] = __builtin_amdgcn_s_memrealtime(); }
#endif
#ifndef PH_MASK
#define PH_MASK 0xFFF
#endif
#define INS(slot, k) ((((PH_MASK) >> (slot)) & 1) && lo <= (k) && (k) < hi)
#define IN(k) (lo <= (k) && (k) < hi)
#define SEAM(k) do { if (IN(k) && IN((k) + 1)) { KArgs B_ = kargs(); XcdBarrier bar; \
        if (PROBE_SPREAD >= 0 && (k) == PROBE_SPREAD && TIDX() == 0) { asm volatile("s_waitcnt vmcnt(0)" ::: "memory"); ((unsigned long long*)(B_->ws + WS_CTL + 131072))[blockIdx.x] = __builtin_amdgcn_s_memrealtime(); } \
        bar.bar = (unsigned*)(B_->ws + WS_CTL) + CW_BAR + B_->li * XCD_BAR_WORDS; bar.x = xb_xcc_id(); bar.tid = TIDX(); \
        bar.st = (volatile LAS unsigned*)((LAS unsigned char*)lds_raw + MISC_OFF); xcd_barrier(bar); \
        if (PROBE_STAMP >= 0 && blockIdx.x == 0 && TIDX() == 0) { unsigned a_ = MISC_OFF + 512; asm volatile("" : "+v"(a_)); volatile LAS unsigned long long* ck_ = (volatile LAS unsigned long long*)((LAS unsigned char*)lds_raw + a_); \
            if ((k) == PROBE_STAMP - 1) ck_[2] = __builtin_amdgcn_s_memrealtime(); if ((k) == PROBE_STAMP) ck_[3] = __builtin_amdgcn_s_memrealtime(); } \
        if (PROBE_SPREAD >= 0 && (k) == PROBE_SPREAD && blockIdx.x == 0 && TIDX() == 0) { const unsigned long long* ts_ = (const unsigned long long*)(B_->ws + WS_CTL + 131072); unsigned long long mn_ = ~0ull, mx_ = 0ull; \
            for (unsigned i_ = 0; i_ < gridDim.x; ++i_) { const unsigned long long t_ = __hip_atomic_load(ts_ + i_, __ATOMIC_RELAXED, __HIP_MEMORY_SCOPE_AGENT); mn_ = t_ < mn_ ? t_ : mn_; mx_ = t_ > mx_ ? t_ : mx_; } \
            unsigned a_ = MISC_OFF + 512; asm volatile("" : "+v"(a_)); volatile LAS unsigned long long* ck_ = (volatile LAS unsigned long long*)((LAS unsigned char*)lds_raw + a_); ck_[2] = mn_; ck_[3] = mx_; } } } while (0)

    for (int l = 0; l < DEPTH; ++l) {
        const int pb = l * NPH;
        if (hi <= pb || lo >= pb + NPH) continue;
        const bool moe = (l & 1) != 0; const int l2 = l >> 1;
        if (INS(0, pb + 0)) { ENV();
            int rot = 0;
            const float* win = in[I_WIN] + (size_t)l * D * NIN;
            { bf16* b1 = (bf16*)B1t; bf16* b2 = (bf16*)B2t; cvt_tiles(F, rot, win, NIN, 0, D, NIN, [=](int s) { return dst_win(s, b1, b2); }); }
            for (int i = F.gtid * 8; i < (N1 - 6160) * D; i += F.gthreads * 8) *(u32x4*)((bf16*)B1t + (size_t)6160 * D + i) = zero_u4();
            { bf16* d0 = (bf16*)PAt; cvt_tiles(F, rot, in[I_WPA] + (size_t)l * D * D, D, 0, D, D, [=](int s) { return d0 + (size_t)s * D; }); }
            { bf16* d0 = (bf16*)PBt; cvt_tiles(F, rot, in[I_WPB] + (size_t)l * D * D, D, 0, D, D, [=](int s) { return d0 + (size_t)s * D; }); }
            { bf16* d0 = (bf16*)Ot; cvt_tiles(F, rot, in[I_WO] + (size_t)l * D * D, D, 0, D, D, [=](int s) { return d0 + (size_t)s * D; }); }
            if (!moe) {
                { bf16* d0 = (bf16*)FGU; cvt_tiles(F, rot, in[I_FG] + (size_t)l2 * D * DFF, DFF, 0, D, DFF, [=](int s) { return d0 + (size_t)(256 * (s >> 7) + (s & 127)) * D; });
                  cvt_tiles(F, rot, in[I_FU] + (size_t)l2 * D * DFF, DFF, 0, D, DFF, [=](int s) { return d0 + (size_t)(256 * (s >> 7) + 128 + (s & 127)) * D; }); }
                { bf16* d0 = (bf16*)FDd; cvt_tiles(F, rot, in[I_FD] + (size_t)l2 * DFF * D, D, 0, DFF, D, [=](int s) { return d0 + (size_t)s * DFF; }); }
            } else {
                if (F.gtid < NEXP) F.ctl[CW_CNT + 64 * F.gtid] = 0u;
            }
            if (l == 0) {
                for (int i = F.gtid; i < 2064 * 64; i += F.gthreads) { const int pos = i >> 6, k = i & 63; const float inv = powf(10000.0f, -(float)k / 64.0f); const float ang = (float)pos * inv;
                    float sn, cs; sincosf(ang, &sn, &cs); ((f32x2*)rope)[i] = (f32x2){cs, sn}; }
                const float* x = in[I_X];
                {
                    const size_t n4 = (size_t)M * D / 4, gs = (size_t)F.gthreads;
                    size_t i = (size_t)F.gtid;
                    for (; i + 7 * gs < n4; i += gs * 8) {
                        f32x4 v[8];
#pragma unroll
                        for (int j = 0; j < 8; ++j) v[j] = *(const f32x4*)(x + (i + (size_t)j * gs) * 4);
#pragma unroll
                        for (int j = 0; j < 8; ++j) store_bf4(HA + (i + (size_t)j * gs) * 4, v[j]);
                    }
                    for (; i < n4; i += gs) store_bf4(HA + i * 4, *(const f32x4*)(x + i * 4));
                }
                for (int i = F.gtid * 4; i < NMETA * D; i += F.gthreads * 4) store_bf4(mA + i, *(const f32x4*)(in[I_META] + i));
            }
        }
        SEAM(pb + 0);

        if (INS(1, pb + 1)) { ENV();
            const float* bg = in[I_BGATE] + (size_t)l * 2 * D;
            { F1 f{mQK, mV, mSIG, mGA, rope, bg, 15, 0};
              meta_gemm(F, 1, N1, D, [=](int, int r) { return mA + (size_t)r * D; }, [=](int, int c) { return B1t + (size_t)c * D; }, [=](int) { return f; }); }
            pg8::SchedDense S; S.init(M, N1, F.G, F.bid, HA, D * 2, B1t, D * 2);
            pg8::EpiF1<F1> E{F1{QK, V, SIG, GA, rope, bg, 2047, 16}};
            pg8::gemm_phase<pg8::EpiF1<F1>, pg8::SchedDense>(F.lds, F.tid, S, E, D, D * 2, D * 2);
        }
        SEAM(pb + 1);

        if (INS(2, pb + 2)) { ENV();
            MixArgs ma{QK, V, GA, mQK, mV, mGA, mO, in[I_WA2] + (size_t)l * 16 * 512, in[I_BA] + (size_t)l * 512, in[I_GNG] + (size_t)l * 256,
                       in[I_RNG] + (size_t)l * 1024, in[I_RNB] + (size_t)l * 1024, 0};
            if (PROBE_DUP & 2) { ma.dry = (PROBE_DUP & 256) ? 2 : 1; mixer_fast(F, ma); ma.dry = 0; }
            mixer_fast(F, ma);
        }
        SEAM(pb + 2);

        if (INS(3, pb + 3)) { ENV();
            { F2 f{mO, mV}; meta_gemm(F, 1, 2048, D, [=](int, int r) { return mA + (size_t)r * D; }, [=](int, int c) { return B2t + (size_t)c * D; }, [=](int) { return f; }); }
            pg8::SchedDense S; S.init(M, 2048, F.G, F.bid, HA, D * 2, B2t, D * 2);
            pg8::EpiRowLd<F2> E{F2{V, V}};
            pg8::gemm_phase<pg8::EpiRowLd<F2>, pg8::SchedDense>(F.lds, F.tid, S, E, D, D * 2, D * 2);
        }
        SEAM(pb + 3);

        if (INS(4, pb + 4)) { ENV();
#pragma unroll 1
            for (int pass = 0; pass < 2; ++pass) {
                const bf16* Wt = pass ? PBt : PAt;
                { F3 f{mMRG, mSIG, pass}; const bf16* mA = mV + pass * 1024; meta_gemm(F, 1, D, D, [=](int, int r) { return mA + (size_t)r * 2048; }, [=](int, int c) { return Wt + (size_t)c * D; }, [=](int) { return f; }); }
                pg8::SchedDense S; S.init(M, D, F.G, F.bid, V + pass * 1024, 2048 * 2, Wt, D * 2);
                pg8::EpiRowLd<F3> E{F3{MRG, SIG, pass}};
                pg8::gemm_phase<pg8::EpiRowLd<F3>, pg8::SchedDense>(F.lds, F.tid, S, E, D, 2048 * 2, D * 2);
            }
        }
        SEAM(pb + 4);

        if (INS(5, pb + 5)) { ENV();
            { F4 f{mA, mB}; meta_gemm(F, 1, D, D, [=](int, int r) { return mMRG + (size_t)r * D; }, [=](int, int c) { return Ot + (size_t)c * D; }, [=](int) { return f; }); }
            pg8::SchedDense S; S.init(M, D, F.G, F.bid, MRG, D * 2, Ot, D * 2);
            pg8::EpiRowLd<F4> E{F4{HA, HB}};
            pg8::gemm_phase<pg8::EpiRowLd<F4>, pg8::SchedDense>(F.lds, F.tid, S, E, D, D * 2, D * 2);
        }
        SEAM(pb + 5);

        if (INS(6, pb + 6)) { ENV();
            const float* g = in[I_LN1G] + (size_t)l * D; const float* bb = in[I_LN1B] + (size_t)l * D; const LnPar LP = ln_par(g, bb, F.lane);
            if (moe) { int rot = 0;
#pragma unroll 1
                for (int e = 0; e < NEXP; ++e) {
                    const float* wg = in[I_MG] + ((size_t)l2 * NEXP + e) * D * DFFE; const float* wu = in[I_MU] + ((size_t)l2 * NEXP + e) * D * DFFE;
                    bf16* d0 = (bf16*)FGU + (size_t)(e * 2) * DFFE * D;
                    cvt_tiles(F, rot, wg, DFFE, 0, D, DFFE, [=](int s) { const int hf = s >= HFF, sl = s - hf * HFF; return d0 + ((size_t)hf * DFFE + 256 * (sl >> 7) + (sl & 127)) * D; });
                    cvt_tiles(F, rot, wu, DFFE, 0, D, DFFE, [=](int s) { const int hf = s >= HFF, sl = s - hf * HFF; return d0 + ((size_t)hf * DFFE + 256 * (sl >> 7) + 128 + (sl & 127)) * D; });
#pragma unroll 1
                    for (int hf = 0; hf < 2; ++hf) { bf16* d1 = (bf16*)FDm + (size_t)(e * 2 + hf) * D * HFF;
                        cvt_tiles(F, rot, in[I_MD] + ((size_t)l2 * NEXP + e) * DFFE * D, D, hf * HFF, HFF, D, [=](int s) { return d1 + (size_t)s * HFF; }); }
                }
            }
            f32x4 wrt[8][4];
#pragma unroll
            for (int e = 0; e < 8; ++e)
#pragma unroll
                for (int k = 0; k < 4; ++k) wrt[e][k] = zero_f4();
            if (moe) { const float* wg_ = in[I_RT] + (size_t)l2 * D * NEXP;
#pragma unroll
                for (int k = 0; k < 4; ++k)
#pragma unroll
                    for (int q = 0; q < 4; ++q) { const float* pc = wg_ + (size_t)(rcol(F.lane, k) + q) * 8; const f32x4 wa_ = *(const f32x4*)pc, wb_ = *(const f32x4*)(pc + 4);
                        wrt[0][k][q] = wa_[0]; wrt[1][k][q] = wa_[1]; wrt[2][k][q] = wa_[2]; wrt[3][k][q] = wa_[3]; wrt[4][k][q] = wb_[0]; wrt[5][k][q] = wb_[1]; wrt[6][k][q] = wb_[2]; wrt[7][k][q] = wb_[3]; }
            }
            {   const int dry = 0;
                int srow = 0, se1 = 0, se2 = 0, nb = 0; float sw1 = 0.f, sw2 = 0.f;
                RawRow nx = raw_load(F.gwave >= M ? mB + (size_t)(F.gwave - M) * D : HB + (size_t)F.gwave * D, F.lane);
                for (int r = F.gwave; r < M + NMETA; r += F.gwaves) {
                    const bool ism = r >= M; const int rr = ism ? r - M : r;
                    bf16* p = ism ? mB + (size_t)rr * D : HB + (size_t)rr * D;
                    const RawRow cu = nx; { const int rn = r + F.gwaves; if (rn < M + NMETA) nx = raw_load(rn >= M ? mB + (size_t)(rn - M) * D : HB + (size_t)rn * D, F.lane); }
                    f32x4 v[4]; raw_unpack(v, cu); ln_vals(v, LP); rowb_store(v, p, F.lane, dry);
                    if (moe) {
                        int e1, e2; float w1, w2; route_row(v, wrt, F.lane, e1, e2, w1, w2);
                        if (ism) { if (F.lane == 0) { mTokE[rr * 2] = e1; mTokE[rr * 2 + 1] = e2; mTokW[rr * 2] = w1; mTokW[rr * 2 + 1] = w2; } }
                        else { if (F.lane == nb) { srow = rr; se1 = e1; se2 = e2; sw1 = w1; sw2 = w2; } ++nb; }
                    }
                    if (moe && (nb == 64 || r + F.gwaves >= M + NMETA) && nb > 0) {
                        const bool val = F.lane < nb;
                        unsigned long long m1[8], m2[8]; unsigned tote = 0u;
#pragma unroll
                        for (int e = 0; e < 8; ++e) { m1[e] = __ballot(val && se1 == e); m2[e] = __ballot(val && se2 == e);
                            const unsigned c = (unsigned)__builtin_popcountll(m1[e]) + (unsigned)__builtin_popcountll(m2[e]); tote = (F.lane == e) ? c : tote; }
                        unsigned base = 0u; if (F.lane < 8) base = atomicAdd(F.ctl + CW_CNT + 64 * F.lane, tote);
                        unsigned r1 = 0u, r2 = 0u;
#pragma unroll
                        for (int e = 0; e < 8; ++e) { const unsigned be = (unsigned)__builtin_amdgcn_readlane((int)base, e);
                            const unsigned b1 = __builtin_amdgcn_mbcnt_hi((unsigned)(m1[e] >> 32), __builtin_amdgcn_mbcnt_lo((unsigned)m1[e], 0u));
                            const unsigned b2 = __builtin_amdgcn_mbcnt_hi((unsigned)(m2[e] >> 32), __builtin_amdgcn_mbcnt_lo((unsigned)m2[e], 0u));
                            if (se1 == e) r1 = be + b1;
                            if (se2 == e) r2 = be + (unsigned)__builtin_popcountll(m1[e]) + b2; }
                        if (val) { perm[se1 * M + (int)r1] = srow; perm[se2 * M + (int)r2] = srow;
                            tok_slot[srow * 2] = (se1 << 16) | (int)r1; tok_slot[srow * 2 + 1] = (se2 << 16) | (int)r2; tok_w[srow * 2] = sw1; tok_w[srow * 2 + 1] = sw2; }
                        nb = 0;
                    }
                }
            }
        }
        SEAM(pb + 6);

        if (!moe) {
            if (INS(7, pb + 7)) { ENV();
                { F5 f{mU, DFF}; meta_gemm_pair(F, 1, DFF, D, [=](int, int r) { return mB + (size_t)r * D; }, [=](int, int c) { return FGU + (size_t)c * D; }, [=](int) { return f; }); }
                pg8::SchedDense S; S.init(M, 2 * DFF, F.G, F.bid, HB, D * 2, FGU, D * 2);
                pg8::EpiRow<F5> E{F5{U, DFF}};
                pg8::gemm_phase<pg8::EpiRow<F5>, pg8::SchedDense>(F.lds, F.tid, S, E, D, D * 2, D * 2);
            }
            SEAM(pb + 7);
            if (INS(8, pb + 8)) { ENV();
                { F4 f{mB, mA}; meta_gemm(F, 1, D, DFF, [=](int, int r) { return mU + (size_t)r * DFF; }, [=](int, int c) { return FDd + (size_t)c * DFF; }, [=](int) { return f; }); }
                pg8::SchedDense S; S.init(M, D, F.G, F.bid, U, DFF * 2, FDd, DFF * 2);
                pg8::EpiRowLd<F4> E{F4{HB, HA}};
                pg8::gemm_phase<pg8::EpiRowLd<F4>, pg8::SchedDense>(F.lds, F.tid, S, E, DFF, DFF * 2, DFF * 2);
            }
            SEAM(pb + 8);
            if (INS(11, pb + 11)) { ENV();
                const float* g = in[I_LN2G] + (size_t)l * D; const float* bb = in[I_LN2B] + (size_t)l * D; const LnPar LP = ln_par(g, bb, F.lane);
    #pragma unroll 1
            for (int rep = (PROBE_DUP & 4) ? 0 : 1; rep < 2; ++rep)
            { RawRow nx = raw_load(F.gwave >= M ? mA + (size_t)(F.gwave - M) * D : HA + (size_t)F.gwave * D, F.lane);
            for (int r = F.gwave; r < M + NMETA; r += F.gwaves) { const int dry = (rep == 0);
                    const bool ism = r >= M; const int rr = ism ? r - M : r;
                    bf16* p = ism ? mA + (size_t)rr * D : HA + (size_t)rr * D;
                    const RawRow cu = nx; { const int rn = r + F.gwaves; if (rn < M + NMETA) nx = raw_load(rn >= M ? mA + (size_t)(rn - M) * D : HA + (size_t)rn * D, F.lane); }
                    f32x4 v[4]; raw_unpack(v, cu); ln_vals(v, LP); rowb_store(v, p, F.lane, dry);
                } }
            }
            SEAM(pb + 11);
        } else {
            if (lo <= pb + 11 && hi > pb + 7) { ENV();
                if (F.wave == 0) {
                    unsigned cl = 0u; if (F.lane < NEXP) cl = __hip_atomic_load(F.ctl + CW_CNT + 64 * F.lane, __ATOMIC_RELAXED, __HIP_MEMORY_SCOPE_AGENT);
                    unsigned ts = 0, cb = 0;
#pragma unroll
                    for (int e = 0; e < NEXP; ++e) { const unsigned c = (unsigned)__builtin_amdgcn_readlane((int)cl, e);
                        if (F.lane == 0) { F.MISC[16 + e] = c; F.MISC[24 + e] = ts; F.MISC[40 + e] = cb; } ts += (c + 255u) >> 8; cb += c; }
                    if (F.lane == 0) F.MISC[32] = ts;
                }
                __syncthreads();
            }
#pragma unroll 1
            for (int hf = 0; hf < 2; ++hf) {
                if (INS(9, pb + 7 + 2 * hf)) { ENV();
                    meta_gemm_pair(F, NEXP, HFF, D, [=](int, int r) { return mB + (size_t)r * D; }, [=](int e, int c) { return FGU + ((size_t)(e * 2 + hf) * DFFE + c) * D; },
                              [=](int e) { return F5{mUall + (size_t)e * NMETA * HFF, HFF}; });
                    SchedMoeUp S{F.MISC, perm, (const char*)HB, (const char*)FGU, F.G, F.bid, hf};
                    pg8::EpiRow<F5> E{F5{U, HFF}};
                    pg8::gemm_phase<pg8::EpiRow<F5>, SchedMoeUp>(F.lds, F.tid, S, E, D, D * 2, D * 2);
                }
                SEAM(pb + 7 + 2 * hf);
                if (INS(10, pb + 8 + 2 * hf)) { ENV();
                    meta_gemm(F, NEXP, D, HFF, [=](int e, int r) { return mUall + ((size_t)e * NMETA + r) * HFF; }, [=](int e, int c) { return FDm + ((size_t)(e * 2 + hf) * D + c) * HFF; },
                              [=](int e) { return F6Mm{mYall + (size_t)e * NMETA * D, hf}; });
                    SchedMoeDown S{F.MISC, (const char*)U, (const char*)FDm, F.G, F.bid, hf};
                    pg8::EpiRowLd<F6M> E{F6M{Y, hf}};
                    pg8::gemm_phase<pg8::EpiRowLd<F6M>, SchedMoeDown>(F.lds, F.tid, S, E, HFF, HFF * 2, HFF * 2);
                }
                SEAM(pb + 8 + 2 * hf);
            }
            if (INS(11, pb + 11)) { ENV();
                const float* g = in[I_LN2G] + (size_t)l * D; const float* bb = in[I_LN2B] + (size_t)l * D; const LnPar LP = ln_par(g, bb, F.lane);
                const int dry = 0;
                for (int rr = F.gwave; rr < NMETA; rr += F.gwaves) {
                    f32x4 v[4]; rowb_load(v, mB + (size_t)rr * D, F.lane);
                    const float w1 = mTokW[rr * 2], w2 = mTokW[rr * 2 + 1]; const int me1 = mTokE[rr * 2], me2 = mTokE[rr * 2 + 1];
#pragma unroll
                    for (int j = 0; j < 4; ++j) { const f32x4 y1 = *(const f32x4*)(mYall + ((size_t)me1 * NMETA + rr) * D + rcol(F.lane, j)), y2 = *(const f32x4*)(mYall + ((size_t)me2 * NMETA + rr) * D + rcol(F.lane, j));
                        v[j] = v[j] * ALPHA + y1 * w1 + y2 * w2; }
                    ln_vals(v, LP); rowb_store(v, mA + (size_t)rr * D, F.lane, dry);
                }
                {
                    const unsigned yb0 = F.MISC[40], yb1 = F.MISC[41], yb2 = F.MISC[42], yb3 = F.MISC[43], yb4 = F.MISC[44], yb5 = F.MISC[45], yb6 = F.MISC[46], yb7 = F.MISC[47];
#define YBASE(e) ((e) == 0 ? yb0 : (e) == 1 ? yb1 : (e) == 2 ? yb2 : (e) == 3 ? yb3 : (e) == 4 ? yb4 : (e) == 5 ? yb5 : (e) == 6 ? yb6 : yb7)
                    int r = F.gwave;
                    int sa1 = 0, sa2 = 0; float wa1 = 0.f, wa2 = 0.f;
                    if (r < M) { sa1 = tok_slot[r * 2]; sa2 = tok_slot[r * 2 + 1]; wa1 = tok_w[r * 2]; wa2 = tok_w[r * 2 + 1]; }
                    RawRow nh, ny1, ny2; nh.a = nh.b = ny1.a = ny1.b = ny2.a = ny2.b = zero_u4(); float nw1 = wa1, nw2 = wa2;
                    if (r < M) { nh = raw_load(HB + (size_t)r * D, F.lane);
                        ny1 = raw_load(Y + ((size_t)YBASE(sa1 >> 16) + (size_t)(sa1 & 0xffff)) * D, F.lane); ny2 = raw_load(Y + ((size_t)YBASE(sa2 >> 16) + (size_t)(sa2 & 0xffff)) * D, F.lane); }
                    { const int r1 = r + F.gwaves; if (r1 < M) { sa1 = tok_slot[r1 * 2]; sa2 = tok_slot[r1 * 2 + 1]; wa1 = tok_w[r1 * 2]; wa2 = tok_w[r1 * 2 + 1]; } }
#pragma unroll 1
                    for (; r < M; r += F.gwaves) {
                        const RawRow ch = nh, cy1 = ny1, cy2 = ny2; const float w1 = nw1, w2 = nw2;
                        const int r1 = r + F.gwaves, r2 = r + 2 * F.gwaves;
                        if (r1 < M) { nh = raw_load(HB + (size_t)r1 * D, F.lane); nw1 = wa1; nw2 = wa2;
                            ny1 = raw_load(Y + ((size_t)YBASE(sa1 >> 16) + (size_t)(sa1 & 0xffff)) * D, F.lane); ny2 = raw_load(Y + ((size_t)YBASE(sa2 >> 16) + (size_t)(sa2 & 0xffff)) * D, F.lane); }
                        if (r2 < M) { sa1 = tok_slot[r2 * 2]; sa2 = tok_slot[r2 * 2 + 1]; wa1 = tok_w[r2 * 2]; wa2 = tok_w[r2 * 2 + 1]; }
                        f32x4 v[4], ya[4], yb[4]; raw_unpack(v, ch); raw_unpack(ya, cy1); raw_unpack(yb, cy2);
#pragma unroll
                        for (int j = 0; j < 4; ++j) v[j] = v[j] * ALPHA + ya[j] * w1 + yb[j] * w2;
                        ln_vals(v, LP);
                        if (l == DEPTH - 1) rowf_store(v, OUTF + (size_t)r * D, F.lane, dry);
                        else rowb_store(v, HA + (size_t)r * D, F.lane, dry);
                    }
#undef YBASE
                }
            }
            SEAM(pb + 11);
        }
    }
    if ((PROBE_STAMP >= 0 || PROBE_SPREAD >= 0) && blockIdx.x == 0 && hi == NPHASES) { __syncthreads(); unsigned a_ = MISC_OFF + 512; asm volatile("" : "+v"(a_)); volatile LAS unsigned long long* ck_ = (volatile LAS unsigned long long*)((LAS unsigned char*)lds_raw + a_);
        const unsigned long long dt = ck_[3] - ck_[2], t0 = __builtin_amdgcn_s_memrealtime();
        if (dt < 100000000ull) while (__builtin_amdgcn_s_memrealtime() - t0 < 10ull * dt) __builtin_amdgcn_s_sleep(8); }
#if PROBE_CLK
    { KArgs B_ = kargs(); XcdBarrier bar; bar.bar = (unsigned*)(B_->ws + WS_CTL) + CW_BAR + B_->li * XCD_BAR_WORDS; bar.x = xb_xcc_id(); bar.tid = TIDX(); bar.st = (volatile LAS unsigned*)((LAS unsigned char*)lds_raw + MISC_OFF); xcd_barrier(bar); }
    if (blockIdx.x == 0 && TIDX() == 0 && hi == NPHASES) { volatile LAS unsigned long long* ck = (volatile LAS unsigned long long*)((LAS unsigned char*)lds_raw + MISC_OFF + 512);
        const unsigned long long dc = (unsigned long long)clock64() - ck[0], dr = __builtin_amdgcn_s_memrealtime() - ck[1];
        args.out[0] = (float)((double)dc / (double)dr * 100.0); }
#endif
#undef IN
#undef SEAM
}

extern "C" void kernel_launch(void* const* d_in, const int* in_sizes, int n_in, void* d_out, int out_size, void* d_ws, size_t ws_size, hipStream_t stream) {
    static int grid = 0;
    if (grid == 0) {
        if (n_in != 23 || in_sizes[0] != M * D || out_size != M * D || ws_size < WS_END) { fprintf(stderr, "kernel_launch: unexpected shapes / workspace (%d inputs, ws %zu)\n", n_in, ws_size); grid = -1; return; }
        int dev = 0, cus = 0, per_cu = 0;
        if (hipGetDevice(&dev) != hipSuccess || hipDeviceGetAttribute(&cus, hipDeviceAttributeMultiprocessorCount, dev) != hipSuccess) { grid = -1; return; }
        if (hipFuncSetAttribute((const void*)fwd_kernel, hipFuncAttributeMaxDynamicSharedMemorySize, LDS_BYTES) != hipSuccess) { fprintf(stderr, "kernel_launch: hipFuncSetAttribute failed\n"); grid = -1; return; }
        if (hipOccupancyMaxActiveBlocksPerMultiprocessor(&per_cu, (const void*)fwd_kernel, NTHR, LDS_BYTES) != hipSuccess || per_cu < 1) fprintf(stderr, "kernel_launch: occupancy query says %d\n", per_cu);
        (void)hipGetLastError();
        grid = cus;
    }
    if (grid < 0) return;
    if (hipMemsetAsync((char*)d_ws + WS_CTL, 0, CTL_ZERO_BYTES, stream) != hipSuccess) return;
    Args a{};
    for (int i = 0; i < 23; ++i) a.in[i] = (const float*)d_in[i];
    a.out = (float*)d_out; a.ws = (unsigned char*)d_ws;
#if defined(PROBE_PHASE)
    a.ph_lo = 0; a.ph_hi = PROBE_PHASE + 1; a.li = 0; hipLaunchKernelGGL(fwd_kernel, dim3(grid), dim3(NTHR), LDS_BYTES, stream, a);
    a.ph_lo = PROBE_PHASE; a.ph_hi = PROBE_PHASE + 1; a.li = 1; hipLaunchKernelGGL(fwd_kernel, dim3(grid), dim3(NTHR), LDS_BYTES, stream, a);
    a.ph_lo = PROBE_PHASE + 1; a.ph_hi = NPHASES; a.li = 2; hipLaunchKernelGGL(fwd_kernel, dim3(grid), dim3(NTHR), LDS_BYTES, stream, a);
#elif N_LAUNCH_MODE == 1
    a.ph_lo = 0; a.ph_hi = NPHASES; a.li = 0;
    hipLaunchKernelGGL(fwd_kernel, dim3(grid), dim3(NTHR), LDS_BYTES, stream, a);
#else
    for (int p = 0; p < NPHASES; ++p) {
        const int l = p / NPH, s = p % NPH;
        if ((l & 1) == 0 && (s == 9 || s == 10)) continue;
        a.ph_lo = p; a.ph_hi = p + 1;
        hipLaunchKernelGGL(fwd_kernel, dim3(grid), dim3(NTHR), LDS_BYTES, stream, a);
    }
#endif
}
```
